# Optimizing an MI355X kernel written in HIP

```python
import jax
import jax.numpy as jnp
from jax import lax
import numpy as np

D_MODEL = 1024
BATCH = 4
SEQ = 4096
DEPTH = 4

HEAD_DIM = 64
D_RWKV = D_MODEL // 2
RWKV_HEADS = D_RWKV // HEAD_DIM
DECAY_LORA = 64
ICL_LORA = 64
GATE_LORA = 128
RWKV_GN_EPS = 64e-5
D_MOBA = D_MODEL // 2
MOBA_HEADS = D_MOBA // HEAD_DIM
MOBA_BLOCK = 256
MOBA_TOPK = 3
MOBA_Q_CHUNK = 32
D_SSM = D_MODEL // 2
SSM_GROUP = 16
SSM_GROUPS = D_SSM // SSM_GROUP
SSM_STATE = 64
N_BRANCHES = 3
N_EXPERT_GROUPS = 4
EXPERTS_PER_GROUP = 8
N_EXPERTS = N_EXPERT_GROUPS * EXPERTS_PER_GROUP
EXPERT_TOPK = 2
D_EXPERT = D_MODEL // 4
MOE_BLOCK = 512
LN_EPS = 1e-5
DEEPNORM_ALPHA = (2 * DEPTH) ** 0.25
DEEPNORM_BETA = (8 * DEPTH) ** -0.25
NEG_INF = -1e30
RWKV_COLS = 3 * D_RWKV + DECAY_LORA + ICL_LORA + GATE_LORA
MOBA_COLS = 3 * D_MOBA
OFF_MOBA = RWKV_COLS
OFF_SSM = OFF_MOBA + MOBA_COLS
OFF_GATE = OFF_SSM + D_SSM
D_IN_PROJ = OFF_GATE + N_BRANCHES * D_MODEL

kernel_name = 'hybrid_rwkv7_moba_s5_hmoe_deepnorm'


def layer_norm(x, w, b):
    xf = x.astype(jnp.float32)
    mu = jnp.mean(xf, -1, keepdims=True)
    var = jnp.mean(jnp.square(xf - mu), -1, keepdims=True)
    y = (xf - mu) * lax.rsqrt(var + LN_EPS) * w.astype(jnp.float32) + b.astype(jnp.float32)
    return y.astype(x.dtype)


def wkv7_scan(r, w, k, v, a, b):
    Bsz, L, H, N = r.shape

    def step(S, inp):
        r_t, w_t, k_t, v_t, a_t, b_t = inp
        sa = jnp.einsum('bhij,bhj->bhi', S, a_t)
        S = S * w_t[:, :, None, :] + sa[..., None] * b_t[:, :, None, :] + v_t[..., None] * k_t[:, :, None, :]
        return S, jnp.einsum('bhij,bhj->bhi', S, r_t)

    xs = tuple(jnp.moveaxis(t, 1, 0) for t in (r, w, k, v, a, b))
    S0 = jnp.zeros((Bsz, H, N, N), jnp.float32)
    _, y = lax.scan(step, S0, xs)
    return jnp.moveaxis(y, 0, 1)


def rwkv7_mixer(z, mu, w0, w2, a0, a2, g2, k_k, k_a, r_k, ln_w, ln_b):
    f32 = jnp.float32
    Bsz, L, _ = z.shape
    z = z.astype(f32)
    z_prev = jnp.pad(z, ((0, 0), (1, 0), (0, 0)))[:, :-1]
    z = z + (z_prev - z) * mu.astype(f32)
    cuts = np.cumsum([D_RWKV, D_RWKV, D_RWKV, DECAY_LORA, ICL_LORA]).tolist()
    r, k, v, xw, xa, xg = jnp.split(z, cuts, axis=-1)
    w_log = -jax.nn.softplus(-(w0.astype(f32) + jnp.tanh(xw) @ w2.astype(f32))) - 0.5
    decay = jnp.exp(-jnp.exp(w_log))
    a = jax.nn.sigmoid(a0.astype(f32) + xa @ a2.astype(f32))
    g = jax.nn.sigmoid(xg) @ g2.astype(f32)

    def heads(t):
        return t.reshape(Bsz, L, RWKV_HEADS, HEAD_DIM)

    kk = heads(k * k_k.astype(f32))
    kk = kk * lax.rsqrt(jnp.maximum(jnp.sum(kk * kk, -1, keepdims=True), 1e-24))
    k = k * (1.0 + (a - 1.0) * k_a.astype(f32))
    rh, kh, vh, ah = heads(r), heads(k), heads(v), heads(a)
    y = wkv7_scan(rh, heads(decay), kh, vh, -kk, kk * ah)
    mean = jnp.mean(y, -1, keepdims=True)
    var = jnp.mean(jnp.square(y - mean), -1, keepdims=True)
    y = ((y - mean) * lax.rsqrt(var + RWKV_GN_EPS)).reshape(Bsz, L, D_RWKV)
    y = y * ln_w.astype(f32) + ln_b.astype(f32)
    bonus = jnp.sum(rh * kh * r_k.astype(f32), -1, keepdims=True) * vh
    return (y + bonus.reshape(Bsz, L, D_RWKV)) * g


def alibi_slopes(n_heads):
    return 2.0 ** (-8.0 * jnp.arange(1, n_heads + 1, dtype=jnp.float32) / n_heads)


def moba_attention(q, k, v):
    f32 = jnp.float32
    Bsz, L, H, Dh = q.shape
    n_blk = -(-L // MOBA_BLOCK)
    Lp = n_blk * MOBA_BLOCK
    k_sel = min(MOBA_TOPK, n_blk)
    pad = ((0, 0), (0, Lp - L), (0, 0), (0, 0))
    q = jnp.pad(q, pad) * (Dh ** -0.5)
    kbt = jnp.pad(k, pad).reshape(Bsz, n_blk, MOBA_BLOCK, H, Dh).transpose(0, 3, 1, 2, 4)
    vbt = jnp.pad(v, pad).reshape(Bsz, n_blk, MOBA_BLOCK, H, Dh).transpose(0, 3, 1, 2, 4)
    kmean = jnp.mean(kbt.astype(f32), axis=3)
    n_chunk = Lp // MOBA_Q_CHUNK
    qc = q.reshape(Bsz, n_chunk, MOBA_Q_CHUNK, H, Dh).transpose(1, 0, 3, 2, 4)
    slopes = alibi_slopes(H)
    bi = jnp.arange(Bsz)[:, None, None, None]
    hi = jnp.arange(H)[None, :, None, None]
    blk_ids = jnp.arange(n_blk)
    offs = jnp.arange(MOBA_BLOCK)

    def one_chunk(args):
        c, qb = args
        q0 = c * MOBA_Q_CHUNK
        blk = q0 // MOBA_BLOCK
        tpos = q0 + jnp.arange(MOBA_Q_CHUNK)
        gate = jnp.einsum('bhqd,bhnd->bhqn', qb.astype(f32), kmean)
        gate = jnp.where(blk_ids < blk, gate, -jnp.inf)
        _, idx = lax.top_k(gate, k_sel)
        valid = idx < blk
        kg = kbt[bi, hi, idx]
        vg = vbt[bi, hi, idx]
        s_sel = jnp.einsum('bhqd,bhqknd->bhqkn', qb, kg, preferred_element_type=f32)
        spos = idx[..., None] * MOBA_BLOCK + offs
        s_sel = s_sel - slopes[:, None, None, None] * (tpos[:, None, None] - spos).astype(f32)
        s_sel = jnp.where(valid[..., None], s_sel, NEG_INF)
        k_own = lax.dynamic_index_in_dim(kbt, blk, axis=2, keepdims=False)
        v_own = lax.dynamic_index_in_dim(vbt, blk, axis=2, keepdims=False)
        s_own = jnp.einsum('bhqd,bhnd->bhqn', qb, k_own, preferred_element_type=f32)
        dist = tpos[:, None] - (blk * MOBA_BLOCK + offs)[None, :]
        s_own = jnp.where(dist >= 0, s_own - slopes[:, None, None] * dist.astype(f32), NEG_INF)
        s = jnp.concatenate([s_sel.reshape(Bsz, H, MOBA_Q_CHUNK, k_sel * MOBA_BLOCK), s_own], -1)
        p = jax.nn.softmax(s, axis=-1)
        p_sel = p[..., :k_sel * MOBA_BLOCK].reshape(Bsz, H, MOBA_Q_CHUNK, k_sel, MOBA_BLOCK).astype(vg.dtype)
        p_own = p[..., k_sel * MOBA_BLOCK:].astype(v_own.dtype)
        return (jnp.einsum('bhqkn,bhqknd->bhqd', p_sel, vg)
                + jnp.einsum('bhqn,bhnd->bhqd', p_own, v_own))

    out = lax.map(one_chunk, (jnp.arange(n_chunk), qc))
    return out.transpose(1, 0, 3, 2, 4).reshape(Bsz, Lp, H * Dh)[:, :L]


def _complex_affine_combine(e1, e2):
    ar1, ai1, br1, bi1 = e1
    ar2, ai2, br2, bi2 = e2
    return (ar2 * ar1 - ai2 * ai1, ar2 * ai1 + ai2 * ar1,
            ar2 * br1 - ai2 * bi1 + br2, ar2 * bi1 + ai2 * br1 + bi2)


def s5_mixer(u, a_re, a_im, b_re, b_im, c_re, c_im, d, log_dt, glu_w, glu_b):
    f32 = jnp.float32
    Bsz, L, _ = u.shape
    u = u.astype(f32)
    a_re = a_re.astype(f32)
    a_im = a_im.astype(f32)
    dt = jnp.exp(log_dt.astype(f32))[:, None]
    mag = jnp.exp(a_re * dt)
    lam_re = mag * jnp.cos(a_im * dt)
    lam_im = mag * jnp.sin(a_im * dt)
    den = a_re * a_re + a_im * a_im
    nr = lam_re - 1.0
    coef_re = (nr * a_re + lam_im * a_im) / den
    coef_im = (lam_im * a_re - nr * a_im) / den
    b_re = b_re.astype(f32)
    b_im = b_im.astype(f32)
    bb_re = coef_re[..., None] * b_re - coef_im[..., None] * b_im
    bb_im = coef_re[..., None] * b_im + coef_im[..., None] * b_re
    ug = u.reshape(Bsz, L, SSM_GROUPS, SSM_GROUP)
    bu_re = jnp.einsum('blgh,gph->blgp', ug, bb_re)
    bu_im = jnp.einsum('blgh,gph->blgp', ug, bb_im)
    lr = jnp.broadcast_to(lam_re, bu_re.shape)
    li = jnp.broadcast_to(lam_im, bu_re.shape)
    _, _, h_re, h_im = lax.associative_scan(_complex_affine_combine, (lr, li, bu_re, bu_im), axis=1)
    y = (jnp.einsum('blgp,ghp->blgh', h_re, c_re.astype(f32))
         - jnp.einsum('blgp,ghp->blgh', h_im, c_im.astype(f32)))
    y = y.reshape(Bsz, L, D_SSM) + d.astype(f32) * u
    y = jax.nn.gelu(y)
    zg = y @ glu_w.astype(f32) + glu_b.astype(f32)
    return zg[..., :D_SSM] * jax.nn.sigmoid(zg[..., D_SSM:])


def hybrid_mixer(x, w_in, rwkv_mu, rwkv_w0, rwkv_w2, rwkv_a0, rwkv_a2, rwkv_g2, rwkv_k_k, rwkv_k_a,
                 rwkv_r_k, rwkv_ln_w, rwkv_ln_b, ssm_a_re, ssm_a_im, ssm_b_re, ssm_b_im, ssm_c_re,
                 ssm_c_im, ssm_d, ssm_log_dt, ssm_glu_w, ssm_glu_b, w_up_rwkv, w_up_moba, w_up_ssm,
                 gate_b, w_out):
    Bsz, L, _ = x.shape
    proj = x @ w_in
    y_a = rwkv7_mixer(proj[..., :OFF_MOBA], rwkv_mu, rwkv_w0, rwkv_w2, rwkv_a0, rwkv_a2, rwkv_g2,
                      rwkv_k_k, rwkv_k_a, rwkv_r_k, rwkv_ln_w, rwkv_ln_b).astype(x.dtype)
    q, k, v = jnp.split(proj[..., OFF_MOBA:OFF_SSM], 3, axis=-1)

    def heads(t):
        return t.reshape(Bsz, L, MOBA_HEADS, HEAD_DIM)

    y_b = moba_attention(heads(q), heads(k), heads(v))
    y_c = s5_mixer(proj[..., OFF_SSM:OFF_GATE], ssm_a_re, ssm_a_im, ssm_b_re, ssm_b_im, ssm_c_re,
                   ssm_c_im, ssm_d, ssm_log_dt, ssm_glu_w, ssm_glu_b).astype(x.dtype)
    gates = jax.nn.sigmoid(proj[..., OFF_GATE:] + gate_b).reshape(Bsz, L, N_BRANCHES, D_MODEL)
    merged = (gates[..., 0, :] * (y_a @ w_up_rwkv)
              + gates[..., 1, :] * (y_b @ w_up_moba)
              + gates[..., 2, :] * (y_c @ w_up_ssm))
    return merged @ w_out


def hier_moe(x, router_group_w, router_group_b, router_expert_w, router_expert_b,
             expert_w_gate, expert_w_up, expert_w_down):
    f32 = jnp.float32
    Bsz, L, D = x.shape
    T = Bsz * L
    TK = T * EXPERT_TOPK
    xt = x.reshape(T, D)
    xf = xt.astype(f32)
    g_logits = xf @ router_group_w.astype(f32) + router_group_b.astype(f32)
    g_sel = jnp.argmax(g_logits, axis=-1)
    p_group = jnp.take_along_axis(jax.nn.softmax(g_logits, -1), g_sel[:, None], axis=-1)
    e_logits = (xf @ router_expert_w.astype(f32) + router_expert_b.astype(f32)).reshape(
        T, N_EXPERT_GROUPS, EXPERTS_PER_GROUP)
    e_logits = jnp.take_along_axis(e_logits, g_sel[:, None, None], axis=1)[:, 0]
    top_logit, top_local = lax.top_k(e_logits, EXPERT_TOPK)
    weight = p_group * jax.nn.softmax(top_logit, axis=-1)
    expert = g_sel[:, None] * EXPERTS_PER_GROUP + top_local
    flat_e = expert.reshape(TK)
    order = jnp.argsort(flat_e)
    e_sorted = flat_e[order]
    tok_sorted = order // EXPERT_TOPK
    counts = jnp.bincount(flat_e, length=N_EXPERTS)
    starts = jnp.cumsum(counts) - counts
    padded = (counts + MOE_BLOCK - 1) // MOE_BLOCK * MOE_BLOCK
    p_ends = jnp.cumsum(padded)
    p_starts = p_ends - padded
    dest = p_starts[e_sorted] + jnp.arange(TK) - starts[e_sorted]
    n_blocks = -(-TK // MOE_BLOCK) + N_EXPERTS
    buf = jnp.zeros((n_blocks * MOE_BLOCK, D), x.dtype).at[dest].set(xt[tok_sorted])
    blk_e = jnp.minimum(jnp.searchsorted(p_ends, jnp.arange(n_blocks) * MOE_BLOCK, side='right'),
                        N_EXPERTS - 1)
    xb = buf.reshape(n_blocks, MOE_BLOCK, D)
    hid = (jax.nn.silu(jnp.einsum('nbd,ndf->nbf', xb, expert_w_gate[blk_e]))
           * jnp.einsum('nbd,ndf->nbf', xb, expert_w_up[blk_e]))
    yb = jnp.einsum('nbf,nfd->nbd', hid, expert_w_down[blk_e]).reshape(n_blocks * MOE_BLOCK, D)
    w_sorted = weight.reshape(TK)[order].astype(x.dtype)
    y = jnp.zeros((T, D), x.dtype).at[tok_sorted].add(yb[dest] * w_sorted[:, None])
    return y.reshape(Bsz, L, D)


def setup_inputs(seed: int = 0) -> dict:
    key = jax.random.key(seed)
    keys = iter(jax.random.split(key, 48))
    f32 = jnp.float32

    def nrm(shape, scale):
        return scale * jax.random.normal(next(keys), shape, f32)

    def near(shape, center, spread):
        return center + spread * jax.random.normal(next(keys), shape, f32)

    Ld = DEPTH
    ratio = jnp.arange(D_RWKV, dtype=f32) / (D_RWKV - 1)
    w0_base = -7.0 + 5.0 * ratio ** 0.85 + 0.5
    a_im_base = jnp.pi * jnp.arange(SSM_STATE, dtype=f32)
    return {
        'x': nrm((BATCH, SEQ, D_MODEL), 1.0),
        'w_in': nrm((Ld, D_MODEL, D_IN_PROJ), D_MODEL ** -0.5),
        'rwkv_mu': jax.random.uniform(next(keys), (Ld, RWKV_COLS), f32),
        'rwkv_w0': w0_base + nrm((Ld, D_RWKV), 0.1),
        'rwkv_w2': nrm((Ld, DECAY_LORA, D_RWKV), 0.5 * DECAY_LORA ** -0.5),
        'rwkv_a0': nrm((Ld, D_RWKV), 0.1),
        'rwkv_a2': nrm((Ld, ICL_LORA, D_RWKV), ICL_LORA ** -0.5),
        'rwkv_g2': nrm((Ld, GATE_LORA, D_RWKV), GATE_LORA ** -0.5),
        'rwkv_k_k': near((Ld, D_RWKV), 0.85, 0.05),
        'rwkv_k_a': near((Ld, D_RWKV), 1.0, 0.05),
        'rwkv_r_k': nrm((Ld, RWKV_HEADS, HEAD_DIM), 0.1),
        'rwkv_ln_w': near((Ld, D_RWKV), 1.0, 0.05),
        'rwkv_ln_b': nrm((Ld, D_RWKV), 0.02),
        'ssm_a_re': near((Ld, SSM_GROUPS, SSM_STATE), -0.5, 0.01),
        'ssm_a_im': jnp.broadcast_to(a_im_base, (Ld, SSM_GROUPS, SSM_STATE)) + nrm((Ld, SSM_GROUPS, SSM_STATE), 0.01),
        'ssm_b_re': nrm((Ld, SSM_GROUPS, SSM_STATE, SSM_GROUP), (2 * SSM_GROUP) ** -0.5),
        'ssm_b_im': nrm((Ld, SSM_GROUPS, SSM_STATE, SSM_GROUP), (2 * SSM_GROUP) ** -0.5),
        'ssm_c_re': nrm((Ld, SSM_GROUPS, SSM_GROUP, SSM_STATE), 0.5),
        'ssm_c_im': nrm((Ld, SSM_GROUPS, SSM_GROUP, SSM_STATE), 0.5),
        'ssm_d': nrm((Ld, D_SSM), 1.0),
        'ssm_log_dt': jax.random.uniform(next(keys), (Ld, SSM_GROUPS), f32,
                                         minval=float(np.log(1e-3)), maxval=float(np.log(1e-1))),
        'ssm_glu_w': nrm((Ld, D_SSM, 2 * D_SSM), D_SSM ** -0.5),
        'ssm_glu_b': nrm((Ld, 2 * D_SSM), 0.02),
        'w_up_rwkv': nrm((Ld, D_RWKV, D_MODEL), D_RWKV ** -0.5),
        'w_up_moba': nrm((Ld, D_MOBA, D_MODEL), D_MOBA ** -0.5),
        'w_up_ssm': nrm((Ld, D_SSM, D_MODEL), D_SSM ** -0.5),
        'gate_b': nrm((Ld, N_BRANCHES * D_MODEL), 0.1),
        'w_out': nrm((Ld, D_MODEL, D_MODEL), DEEPNORM_BETA * D_MODEL ** -0.5),
        'ln1_w': near((Ld, D_MODEL), 1.0, 0.05),
        'ln1_b': nrm((Ld, D_MODEL), 0.02),
        'router_group_w': nrm((Ld, D_MODEL, N_EXPERT_GROUPS), D_MODEL ** -0.5),
        'router_group_b': nrm((Ld, N_EXPERT_GROUPS), 0.01),
        'router_expert_w': nrm((Ld, D_MODEL, N_EXPERTS), D_MODEL ** -0.5),
        'router_expert_b': nrm((Ld, N_EXPERTS), 0.01),
        'expert_w_gate': nrm((Ld, N_EXPERTS, D_MODEL, D_EXPERT), D_MODEL ** -0.5),
        'expert_w_up': nrm((Ld, N_EXPERTS, D_MODEL, D_EXPERT), D_MODEL ** -0.5),
        'expert_w_down': nrm((Ld, N_EXPERTS, D_EXPERT, D_MODEL), DEEPNORM_BETA * D_EXPERT ** -0.5),
        'ln2_w': near((Ld, D_MODEL), 1.0, 0.05),
        'ln2_b': nrm((Ld, D_MODEL), 0.02),
    }


def reference(x, w_in, rwkv_mu, rwkv_w0, rwkv_w2, rwkv_a0, rwkv_a2, rwkv_g2, rwkv_k_k, rwkv_k_a,
              rwkv_r_k, rwkv_ln_w, rwkv_ln_b, ssm_a_re, ssm_a_im, ssm_b_re, ssm_b_im, ssm_c_re,
              ssm_c_im, ssm_d, ssm_log_dt, ssm_glu_w, ssm_glu_b, w_up_rwkv, w_up_moba, w_up_ssm,
              gate_b, w_out, ln1_w, ln1_b, router_group_w, router_group_b, router_expert_w,
              router_expert_b, expert_w_gate, expert_w_up, expert_w_down, ln2_w, ln2_b):
    for l in range(DEPTH):
        h = hybrid_mixer(x, w_in[l], rwkv_mu[l], rwkv_w0[l], rwkv_w2[l], rwkv_a0[l], rwkv_a2[l],
                         rwkv_g2[l], rwkv_k_k[l], rwkv_k_a[l], rwkv_r_k[l], rwkv_ln_w[l], rwkv_ln_b[l],
                         ssm_a_re[l], ssm_a_im[l], ssm_b_re[l], ssm_b_im[l], ssm_c_re[l], ssm_c_im[l],
                         ssm_d[l], ssm_log_dt[l], ssm_glu_w[l], ssm_glu_b[l], w_up_rwkv[l],
                         w_up_moba[l], w_up_ssm[l], gate_b[l], w_out[l])
        x = layer_norm(DEEPNORM_ALPHA * x + h, ln1_w[l], ln1_b[l])
        h = hier_moe(x, router_group_w[l], router_group_b[l], router_expert_w[l], router_expert_b[l],
                     expert_w_gate[l], expert_w_up[l], expert_w_down[l])
        x = layer_norm(DEEPNORM_ALPHA * x + h, ln2_w[l], ln2_b[l])
    return x
```

```cpp
#include <hip/hip_runtime.h>
#include <cstdio>
#include <cstdint>
#include <cmath>

typedef unsigned short bf16_t;
typedef short bf16x8 __attribute__((ext_vector_type(8)));
typedef float f32x4 __attribute__((ext_vector_type(4)));

constexpr int NB = 4, SEQ = 4096, T = NB * SEQ, D = 1024, DEPTH = 4, HD = 64;
constexpr int DR = 512, RH = 8, DMO = 512, MH = 8, DSS = 512, SGRP = 16, NGR = 32, SST = 64;
constexpr int OFF_MOBA = 1792, OFF_SSM = 3328, OFF_GATE = 3840, NPROJ = 6912;
constexpr int MBLK = 256, NBLK = SEQ / MBLK;
constexpr int NE = 32, EPG = 8, NGRP = 4, DE = 256;
constexpr int MAXSLOT = 40960;
constexpr float LN_EPS = 1e-5f, GN_EPS = 64e-5f;
constexpr float ALPHA = 1.6817928305074290f;

constexpr size_t MiB = 1u << 20;
constexpr size_t WS_CTL = 0, CTL_BYTES = 1 * MiB;
constexpr size_t WS_SMALL = 1 * MiB;
constexpr size_t WS_WT_IN = 4 * MiB, WS_WT_GLU = 18 * MiB, WS_WT_UPA = 19 * MiB, WS_WT_UPB = 20 * MiB, WS_WT_UPC = 21 * MiB,
                 WS_WT_OUT = 22 * MiB, WS_WT_EGU = 24 * MiB, WS_WT_ED = 56 * MiB;
constexpr size_t WS_PROJ = 72 * MiB;
constexpr size_t WS_XN = 288 * MiB;
constexpr size_t WS_R = 320 * MiB, WS_KP = 336 * MiB, WS_V = 352 * MiB, WS_KK = 368 * MiB, WS_AA = 384 * MiB, WS_GG = 400 * MiB;
constexpr size_t WS_LW = 416 * MiB;
constexpr size_t WS_YRAW = 448 * MiB;
constexpr size_t WS_YA = 480 * MiB, WS_YB = 496 * MiB, WS_YC = 512 * MiB, WS_YCPRE = 528 * MiB;
constexpr size_t WS_ROUTE = 544 * MiB;
constexpr size_t WS_END = 548 * MiB;
constexpr size_t WS_MERGED = 320 * MiB;
constexpr size_t WS_MERGEDB = 384 * MiB;
constexpr size_t WS_S = 416 * MiB;
constexpr size_t WS_XG = 72 * MiB;
constexpr size_t WS_HID = 152 * MiB;
constexpr size_t WS_YG = 172 * MiB;
constexpr size_t SM_LAM = 0;
constexpr size_t SM_BB = 16384;
constexpr size_t SM_KMEAN = 16384 + 262144;
constexpr size_t SM_RTW = SM_KMEAN + 131072;
constexpr size_t RT_EID = 0, RT_POS = 131072, RT_SLOT = 262144, RT_WGT = 393216;
constexpr int CW_CNT = 1024;

__device__ __forceinline__ float bf2f(bf16_t h) { return __uint_as_float(((unsigned)h) << 16); }
__device__ __forceinline__ bf16_t f2bf(float f) { unsigned u = __float_as_uint(f); return (bf16_t)((u + 0x7fffu + ((u >> 16) & 1u)) >> 16); }
__device__ __forceinline__ float wave_allsum(float v) {
#pragma unroll
    for (int o = 1; o < 64; o <<= 1) v += __shfl_xor(v, o);
    return v;
}
__device__ __forceinline__ float sigmoidf_(float x) { return 1.f / (1.f + __expf(-x)); }
__device__ __forceinline__ float gelu_tanh(float x) { const float u = 0.7978845608028654f * (x + 0.044715f * x * x * x); return 0.5f * x * (1.f + tanhf(u)); }

__global__ void k_cvt(const float* __restrict__ W, int ldw, int K, int Nsub, bf16_t* __restrict__ WT, int interleave, int row_off) {
    const long i = (long)blockIdx.x * blockDim.x + threadIdx.x;
    if (i >= (long)K * Nsub) return;
    const int n = (int)(i / K), k = (int)(i % K);
    const int dr = interleave ? ((n >> 7) * 256 + (n & 127) + row_off) : (n + row_off);
    WT[(size_t)dr * K + k] = f2bf(W[(size_t)k * ldw + n]);
}
__global__ void k_rtw(const float* __restrict__ gw, const float* __restrict__ ew, float* __restrict__ RTW) {
    const int i = blockIdx.x * blockDim.x + threadIdx.x;
    if (i >= 36 * 1024) return;
    const int j = i / 1024, k = i % 1024;
    RTW[i] = j < 4 ? gw[k * 4 + j] : ew[k * 32 + (j - 4)];
}
__global__ void k_s5tab(const float* __restrict__ a_re, const float* __restrict__ a_im, const float* __restrict__ b_re, const float* __restrict__ b_im,
                        const float* __restrict__ log_dt, float* __restrict__ LAM, float* __restrict__ BB) {
    const int i = blockIdx.x * blockDim.x + threadIdx.x;
    if (i >= NGR * SST) return;
    const int g = i / SST;
    const float dt = expf(log_dt[g]);
    const float are = a_re[i], aim = a_im[i];
    const float mag = expf(are * dt);
    const float ang = aim * dt;
    const float lre = mag * cosf(ang), lim = mag * sinf(ang);
    const float den = are * are + aim * aim, nr = lre - 1.0f;
    const float cre = (nr * are + lim * aim) / den, cim = (lim * are - nr * aim) / den;
    LAM[i * 2] = lre; LAM[i * 2 + 1] = lim;
    for (int h = 0; h < SGRP; ++h) {
        const float bre = b_re[i * SGRP + h], bim = b_im[i * SGRP + h];
        BB[(i * SGRP + h) * 2] = cre * bre - cim * bim;
        BB[(i * SGRP + h) * 2 + 1] = cre * bim + cim * bre;
    }
}
__global__ void k_x0(const float* __restrict__ x, float* __restrict__ X, bf16_t* __restrict__ XN) {
    const long i = (long)blockIdx.x * blockDim.x + threadIdx.x;
    if (i >= (long)T * D) return;
    const float v = x[i]; X[i] = v; XN[i] = f2bf(v);
}

template <class Epi, bool PAIR>
__global__ __launch_bounds__(256) void k_gemm(const bf16_t* __restrict__ A, const bf16_t* __restrict__ Bt, int K, Epi E) {
    const int wave = threadIdx.x >> 6, lane = threadIdx.x & 63, fr = lane & 15, fq = lane >> 4;
    const int rt = blockIdx.y;
    if (!E.active(rt)) return;
    const bf16_t* B2 = Bt + E.bt_off(rt);
    const int row0 = rt * 64 + (wave >> 1) * 32;
    int colA, colB = 0, ch0 = 0;
    if (PAIR) { ch0 = blockIdx.x * 64 + (wave & 1) * 32; colA = (ch0 >> 7) * 256 + (ch0 & 127); colB = colA + 128; }
    else colA = blockIdx.x * 64 + (wave & 1) * 32;
    f32x4 acc[2][2], acc2[2][2];
#pragma unroll
    for (int i = 0; i < 2; ++i)
#pragma unroll
        for (int j = 0; j < 2; ++j) { acc[i][j] = (f32x4){0.f, 0.f, 0.f, 0.f}; acc2[i][j] = (f32x4){0.f, 0.f, 0.f, 0.f}; }
    for (int k0 = 0; k0 < K; k0 += 32) {
        bf16x8 a[2], b[2], b2[2];
#pragma unroll
        for (int i = 0; i < 2; ++i) a[i] = *(const bf16x8*)(A + (size_t)(row0 + i * 16 + fr) * K + k0 + fq * 8);
#pragma unroll
        for (int j = 0; j < 2; ++j) b[j] = *(const bf16x8*)(B2 + (size_t)(colA + j * 16 + fr) * K + k0 + fq * 8);
        if (PAIR) {
#pragma unroll
            for (int j = 0; j < 2; ++j) b2[j] = *(const bf16x8*)(B2 + (size_t)(colB + j * 16 + fr) * K + k0 + fq * 8);
        }
#pragma unroll
        for (int i = 0; i < 2; ++i)
#pragma unroll
            for (int j = 0; j < 2; ++j) {
                acc[i][j] = __builtin_amdgcn_mfma_f32_16x16x32_bf16(a[i], b[j], acc[i][j], 0, 0, 0);
                if (PAIR) acc2[i][j] = __builtin_amdgcn_mfma_f32_16x16x32_bf16(a[i], b2[j], acc2[i][j], 0, 0, 0);
            }
    }
#pragma unroll
    for (int i = 0; i < 2; ++i)
#pragma unroll
        for (int j = 0; j < 2; ++j)
#pragma unroll
            for (int r = 0; r < 4; ++r) {
                const int row = row0 + i * 16 + fq * 4 + r;
                if (PAIR) E.store2(row, ch0 + j * 16 + fr, acc[i][j][r], acc2[i][j][r]);
                else E.store(row, colA + j * 16 + fr, acc[i][j][r]);
            }
}
struct EDense { __device__ bool active(int) const { return true; } __device__ size_t bt_off(int) const { return 0; } };
struct EProj : EDense { bf16_t* P; __device__ void store(int r, int c, float v) const { P[(size_t)r * NPROJ + c] = f2bf(v); } __device__ void store2(int, int, float, float) const {} };
struct EGlu : EDense { bf16_t* YC; const float* bias;
    __device__ void store(int, int, float) const {}
    __device__ void store2(int r, int ch, float v, float g) const { YC[(size_t)r * DSS + ch] = f2bf((v + bias[ch]) * sigmoidf_(g + bias[DSS + ch])); } };
struct EUp : EDense { const bf16_t* P; const float* gate_b; float* M; bf16_t* MB; int br;
    __device__ void store2(int, int, float, float) const {}
    __device__ void store(int r, int c, float v) const {
        const float gl = bf2f(P[(size_t)r * NPROJ + OFF_GATE + br * D + c]) + gate_b[br * D + c];
        float m = sigmoidf_(gl) * v; const size_t o = (size_t)r * D + c;
        if (br > 0) m += M[o];
        M[o] = m; if (br == 2) MB[o] = f2bf(m); } };
struct EOut : EDense { const float* X; float* S;
    __device__ void store2(int, int, float, float) const {}
    __device__ void store(int r, int c, float v) const { const size_t o = (size_t)r * D + c; S[o] = ALPHA * X[o] + v; } };
struct EGrouped { const unsigned* cnt; int rows_per_e;
    __device__ int expert_of(int rt, bool& ok) const {
        int off = 0; const int r0 = rt * 64;
        for (int e = 0; e < NE; ++e) { const int p = ((int)cnt[e] + 255) & ~255; if (r0 < off + p) { ok = true; return e; } off += p; }
        ok = false; return 0; }
    __device__ bool active(int rt) const { bool ok; expert_of(rt, ok); return ok; }
};
struct ESwi : EGrouped { bf16_t* HID;
    __device__ size_t bt_off(int rt) const { bool ok; const int e = expert_of(rt, ok); return (size_t)e * 512 * D; }
    __device__ void store(int, int, float) const {}
    __device__ void store2(int r, int ch, float g, float u) const { HID[(size_t)r * DE + ch] = f2bf(g * sigmoidf_(g) * u); } };
struct EDown : EGrouped { bf16_t* YG;
    __device__ size_t bt_off(int rt) const { bool ok; const int e = expert_of(rt, ok); return (size_t)e * D * DE; }
    __device__ void store2(int, int, float, float) const {}
    __device__ void store(int r, int c, float v) const { YG[(size_t)r * D + c] = f2bf(v); } };

__global__ __launch_bounds__(512) void k_prep(const bf16_t* __restrict__ P, const float* __restrict__ mu, const float* __restrict__ w0, const float* __restrict__ w2,
        const float* __restrict__ a0, const float* __restrict__ a2, const float* __restrict__ g2, const float* __restrict__ k_k, const float* __restrict__ k_a,
        bf16_t* R, bf16_t* KP, bf16_t* V, bf16_t* KK, bf16_t* AA, bf16_t* GG, float* LW) {
    __shared__ float act[256];
    const int t = blockIdx.x, c = threadIdx.x;
    const bool first = (t % SEQ) == 0;
    const bf16_t* row = P + (size_t)t * NPROJ; const bf16_t* prow = row - NPROJ;
    auto zs = [&](int col) -> float { const float z = bf2f(row[col]); const float zp = first ? 0.f : bf2f(prow[col]); return z + (zp - z) * mu[col]; };
    if (c < 256) { const float z = zs(1536 + c); act[c] = c < 64 ? tanhf(z) : (c < 128 ? z : sigmoidf_(z)); }
    __syncthreads();
    const float r = zs(c), k = zs(512 + c), v = zs(1024 + c);
    float sw = 0.f, sa = 0.f, sg = 0.f;
#pragma unroll 4
    for (int i = 0; i < 64; ++i) { sw += act[i] * w2[i * DR + c]; sa += act[64 + i] * a2[i * DR + c]; }
#pragma unroll 4
    for (int i = 0; i < 128; ++i) sg += act[128 + i] * g2[i * DR + c];
    const float xx = -(w0[c] + sw);
    const float sp = fmaxf(xx, 0.f) + log1pf(expf(-fabsf(xx)));
    const float wl = -sp - 0.5f;
    const float lw = -expf(wl);
    const float a = sigmoidf_(a0[c] + sa);
    const float kk = k * k_k[c];
    const float ss = wave_allsum(kk * kk);
    const float kkn = kk * rsqrtf(fmaxf(ss, 1e-24f));
    const float kp = k * (1.f + (a - 1.f) * k_a[c]);
    const size_t o = (size_t)t * DR + c;
    R[o] = f2bf(r); KP[o] = f2bf(kp); V[o] = f2bf(v); KK[o] = f2bf(kkn); AA[o] = f2bf(a); GG[o] = f2bf(sg); LW[o] = lw;
}
__global__ __launch_bounds__(256) void k_wkv(const bf16_t* __restrict__ R, const bf16_t* __restrict__ KP, const bf16_t* __restrict__ V, const bf16_t* __restrict__ KK,
        const bf16_t* __restrict__ AA, const float* __restrict__ LW, float* __restrict__ YRAW) {
    const int gwv = blockIdx.x * 4 + (threadIdx.x >> 6), j = threadIdx.x & 63;
    const int i = gwv & 63, h = (gwv >> 6) & 7, b = gwv >> 9;
    float S = 0.f;
    for (int t = 0; t < SEQ; ++t) {
        const size_t o = (size_t)(b * SEQ + t) * DR + h * 64;
        const float r = bf2f(R[o + j]), w = __expf(LW[o + j]), k = bf2f(KP[o + j]), kk = bf2f(KK[o + j]), a = bf2f(AA[o + j]), v = bf2f(V[o + i]);
        const float sa = wave_allsum(S * (-kk));
        S = S * w + sa * (kk * a) + v * k;
        const float y = wave_allsum(S * r);
        if (j == 0) YRAW[o + i] = y;
    }
}
__global__ __launch_bounds__(512) void k_wkvpost(const float* __restrict__ YRAW, const bf16_t* __restrict__ R, const bf16_t* __restrict__ KP, const bf16_t* __restrict__ V,
        const bf16_t* __restrict__ GG, const float* __restrict__ r_k, const float* __restrict__ ln_w, const float* __restrict__ ln_b, bf16_t* __restrict__ YA) {
    const int t = blockIdx.x, c = threadIdx.x; const size_t o = (size_t)t * DR + c;
    const float y = YRAW[o];
    const float mean = wave_allsum(y) * (1.f / 64.f);
    const float dv = y - mean;
    const float var = wave_allsum(dv * dv) * (1.f / 64.f);
    const float yn = dv * rsqrtf(var + GN_EPS) * ln_w[c] + ln_b[c];
    const float bonus = wave_allsum(bf2f(R[o]) * bf2f(KP[o]) * r_k[c]) * bf2f(V[o]);
    YA[o] = f2bf((yn + bonus) * bf2f(GG[o]));
}
__global__ void k_kmean(const bf16_t* __restrict__ P, float* __restrict__ KM) {
    const int i = blockIdx.x * blockDim.x + threadIdx.x;
    if (i >= NB * MH * NBLK * HD) return;
    const int d = i & 63, n = (i >> 6) & 15, h = (i >> 10) & 7, b = i >> 13;
    float s = 0.f;
    for (int q = 0; q < MBLK; ++q) s += bf2f(P[(size_t)(b * SEQ + n * MBLK + q) * NPROJ + OFF_MOBA + 512 + h * 64 + d]);
    KM[i] = s * (1.f / MBLK);
}
__global__ __launch_bounds__(256) void k_moba(const bf16_t* __restrict__ P, const float* __restrict__ KM, bf16_t* __restrict__ YB) {
    const int gwv = blockIdx.x * 4 + (threadIdx.x >> 6), lane = threadIdx.x & 63;
    const int h = gwv & 7, tt = gwv >> 3;
    const int b = tt / SEQ, tpos = tt % SEQ, blk = tpos / MBLK;
    const float slope = exp2f(-(float)(h + 1));
    const bf16_t* qrow = P + (size_t)tt * NPROJ + OFF_MOBA + h * 64;
    const float qd = bf2f(qrow[lane]) * 0.125f;
    float q[64];
#pragma unroll
    for (int d = 0; d < 64; ++d) q[d] = __shfl(qd, d);
    int sel[3] = {-1, -1, -1};
    {
        float gate[16];
#pragma unroll
        for (int n = 0; n < 16; ++n) { const float km = KM[((b * MH + h) * NBLK + n) * HD + lane]; gate[n] = wave_allsum(qd * km); }
#pragma unroll
        for (int s = 0; s < 3; ++s) {
            int best = -1; float bv = 0.f;
#pragma unroll
            for (int n = 0; n < 16; ++n) { const bool ok = n < blk && n != sel[0] && n != sel[1]; if (ok && (best < 0 || gate[n] > bv)) { best = n; bv = gate[n]; } }
            sel[s] = best;
        }
    }
    float m = -INFINITY, l = 0.f, o = 0.f;
    for (int s = 0; s < 4; ++s) {
        const int n = s < 3 ? sel[s] : blk;
        if (n < 0) continue;
        for (int c0 = 0; c0 < MBLK; c0 += 64) {
            const int sp = n * MBLK + c0 + lane;
            const bool valid = sp <= tpos;
            if (n * MBLK + c0 > tpos) break;
            const bf16_t* krow = P + (size_t)(b * SEQ + sp) * NPROJ + OFF_MOBA + 512 + h * 64;
            float sc = 0.f;
#pragma unroll
            for (int d8 = 0; d8 < 8; ++d8) { const bf16x8 kv = *(const bf16x8*)(krow + d8 * 8);
#pragma unroll
                for (int e = 0; e < 8; ++e) sc += q[d8 * 8 + e] * bf2f((bf16_t)kv[e]); }
            sc -= slope * (float)(tpos - sp);
            if (!valid) sc = -INFINITY;
            float mx = sc;
#pragma unroll
            for (int of = 1; of < 64; of <<= 1) mx = fmaxf(mx, __shfl_xor(mx, of));
            const float mn = fmaxf(m, mx);
            const float scale = __expf(m - mn);
            const float p = valid ? __expf(sc - mn) : 0.f;
            l = l * scale + wave_allsum(p);
            o *= scale;
            const bf16_t* vbase = P + (size_t)(b * SEQ + n * MBLK + c0) * NPROJ + OFF_MOBA + 1024 + h * 64 + lane;
            for (int e = 0; e < 64; ++e) { const float pe = __shfl(p, e); o += pe * bf2f(vbase[(size_t)e * NPROJ]); }
            m = mn;
        }
    }
    YB[(size_t)tt * DMO + h * 64 + lane] = f2bf(o / l);
}
__global__ __launch_bounds__(64) void k_s5(const bf16_t* __restrict__ P, const float* __restrict__ LAM, const float* __restrict__ BB, const float* __restrict__ c_re,
        const float* __restrict__ c_im, const float* __restrict__ dvec, bf16_t* __restrict__ YCPRE) {
    const int b = blockIdx.x / NGR, g = blockIdx.x % NGR, p = threadIdx.x;
    const float lre = LAM[(g * SST + p) * 2], lim = LAM[(g * SST + p) * 2 + 1];
    float bre[16], bim[16], cre[16], cim[16], dd[16];
#pragma unroll
    for (int h = 0; h < 16; ++h) { bre[h] = BB[((g * SST + p) * 16 + h) * 2]; bim[h] = BB[((g * SST + p) * 16 + h) * 2 + 1];
        cre[h] = c_re[(g * 16 + h) * SST + p]; cim[h] = c_im[(g * 16 + h) * SST + p]; dd[h] = dvec[g * 16 + h]; }
    float hre = 0.f, him = 0.f;
    for (int t = 0; t < SEQ; ++t) {
        const bf16_t* ur = P + (size_t)(b * SEQ + t) * NPROJ + OFF_SSM + g * 16;
        float u[16];
#pragma unroll
        for (int h = 0; h < 16; ++h) u[h] = bf2f(ur[h]);
        float bur = 0.f, bui = 0.f;
#pragma unroll
        for (int h = 0; h < 16; ++h) { bur += bre[h] * u[h]; bui += bim[h] * u[h]; }
        const float nre = lre * hre - lim * him + bur, nim = lre * him + lim * hre + bui;
        hre = nre; him = nim;
        float myy = 0.f;
#pragma unroll
        for (int h = 0; h < 16; ++h) { const float y = wave_allsum(cre[h] * hre - cim[h] * him) + dd[h] * u[h]; if (p == h) myy = y; }
        if (p < 16) YCPRE[(size_t)(b * SEQ + t) * DSS + g * 16 + p] = f2bf(gelu_tanh(myy));
    }
}
__global__ __launch_bounds__(256) void k_ln1route(const float* __restrict__ S, const float* __restrict__ lw, const float* __restrict__ lb, float* __restrict__ X, bf16_t* __restrict__ XN,
        const float* __restrict__ RTW, const float* __restrict__ gb, const float* __restrict__ eb, unsigned* __restrict__ cnt,
        int* __restrict__ EID, int* __restrict__ POS, float* __restrict__ WGT) {
    const int t = blockIdx.x * 4 + (threadIdx.x >> 6), lane = threadIdx.x & 63;
    float v[16]; float s = 0.f;
#pragma unroll
    for (int i = 0; i < 16; ++i) { v[i] = S[(size_t)t * D + i * 64 + lane]; s += v[i]; }
    const float mean = wave_allsum(s) * (1.f / D);
    float q = 0.f;
#pragma unroll
    for (int i = 0; i < 16; ++i) { v[i] -= mean; q += v[i] * v[i]; }
    const float rstd = rsqrtf(wave_allsum(q) * (1.f / D) + LN_EPS);
#pragma unroll
    for (int i = 0; i < 16; ++i) { const int c = i * 64 + lane; v[i] = v[i] * rstd * lw[c] + lb[c]; X[(size_t)t * D + c] = v[i]; XN[(size_t)t * D + c] = f2bf(v[i]); }
    float lg[36];
#pragma unroll
    for (int j = 0; j < 36; ++j) { float a = 0.f;
#pragma unroll
        for (int i = 0; i < 16; ++i) a += v[i] * RTW[j * 1024 + i * 64 + lane];
        lg[j] = wave_allsum(a); }
    if (lane == 0) {
        int gs = 0; float gm = lg[0] + gb[0]; float gl[4];
#pragma unroll
        for (int j = 0; j < 4; ++j) { gl[j] = lg[j] + gb[j]; if (gl[j] > gm) { gm = gl[j]; gs = j; } }
        float den = 0.f;
#pragma unroll
        for (int j = 0; j < 4; ++j) den += __expf(gl[j] - gm);
        const float pg = 1.f / den;
        float el[8];
#pragma unroll
        for (int j = 0; j < 8; ++j) { float x = 0.f;
#pragma unroll
            for (int g2 = 0; g2 < 4; ++g2) if (g2 == gs) x = lg[4 + g2 * 8 + j] + eb[g2 * 8 + j];
            el[j] = x; }
        int i0 = 0; float m0 = el[0];
#pragma unroll
        for (int j = 1; j < 8; ++j) if (el[j] > m0) { m0 = el[j]; i0 = j; }
        int i1 = -1; float m1 = 0.f;
#pragma unroll
        for (int j = 0; j < 8; ++j) if (j != i0 && (i1 < 0 || el[j] > m1)) { m1 = el[j]; i1 = j; }
        const float e1 = __expf(m1 - m0);
        const float p0 = 1.f / (1.f + e1), p1 = e1 / (1.f + e1);
        const int ex0 = gs * 8 + i0, ex1 = gs * 8 + i1;
        EID[t * 2] = ex0; EID[t * 2 + 1] = ex1;
        WGT[t * 2] = pg * p0; WGT[t * 2 + 1] = pg * p1;
        POS[t * 2] = (int)atomicAdd(&cnt[ex0], 1u);
        POS[t * 2 + 1] = (int)atomicAdd(&cnt[ex1], 1u);
    }
}
__global__ __launch_bounds__(256) void k_gather(const bf16_t* __restrict__ XN, const unsigned* __restrict__ cnt, const int* __restrict__ EID, const int* __restrict__ POS,
        int* __restrict__ SLOT, bf16_t* __restrict__ XG) {
    const int t = blockIdx.x * 4 + (threadIdx.x >> 6), lane = threadIdx.x & 63;
    for (int k = 0; k < 2; ++k) {
        const int e = EID[t * 2 + k]; int off = 0;
        for (int j = 0; j < e; ++j) off += ((int)cnt[j] + 255) & ~255;
        const int slot = off + POS[t * 2 + k];
        if (lane == 0) SLOT[t * 2 + k] = slot;
        const uint4* src = (const uint4*)(XN + (size_t)t * D); uint4* dst = (uint4*)(XG + (size_t)slot * D);
        dst[lane] = src[lane]; dst[lane + 64] = src[lane + 64];
    }
}
__global__ __launch_bounds__(256) void k_ln2(const bf16_t* __restrict__ YG, const int* __restrict__ SLOT, const float* __restrict__ WGT, const float* __restrict__ lw, const float* __restrict__ lb,
        float* __restrict__ X, bf16_t* __restrict__ XN) {
    const int t = blockIdx.x * 4 + (threadIdx.x >> 6), lane = threadIdx.x & 63;
    const int s0 = SLOT[t * 2], s1 = SLOT[t * 2 + 1]; const float w0 = WGT[t * 2], w1 = WGT[t * 2 + 1];
    float v[16]; float s = 0.f;
#pragma unroll
    for (int i = 0; i < 16; ++i) { const int c = i * 64 + lane;
        const float y = bf2f(YG[(size_t)s0 * D + c]) * w0 + bf2f(YG[(size_t)s1 * D + c]) * w1;
        v[i] = ALPHA * X[(size_t)t * D + c] + y; s += v[i]; }
    const float mean = wave_allsum(s) * (1.f / D);
    float q = 0.f;
#pragma unroll
    for (int i = 0; i < 16; ++i) { v[i] -= mean; q += v[i] * v[i]; }
    const float rstd = rsqrtf(wave_allsum(q) * (1.f / D) + LN_EPS);
#pragma unroll
    for (int i = 0; i < 16; ++i) { const int c = i * 64 + lane; const float o = v[i] * rstd * lw[c] + lb[c]; X[(size_t)t * D + c] = o; XN[(size_t)t * D + c] = f2bf(o); }
}

static inline int cdiv(long a, long b) { return (int)((a + b - 1) / b); }
extern "C" void kernel_launch(void* const* d_in, const int* in_sizes, int n_in, void* d_out, int out_size, void* d_ws, size_t ws_size, hipStream_t stream) {
    if (n_in != 39 || out_size != T * D || ws_size < WS_END) { fprintf(stderr, "kernel_launch: unexpected shapes n_in %d out %d ws %zu\n", n_in, out_size, ws_size); return; }
    const float* const* in = (const float* const*)d_in;
    unsigned char* ws = (unsigned char*)d_ws;
    float* X = (float*)d_out;
    auto BF = [&](size_t off) { return (bf16_t*)(ws + off); };
    auto F32 = [&](size_t off) { return (float*)(ws + off); };
    unsigned* ctl = (unsigned*)(ws + WS_CTL);
    (void)hipMemsetAsync(ws + WS_CTL, 0, CTL_BYTES, stream);
    float* LAM = F32(WS_SMALL + SM_LAM); float* BBt = F32(WS_SMALL + SM_BB); float* KM = F32(WS_SMALL + SM_KMEAN); float* RTW = F32(WS_SMALL + SM_RTW);
    int* EID = (int*)(ws + WS_ROUTE + RT_EID); int* POS = (int*)(ws + WS_ROUTE + RT_POS); int* SLOT = (int*)(ws + WS_ROUTE + RT_SLOT); float* WGT = (float*)(ws + WS_ROUTE + RT_WGT);
    k_x0<<<cdiv((long)T * D, 256), 256, 0, stream>>>(in[0], X, BF(WS_XN));
    for (int l = 0; l < DEPTH; ++l) {
        const float* w_in = in[1] + (size_t)l * D * NPROJ;
        k_cvt<<<cdiv((long)D * NPROJ, 256), 256, 0, stream>>>(w_in, NPROJ, D, NPROJ, BF(WS_WT_IN), 0, 0);
        const float* glu_w = in[21] + (size_t)l * DSS * 2 * DSS;
        k_cvt<<<cdiv((long)DSS * DSS, 256), 256, 0, stream>>>(glu_w, 2 * DSS, DSS, DSS, BF(WS_WT_GLU), 1, 0);
        k_cvt<<<cdiv((long)DSS * DSS, 256), 256, 0, stream>>>(glu_w + DSS, 2 * DSS, DSS, DSS, BF(WS_WT_GLU), 1, 128);
        k_cvt<<<cdiv((long)DR * D, 256), 256, 0, stream>>>(in[23] + (size_t)l * DR * D, D, DR, D, BF(WS_WT_UPA), 0, 0);
        k_cvt<<<cdiv((long)DR * D, 256), 256, 0, stream>>>(in[24] + (size_t)l * DR * D, D, DR, D, BF(WS_WT_UPB), 0, 0);
        k_cvt<<<cdiv((long)DR * D, 256), 256, 0, stream>>>(in[25] + (size_t)l * DR * D, D, DR, D, BF(WS_WT_UPC), 0, 0);
        k_cvt<<<cdiv((long)D * D, 256), 256, 0, stream>>>(in[27] + (size_t)l * D * D, D, D, D, BF(WS_WT_OUT), 0, 0);
        for (int e = 0; e < NE; ++e) {
            const size_t eo = ((size_t)l * NE + e) * D * DE;
            k_cvt<<<cdiv((long)D * DE, 256), 256, 0, stream>>>(in[34] + eo, DE, D, DE, BF(WS_WT_EGU) + (size_t)e * 512 * D, 1, 0);
            k_cvt<<<cdiv((long)D * DE, 256), 256, 0, stream>>>(in[35] + eo, DE, D, DE, BF(WS_WT_EGU) + (size_t)e * 512 * D, 1, 128);
            k_cvt<<<cdiv((long)D * DE, 256), 256, 0, stream>>>(in[36] + eo, D, DE, D, BF(WS_WT_ED) + (size_t)e * D * DE, 0, 0);
        }
        k_rtw<<<cdiv(36 * 1024, 256), 256, 0, stream>>>(in[30] + (size_t)l * D * 4, in[32] + (size_t)l * D * 32, RTW);
        k_s5tab<<<cdiv(NGR * SST, 256), 256, 0, stream>>>(in[13] + (size_t)l * NGR * SST, in[14] + (size_t)l * NGR * SST, in[15] + (size_t)l * NGR * SST * SGRP,
                                                        in[16] + (size_t)l * NGR * SST * SGRP, in[20] + (size_t)l * NGR, LAM, BBt);
        { EProj E; E.P = BF(WS_PROJ); k_gemm<EProj, false><<<dim3(NPROJ / 64, T / 64), 256, 0, stream>>>(BF(WS_XN), BF(WS_WT_IN), D, E); }
        k_prep<<<T, 512, 0, stream>>>(BF(WS_PROJ), in[2] + (size_t)l * 1792, in[3] + (size_t)l * DR, in[4] + (size_t)l * 64 * DR, in[5] + (size_t)l * DR, in[6] + (size_t)l * 64 * DR,
                                      in[7] + (size_t)l * 128 * DR, in[8] + (size_t)l * DR, in[9] + (size_t)l * DR, BF(WS_R), BF(WS_KP), BF(WS_V), BF(WS_KK), BF(WS_AA), BF(WS_GG), F32(WS_LW));
        k_kmean<<<cdiv(NB * MH * NBLK * HD, 256), 256, 0, stream>>>(BF(WS_PROJ), KM);
        k_wkv<<<NB * RH * 64 / 4, 256, 0, stream>>>(BF(WS_R), BF(WS_KP), BF(WS_V), BF(WS_KK), BF(WS_AA), F32(WS_LW), F32(WS_YRAW));
        k_moba<<<T * MH / 4, 256, 0, stream>>>(BF(WS_PROJ), KM, BF(WS_YB));
        k_s5<<<NB * NGR, 64, 0, stream>>>(BF(WS_PROJ), LAM, BBt, in[17] + (size_t)l * NGR * SGRP * SST, in[18] + (size_t)l * NGR * SGRP * SST, in[19] + (size_t)l * DSS, BF(WS_YCPRE));
        k_wkvpost<<<T, 512, 0, stream>>>(F32(WS_YRAW), BF(WS_R), BF(WS_KP), BF(WS_V), BF(WS_GG), in[10] + (size_t)l * DR, in[11] + (size_t)l * DR, in[12] + (size_t)l * DR, BF(WS_YA));
        { EGlu E; E.YC = BF(WS_YC); E.bias = in[22] + (size_t)l * 2 * DSS; k_gemm<EGlu, true><<<dim3(DSS / 64, T / 64), 256, 0, stream>>>(BF(WS_YCPRE), BF(WS_WT_GLU), DSS, E); }
        for (int br = 0; br < 3; ++br) {
            EUp E; E.P = BF(WS_PROJ); E.gate_b = in[26] + (size_t)l * 3 * D; E.M = F32(WS_MERGED); E.MB = BF(WS_MERGEDB); E.br = br;
            k_gemm<EUp, false><<<dim3(D / 64, T / 64), 256, 0, stream>>>(BF(br == 0 ? WS_YA : br == 1 ? WS_YB : WS_YC), BF(br == 0 ? WS_WT_UPA : br == 1 ? WS_WT_UPB : WS_WT_UPC), DR, E);
        }
        { EOut E; E.X = X; E.S = F32(WS_S); k_gemm<EOut, false><<<dim3(D / 64, T / 64), 256, 0, stream>>>(BF(WS_MERGEDB), BF(WS_WT_OUT), D, E); }
        unsigned* cnt = ctl + CW_CNT + l * 64;
        k_ln1route<<<T / 4, 256, 0, stream>>>(F32(WS_S), in[28] + (size_t)l * D, in[29] + (size_t)l * D, X, BF(WS_XN), RTW, in[31] + (size_t)l * 4, in[33] + (size_t)l * 32, cnt, EID, POS, WGT);
        k_gather<<<T / 4, 256, 0, stream>>>(BF(WS_XN), cnt, EID, POS, SLOT, BF(WS_XG));
        { ESwi E; E.cnt = cnt; E.rows_per_e = 512; E.HID = BF(WS_HID); k_gemm<ESwi, true><<<dim3(DE / 64, MAXSLOT / 64), 256, 0, stream>>>(BF(WS_XG), BF(WS_WT_EGU), D, E); }
        { EDown E; E.cnt = cnt; E.rows_per_e = D; E.YG = BF(WS_YG); k_gemm<EDown, false><<<dim3(D / 64, MAXSLOT / 64), 256, 0, stream>>>(BF(WS_HID), BF(WS_WT_ED), DE, E); }
        k_ln2<<<T / 4, 256, 0, stream>>>(BF(WS_YG), SLOT, WGT, in[37] + (size_t)l * D, in[38] + (size_t)l * D, X, BF(WS_XN));
    }
}
```

```cpp
#include <hip/hip_runtime.h>
#include <cstdio>
#include <cstdint>
#include <cmath>

typedef unsigned short bf16_t;
typedef short bf16x8 __attribute__((ext_vector_type(8)));
typedef float f32x4 __attribute__((ext_vector_type(4)));

constexpr int NB = 4, SEQ = 4096, T = NB * SEQ, D = 1024, DEPTH = 4, HD = 64;
constexpr int DR = 512, RH = 8, DMO = 512, MH = 8, DSS = 512, SGRP = 16, NGR = 32, SST = 64;
constexpr int OFF_MOBA = 1792, OFF_SSM = 3328, OFF_GATE = 3840, NPROJ = 6912;
constexpr int MBLK = 256, NBLK = SEQ / MBLK;
constexpr int NE = 32, EPG = 8, NGRP = 4, DE = 256;
constexpr int MAXSLOT = 40960;
constexpr float LN_EPS = 1e-5f, GN_EPS = 64e-5f;
constexpr float ALPHA = 1.6817928305074290f;

constexpr size_t MiB = 1u << 20;
constexpr size_t WS_CTL = 0, CTL_BYTES = 1 * MiB;
constexpr size_t WS_SMALL = 1 * MiB;
constexpr size_t WS_WT_IN = 4 * MiB, WS_WT_GLU = 18 * MiB, WS_WT_UPA = 19 * MiB, WS_WT_UPB = 20 * MiB, WS_WT_UPC = 21 * MiB,
                 WS_WT_OUT = 22 * MiB, WS_WT_EGU = 24 * MiB, WS_WT_ED = 56 * MiB;
constexpr size_t WS_PROJ = 72 * MiB;
constexpr size_t WS_XN = 288 * MiB;
constexpr size_t WS_R = 320 * MiB, WS_KP = 336 * MiB, WS_V = 352 * MiB, WS_KK = 368 * MiB, WS_AA = 384 * MiB, WS_GG = 400 * MiB;
constexpr size_t WS_LW = 416 * MiB;
constexpr size_t WS_YRAW = 448 * MiB;
constexpr size_t WS_YA = 480 * MiB, WS_YB = 496 * MiB, WS_YC = 512 * MiB, WS_YCPRE = 528 * MiB;
constexpr size_t WS_ROUTE = 544 * MiB;
constexpr size_t WS_END = 548 * MiB;
constexpr size_t WS_MERGED = 320 * MiB;
constexpr size_t WS_MERGEDB = 384 * MiB;
constexpr size_t WS_S = 416 * MiB;
constexpr size_t WS_XG = 72 * MiB;
constexpr size_t WS_HID = 152 * MiB;
constexpr size_t WS_YG = 172 * MiB;
constexpr size_t SM_LAM = 0;
constexpr size_t SM_BB = 16384;
constexpr size_t SM_KMEAN = 16384 + 262144;
constexpr size_t SM_RTW = SM_KMEAN + 131072;
constexpr size_t RT_EID = 0, RT_POS = 131072, RT_SLOT = 262144, RT_WGT = 393216;
constexpr int CW_CNT = 1024;

__device__ __forceinline__ float bf2f(bf16_t h) { return __uint_as_float(((unsigned)h) << 16); }
__device__ __forceinline__ bf16_t f2bf(float f) { unsigned u = __float_as_uint(f); return (bf16_t)((u + 0x7fffu + ((u >> 16) & 1u)) >> 16); }
__device__ __forceinline__ float wave_allsum(float v) {
#pragma unroll
    for (int o = 1; o < 64; o <<= 1) v += __shfl_xor(v, o);
    return v;
}
__device__ __forceinline__ float sigmoidf_(float x) { return 1.f / (1.f + __expf(-x)); }
__device__ __forceinline__ float gelu_tanh(float x) { const float u = 0.7978845608028654f * (x + 0.044715f * x * x * x); return 0.5f * x * (1.f + tanhf(u)); }

__device__ __forceinline__ void k_cvt(int vb, int vt, const float* __restrict__ W, int ldw, int K, int Nsub, bf16_t* __restrict__ WT, int interleave, int row_off) {
    const long i = (long)vb * 256 + vt;
    if (i >= (long)K * Nsub) return;
    const int n = (int)(i / K), k = (int)(i % K);
    const int dr = interleave ? ((n >> 7) * 256 + (n & 127) + row_off) : (n + row_off);
    WT[(size_t)dr * K + k] = f2bf(W[(size_t)k * ldw + n]);
}
__device__ __forceinline__ void k_rtw(int vb, int vt, const float* __restrict__ gw, const float* __restrict__ ew, float* __restrict__ RTW) {
    const int i = vb * 256 + vt;
    if (i >= 36 * 1024) return;
    const int j = i / 1024, k = i % 1024;
    RTW[i] = j < 4 ? gw[k * 4 + j] : ew[k * 32 + (j - 4)];
}
__device__ __forceinline__ void k_s5tab(int vb, int vt, const float* __restrict__ a_re, const float* __restrict__ a_im, const float* __restrict__ b_re, const float* __restrict__ b_im,
                        const float* __restrict__ log_dt, float* __restrict__ LAM, float* __restrict__ BB) {
    const int i = vb * 256 + vt;
    if (i >= NGR * SST) return;
    const int g = i / SST;
    const float dt = expf(log_dt[g]);
    const float are = a_re[i], aim = a_im[i];
    const float mag = expf(are * dt);
    const float ang = aim * dt;
    const float lre = mag * cosf(ang), lim = mag * sinf(ang);
    const float den = are * are + aim * aim, nr = lre - 1.0f;
    const float cre = (nr * are + lim * aim) / den, cim = (lim * are - nr * aim) / den;
    LAM[i * 2] = lre; LAM[i * 2 + 1] = lim;
    for (int h = 0; h < SGRP; ++h) {
        const float bre = b_re[i * SGRP + h], bim = b_im[i * SGRP + h];
        BB[(i * SGRP + h) * 2] = cre * bre - cim * bim;
        BB[(i * SGRP + h) * 2 + 1] = cre * bim + cim * bre;
    }
}
__device__ __forceinline__ void k_x0(int vb, int vt, const float* __restrict__ x, float* __restrict__ X, bf16_t* __restrict__ XN) {
    const long i = (long)vb * 256 + vt;
    if (i >= (long)T * D) return;
    const float v = x[i]; X[i] = v; XN[i] = f2bf(v);
}

template <class Epi, bool PAIR>
__device__ __forceinline__ void k_gemm(int vbx, int vby, int vt, const bf16_t* __restrict__ A, const bf16_t* __restrict__ Bt, int K, Epi E) {
    const int wave = vt >> 6, lane = vt & 63, fr = lane & 15, fq = lane >> 4;
    const int rt = vby;
    if (!E.active(rt)) return;
    const bf16_t* B2 = Bt + E.bt_off(rt);
    const int row0 = rt * 64 + (wave >> 1) * 32;
    int colA, colB = 0, ch0 = 0;
    if (PAIR) { ch0 = vbx * 64 + (wave & 1) * 32; colA = (ch0 >> 7) * 256 + (ch0 & 127); colB = colA + 128; }
    else colA = vbx * 64 + (wave & 1) * 32;
    f32x4 acc[2][2], acc2[2][2];
#pragma unroll
    for (int i = 0; i < 2; ++i)
#pragma unroll
        for (int j = 0; j < 2; ++j) { acc[i][j] = (f32x4){0.f, 0.f, 0.f, 0.f}; acc2[i][j] = (f32x4){0.f, 0.f, 0.f, 0.f}; }
    for (int k0 = 0; k0 < K; k0 += 32) {
        bf16x8 a[2], b[2], b2[2];
#pragma unroll
        for (int i = 0; i < 2; ++i) a[i] = *(const bf16x8*)(A + (size_t)(row0 + i * 16 + fr) * K + k0 + fq * 8);
#pragma unroll
        for (int j = 0; j < 2; ++j) b[j] = *(const bf16x8*)(B2 + (size_t)(colA + j * 16 + fr) * K + k0 + fq * 8);
        if (PAIR) {
#pragma unroll
            for (int j = 0; j < 2; ++j) b2[j] = *(const bf16x8*)(B2 + (size_t)(colB + j * 16 + fr) * K + k0 + fq * 8);
        }
#pragma unroll
        for (int i = 0; i < 2; ++i)
#pragma unroll
            for (int j = 0; j < 2; ++j) {
                acc[i][j] = __builtin_amdgcn_mfma_f32_16x16x32_bf16(a[i], b[j], acc[i][j], 0, 0, 0);
                if (PAIR) acc2[i][j] = __builtin_amdgcn_mfma_f32_16x16x32_bf16(a[i], b2[j], acc2[i][j], 0, 0, 0);
            }
    }
#pragma unroll
    for (int i = 0; i < 2; ++i)
#pragma unroll
        for (int j = 0; j < 2; ++j)
#pragma unroll
            for (int r = 0; r < 4; ++r) {
                const int row = row0 + i * 16 + fq * 4 + r;
                if (PAIR) E.store2(row, ch0 + j * 16 + fr, acc[i][j][r], acc2[i][j][r]);
                else E.store(row, colA + j * 16 + fr, acc[i][j][r]);
            }
}
struct EDense { __device__ bool active(int) const { return true; } __device__ size_t bt_off(int) const { return 0; } };
struct EProj : EDense { bf16_t* P; __device__ void store(int r, int c, float v) const { P[(size_t)r * NPROJ + c] = f2bf(v); } __device__ void store2(int, int, float, float) const {} };
struct EGlu : EDense { bf16_t* YC; const float* bias;
    __device__ void store(int, int, float) const {}
    __device__ void store2(int r, int ch, float v, float g) const { YC[(size_t)r * DSS + ch] = f2bf((v + bias[ch]) * sigmoidf_(g + bias[DSS + ch])); } };
struct EUp : EDense { const bf16_t* P; const float* gate_b; float* M; bf16_t* MB; int br;
    __device__ void store2(int, int, float, float) const {}
    __device__ void store(int r, int c, float v) const {
        const float gl = bf2f(P[(size_t)r * NPROJ + OFF_GATE + br * D + c]) + gate_b[br * D + c];
        float m = sigmoidf_(gl) * v; const size_t o = (size_t)r * D + c;
        if (br > 0) m += M[o];
        M[o] = m; if (br == 2) MB[o] = f2bf(m); } };
struct EOut : EDense { const float* X; float* S;
    __device__ void store2(int, int, float, float) const {}
    __device__ void store(int r, int c, float v) const { const size_t o = (size_t)r * D + c; S[o] = ALPHA * X[o] + v; } };
struct EGrouped { const unsigned* cnt; int rows_per_e;
    __device__ int expert_of(int rt, bool& ok) const {
        int off = 0; const int r0 = rt * 64;
        for (int e = 0; e < NE; ++e) { const int p = ((int)cnt[e] + 255) & ~255; if (r0 < off + p) { ok = true; return e; } off += p; }
        ok = false; return 0; }
    __device__ bool active(int rt) const { bool ok; expert_of(rt, ok); return ok; }
};
struct ESwi : EGrouped { bf16_t* HID;
    __device__ size_t bt_off(int rt) const { bool ok; const int e = expert_of(rt, ok); return (size_t)e * 512 * D; }
    __device__ void store(int, int, float) const {}
    __device__ void store2(int r, int ch, float g, float u) const { HID[(size_t)r * DE + ch] = f2bf(g * sigmoidf_(g) * u); } };
struct EDown : EGrouped { bf16_t* YG;
    __device__ size_t bt_off(int rt) const { bool ok; const int e = expert_of(rt, ok); return (size_t)e * D * DE; }
    __device__ void store2(int, int, float, float) const {}
    __device__ void store(int r, int c, float v) const { YG[(size_t)r * D + c] = f2bf(v); } };

__device__ __forceinline__ void k_prep(int vb, int vt, const bf16_t* __restrict__ P, const float* __restrict__ mu, const float* __restrict__ w0, const float* __restrict__ w2,
        const float* __restrict__ a0, const float* __restrict__ a2, const float* __restrict__ g2, const float* __restrict__ k_k, const float* __restrict__ k_a,
        bf16_t* R, bf16_t* KP, bf16_t* V, bf16_t* KK, bf16_t* AA, bf16_t* GG, float* LW) {
    __shared__ float act[256];
    const int t = vb, c = vt;
    const bool first = (t % SEQ) == 0;
    const bf16_t* row = P + (size_t)t * NPROJ; const bf16_t* prow = row - NPROJ;
    auto zs = [&](int col) -> float { const float z = bf2f(row[col]); const float zp = first ? 0.f : bf2f(prow[col]); return z + (zp - z) * mu[col]; };
    if (c < 256) { const float z = zs(1536 + c); act[c] = c < 64 ? tanhf(z) : (c < 128 ? z : sigmoidf_(z)); }
    __syncthreads();
    const float r = zs(c), k = zs(512 + c), v = zs(1024 + c);
    float sw = 0.f, sa = 0.f, sg = 0.f;
#pragma unroll 4
    for (int i = 0; i < 64; ++i) { sw += act[i] * w2[i * DR + c]; sa += act[64 + i] * a2[i * DR + c]; }
#pragma unroll 4
    for (int i = 0; i < 128; ++i) sg += act[128 + i] * g2[i * DR + c];
    const float xx = -(w0[c] + sw);
    const float sp = fmaxf(xx, 0.f) + log1pf(expf(-fabsf(xx)));
    const float wl = -sp - 0.5f;
    const float lw = -expf(wl);
    const float a = sigmoidf_(a0[c] + sa);
    const float kk = k * k_k[c];
    const float ss = wave_allsum(kk * kk);
    const float kkn = kk * rsqrtf(fmaxf(ss, 1e-24f));
    const float kp = k * (1.f + (a - 1.f) * k_a[c]);
    const size_t o = (size_t)t * DR + c;
    R[o] = f2bf(r); KP[o] = f2bf(kp); V[o] = f2bf(v); KK[o] = f2bf(kkn); AA[o] = f2bf(a); GG[o] = f2bf(sg); LW[o] = lw;
    __syncthreads();
}
__device__ __forceinline__ void k_wkv(int vb, int vt, const bf16_t* __restrict__ R, const bf16_t* __restrict__ KP, const bf16_t* __restrict__ V, const bf16_t* __restrict__ KK,
        const bf16_t* __restrict__ AA, const float* __restrict__ LW, float* __restrict__ YRAW) {
    const int gwv = vb * 4 + (vt >> 6), j = vt & 63;
    const int i = gwv & 63, h = (gwv >> 6) & 7, b = gwv >> 9;
    float S = 0.f;
    for (int t = 0; t < SEQ; ++t) {
        const size_t o = (size_t)(b * SEQ + t) * DR + h * 64;
        const float r = bf2f(R[o + j]), w = __expf(LW[o + j]), k = bf2f(KP[o + j]), kk = bf2f(KK[o + j]), a = bf2f(AA[o + j]), v = bf2f(V[o + i]);
        const float sa = wave_allsum(S * (-kk));
        S = S * w + sa * (kk * a) + v * k;
        const float y = wave_allsum(S * r);
        if (j == 0) YRAW[o + i] = y;
    }
}
__device__ __forceinline__ void k_wkvpost(int vb, int vt, const float* __restrict__ YRAW, const bf16_t* __restrict__ R, const bf16_t* __restrict__ KP, const bf16_t* __restrict__ V,
        const bf16_t* __restrict__ GG, const float* __restrict__ r_k, const float* __restrict__ ln_w, const float* __restrict__ ln_b, bf16_t* __restrict__ YA) {
    const int t = vb, c = vt; const size_t o = (size_t)t * DR + c;
    const float y = YRAW[o];
    const float mean = wave_allsum(y) * (1.f / 64.f);
    const float dv = y - mean;
    const float var = wave_allsum(dv * dv) * (1.f / 64.f);
    const float yn = dv * rsqrtf(var + GN_EPS) * ln_w[c] + ln_b[c];
    const float bonus = wave_allsum(bf2f(R[o]) * bf2f(KP[o]) * r_k[c]) * bf2f(V[o]);
    YA[o] = f2bf((yn + bonus) * bf2f(GG[o]));
}
__device__ __forceinline__ void k_kmean(int vb, int vt, const bf16_t* __restrict__ P, float* __restrict__ KM) {
    const int i = vb * 256 + vt;
    if (i >= NB * MH * NBLK * HD) return;
    const int d = i & 63, n = (i >> 6) & 15, h = (i >> 10) & 7, b = i >> 13;
    float s = 0.f;
    for (int q = 0; q < MBLK; ++q) s += bf2f(P[(size_t)(b * SEQ + n * MBLK + q) * NPROJ + OFF_MOBA + 512 + h * 64 + d]);
    KM[i] = s * (1.f / MBLK);
}
__device__ __forceinline__ void k_moba(int vb, int vt, const bf16_t* __restrict__ P, const float* __restrict__ KM, bf16_t* __restrict__ YB) {
    const int gwv = vb * 4 + (vt >> 6), lane = vt & 63;
    const int h = gwv & 7, tt = gwv >> 3;
    const int b = tt / SEQ, tpos = tt % SEQ, blk = tpos / MBLK;
    const float slope = exp2f(-(float)(h + 1));
    const bf16_t* qrow = P + (size_t)tt * NPROJ + OFF_MOBA + h * 64;
    const float qd = bf2f(qrow[lane]) * 0.125f;
    float q[64];
#pragma unroll
    for (int d = 0; d < 64; ++d) q[d] = __shfl(qd, d);
    int sel[3] = {-1, -1, -1};
    {
        float gate[16];
#pragma unroll
        for (int n = 0; n < 16; ++n) { const float km = KM[((b * MH + h) * NBLK + n) * HD + lane]; gate[n] = wave_allsum(qd * km); }
#pragma unroll
        for (int s = 0; s < 3; ++s) {
            int best = -1; float bv = 0.f;
#pragma unroll
            for (int n = 0; n < 16; ++n) { const bool ok = n < blk && n != sel[0] && n != sel[1]; if (ok && (best < 0 || gate[n] > bv)) { best = n; bv = gate[n]; } }
            sel[s] = best;
        }
    }
    float m = -INFINITY, l = 0.f, o = 0.f;
    for (int s = 0; s < 4; ++s) {
        const int n = s < 3 ? sel[s] : blk;
        if (n < 0) continue;
        for (int c0 = 0; c0 < MBLK; c0 += 64) {
            const int sp = n * MBLK + c0 + lane;
            const bool valid = sp <= tpos;
            if (n * MBLK + c0 > tpos) break;
            const bf16_t* krow = P + (size_t)(b * SEQ + sp) * NPROJ + OFF_MOBA + 512 + h * 64;
            float sc = 0.f;
#pragma unroll
            for (int d8 = 0; d8 < 8; ++d8) { const bf16x8 kv = *(const bf16x8*)(krow + d8 * 8);
#pragma unroll
                for (int e = 0; e < 8; ++e) sc += q[d8 * 8 + e] * bf2f((bf16_t)kv[e]); }
            sc -= slope * (float)(tpos - sp);
            if (!valid) sc = -INFINITY;
            float mx = sc;
#pragma unroll
            for (int of = 1; of < 64; of <<= 1) mx = fmaxf(mx, __shfl_xor(mx, of));
            const float mn = fmaxf(m, mx);
            const float scale = __expf(m - mn);
            const float p = valid ? __expf(sc - mn) : 0.f;
            l = l * scale + wave_allsum(p);
            o *= scale;
            const bf16_t* vbase = P + (size_t)(b * SEQ + n * MBLK + c0) * NPROJ + OFF_MOBA + 1024 + h * 64 + lane;
            for (int e = 0; e < 64; ++e) { const float pe = __shfl(p, e); o += pe * bf2f(vbase[(size_t)e * NPROJ]); }
            m = mn;
        }
    }
    YB[(size_t)tt * DMO + h * 64 + lane] = f2bf(o / l);
}
__device__ __forceinline__ void k_s5(int vb, int vt, const bf16_t* __restrict__ P, const float* __restrict__ LAM, const float* __restrict__ BB, const float* __restrict__ c_re,
        const float* __restrict__ c_im, const float* __restrict__ dvec, bf16_t* __restrict__ YCPRE) {
    const int b = vb / NGR, g = vb % NGR, p = vt;
    const float lre = LAM[(g * SST + p) * 2], lim = LAM[(g * SST + p) * 2 + 1];
    float bre[16], bim[16], cre[16], cim[16], dd[16];
#pragma unroll
    for (int h = 0; h < 16; ++h) { bre[h] = BB[((g * SST + p) * 16 + h) * 2]; bim[h] = BB[((g * SST + p) * 16 + h) * 2 + 1];
        cre[h] = c_re[(g * 16 + h) * SST + p]; cim[h] = c_im[(g * 16 + h) * SST + p]; dd[h] = dvec[g * 16 + h]; }
    float hre = 0.f, him = 0.f;
    for (int t = 0; t < SEQ; ++t) {
        const bf16_t* ur = P + (size_t)(b * SEQ + t) * NPROJ + OFF_SSM + g * 16;
        float u[16];
#pragma unroll
        for (int h = 0; h < 16; ++h) u[h] = bf2f(ur[h]);
        float bur = 0.f, bui = 0.f;
#pragma unroll
        for (int h = 0; h < 16; ++h) { bur += bre[h] * u[h]; bui += bim[h] * u[h]; }
        const float nre = lre * hre - lim * him + bur, nim = lre * him + lim * hre + bui;
        hre = nre; him = nim;
        float myy = 0.f;
#pragma unroll
        for (int h = 0; h < 16; ++h) { const float y = wave_allsum(cre[h] * hre - cim[h] * him) + dd[h] * u[h]; if (p == h) myy = y; }
        if (p < 16) YCPRE[(size_t)(b * SEQ + t) * DSS + g * 16 + p] = f2bf(gelu_tanh(myy));
    }
}
__device__ __forceinline__ void k_ln1route(int vb, int vt, const float* __restrict__ S, const float* __restrict__ lw, const float* __restrict__ lb, float* __restrict__ X, bf16_t* __restrict__ XN,
        const float* __restrict__ RTW, const float* __restrict__ gb, const float* __restrict__ eb, unsigned* __restrict__ cnt,
        int* __restrict__ EID, int* __restrict__ POS, float* __restrict__ WGT) {
    const int t = vb * 4 + (vt >> 6), lane = vt & 63;
    float v[16]; float s = 0.f;
#pragma unroll
    for (int i = 0; i < 16; ++i) { v[i] = S[(size_t)t * D + i * 64 + lane]; s += v[i]; }
    const float mean = wave_allsum(s) * (1.f / D);
    float q = 0.f;
#pragma unroll
    for (int i = 0; i < 16; ++i) { v[i] -= mean; q += v[i] * v[i]; }
    const float rstd = rsqrtf(wave_allsum(q) * (1.f / D) + LN_EPS);
#pragma unroll
    for (int i = 0; i < 16; ++i) { const int c = i * 64 + lane; v[i] = v[i] * rstd * lw[c] + lb[c]; X[(size_t)t * D + c] = v[i]; XN[(size_t)t * D + c] = f2bf(v[i]); }
    __shared__ float rlog[8][40];
    float* lg = rlog[threadIdx.x >> 6];
    for (int j = 0; j < 36; ++j) { float a = 0.f;
#pragma unroll
        for (int i = 0; i < 16; ++i) a += v[i] * RTW[j * 1024 + i * 64 + lane];
        a = wave_allsum(a); if (lane == 0) lg[j] = a; }
    if (lane == 0) {
        int gs = 0; float gm = lg[0] + gb[0];
        for (int j = 1; j < 4; ++j) { const float x = lg[j] + gb[j]; if (x > gm) { gm = x; gs = j; } }
        float den = 0.f;
        for (int j = 0; j < 4; ++j) den += __expf(lg[j] + gb[j] - gm);
        const float pg = 1.f / den;
        int i0 = 0; float m0 = lg[4 + gs * 8] + eb[gs * 8];
        for (int j = 1; j < 8; ++j) { const float x = lg[4 + gs * 8 + j] + eb[gs * 8 + j]; if (x > m0) { m0 = x; i0 = j; } }
        int i1 = -1; float m1 = 0.f;
        for (int j = 0; j < 8; ++j) { const float x = lg[4 + gs * 8 + j] + eb[gs * 8 + j]; if (j != i0 && (i1 < 0 || x > m1)) { m1 = x; i1 = j; } }
        const float e1 = __expf(m1 - m0);
        const float p0 = 1.f / (1.f + e1), p1 = e1 / (1.f + e1);
        const int ex0 = gs * 8 + i0, ex1 = gs * 8 + i1;
        EID[t * 2] = ex0; EID[t * 2 + 1] = ex1;
        WGT[t * 2] = pg * p0; WGT[t * 2 + 1] = pg * p1;
        POS[t * 2] = (int)atomicAdd(&cnt[ex0], 1u);
        POS[t * 2 + 1] = (int)atomicAdd(&cnt[ex1], 1u);
    }
}
__device__ __forceinline__ void k_gather(int vb, int vt, const bf16_t* __restrict__ XN, const unsigned* __restrict__ cnt, const int* __restrict__ EID, const int* __restrict__ POS,
        int* __restrict__ SLOT, bf16_t* __restrict__ XG) {
    const int t = vb * 4 + (vt >> 6), lane = vt & 63;
    for (int k = 0; k < 2; ++k) {
        const int e = EID[t * 2 + k]; int off = 0;
        for (int j = 0; j < e; ++j) off += ((int)cnt[j] + 255) & ~255;
        const int slot = off + POS[t * 2 + k];
        if (lane == 0) SLOT[t * 2 + k] = slot;
        const uint4* src = (const uint4*)(XN + (size_t)t * D); uint4* dst = (uint4*)(XG + (size_t)slot * D);
        dst[lane] = src[lane]; dst[lane + 64] = src[lane + 64];
    }
}
__device__ __forceinline__ void k_ln2(int vb, int vt, const bf16_t* __restrict__ YG, const int* __restrict__ SLOT, const float* __restrict__ WGT, const float* __restrict__ lw, const float* __restrict__ lb,
        float* __restrict__ X, bf16_t* __restrict__ XN) {
    const int t = vb * 4 + (vt >> 6), lane = vt & 63;
    const int s0 = SLOT[t * 2], s1 = SLOT[t * 2 + 1]; const float w0 = WGT[t * 2], w1 = WGT[t * 2 + 1];
    float v[16]; float s = 0.f;
#pragma unroll
    for (int i = 0; i < 16; ++i) { const int c = i * 64 + lane;
        const float y = bf2f(YG[(size_t)s0 * D + c]) * w0 + bf2f(YG[(size_t)s1 * D + c]) * w1;
        v[i] = ALPHA * X[(size_t)t * D + c] + y; s += v[i]; }
    const float mean = wave_allsum(s) * (1.f / D);
    float q = 0.f;
#pragma unroll
    for (int i = 0; i < 16; ++i) { v[i] -= mean; q += v[i] * v[i]; }
    const float rstd = rsqrtf(wave_allsum(q) * (1.f / D) + LN_EPS);
#pragma unroll
    for (int i = 0; i < 16; ++i) { const int c = i * 64 + lane; const float o = v[i] * rstd * lw[c] + lb[c]; X[(size_t)t * D + c] = o; XN[(size_t)t * D + c] = f2bf(o); }
}

#define LAS __attribute__((address_space(3)))
#define XB_TMO      128
#define XB_XCNT(j)  (256  + 64 * (j))
#define XB_XSUB(j)  (1280 + 64 * (j))
#define XB_XGEN(j)  (2304 + 64 * (j))
#define XB_TOP      3328
#define XB_TOPGEN   3392
#define XCD_BAR_WORDS 3456
#define XB_SPIN_CAP (1u << 18)
__device__ __forceinline__ unsigned xb_ld(unsigned* p)              { return __hip_atomic_load(p, __ATOMIC_RELAXED, __HIP_MEMORY_SCOPE_AGENT); }
__device__ __forceinline__ unsigned xb_add(unsigned* p, unsigned v) { return __hip_atomic_fetch_add(p, v, __ATOMIC_RELAXED, __HIP_MEMORY_SCOPE_AGENT); }
__device__ __forceinline__ unsigned xb_xcc_id() { return (unsigned)__builtin_amdgcn_s_getreg((3 << 11) | 20) & 0xFu; }
#define XB_SPIN(cond, bar) do { unsigned _sp = 0; while (cond) { __builtin_amdgcn_s_sleep(1); \
    if ((++_sp & 255u) == 0u) { if (xb_ld(&(bar)[XB_TMO])) break; if (_sp > XB_SPIN_CAP) { atomicAdd(&(bar)[XB_TMO], 1u); break; } } } } while (0)
struct XcdBarrier { unsigned* bar; unsigned x; volatile LAS unsigned* st; };
__device__ __forceinline__ XcdBarrier xcd_barrier_post(unsigned* bar, volatile LAS unsigned* st) {
    XcdBarrier b; b.bar = bar; b.x = xb_xcc_id(); b.st = st;
    if (threadIdx.x == 0) (void)xb_add(&bar[XB_XCNT(b.x)], 1u);
    return b;
}
__device__ __forceinline__ void xcd_barrier_complete(unsigned* bar, unsigned x, unsigned& nloc, unsigned& nx) {
    const unsigned G = gridDim.x * gridDim.y * gridDim.z;
    unsigned sum, cnt, mine, sp = 0u;
    for (;;) {
        sum = 0u; cnt = 0u; mine = 0u;
#pragma unroll
        for (unsigned j = 0; j < 16; ++j) { const unsigned c = xb_ld(&bar[XB_XCNT(j)]); sum += c; cnt += (c > 0u) ? 1u : 0u; mine = (j == x) ? c : mine; }
        if (sum == G) break;
        __builtin_amdgcn_s_sleep(1);
        if ((++sp & 255u) == 0u) { if (xb_ld(&bar[XB_TMO])) break; if (sp > XB_SPIN_CAP) { atomicAdd(&bar[XB_TMO], 1u); break; } }
    }
    nloc = mine > 0u ? mine : 1u; nx = cnt > 0u ? cnt : 1u;
}
__device__ __forceinline__ void xcd_barrier(const XcdBarrier& b) {
    asm volatile("s_waitcnt vmcnt(0)" ::: "memory");
    __syncthreads();
    if (threadIdx.x == 0) {
        unsigned* bar = b.bar;
        __builtin_amdgcn_s_waitcnt(0);
        unsigned nloc = b.st[0], nx = b.st[1];
        if (nloc == 0u) { xcd_barrier_complete(bar, b.x, nloc, nx); b.st[0] = nloc; b.st[1] = nx; }
        const unsigned old = xb_add(&bar[XB_XSUB(b.x)], 1u);
        const unsigned gen = old / nloc;
        if (old + 1u == (gen + 1u) * nloc) {
            __builtin_amdgcn_fence(__ATOMIC_RELEASE, "agent");
            asm volatile("s_waitcnt vmcnt(0)" ::: "memory");
            const unsigned og = xb_add(&bar[XB_TOP], 1u);
            const unsigned tg = og / nx;
            if (og + 1u == (tg + 1u) * nx) xb_add(&bar[XB_TOPGEN], 1u);
            else XB_SPIN(xb_ld(&bar[XB_TOPGEN]) == tg, bar);
            __builtin_amdgcn_fence(__ATOMIC_ACQUIRE, "agent");
            xb_add(&bar[XB_XGEN(b.x)], 1u);
            asm volatile("s_waitcnt vmcnt(0)" ::: "memory");
        } else {
            XB_SPIN(xb_ld(&bar[XB_XGEN(b.x)]) == gen, bar);
            __builtin_amdgcn_fence(__ATOMIC_ACQUIRE, "agent");
            asm volatile("s_waitcnt vmcnt(0)" ::: "memory");
        }
    }
    __syncthreads();
}
constexpr int CW_BAR = 4096;

struct Args { const float* in[39]; float* out; unsigned char* ws; };
__device__ __forceinline__ int otid() { int t = threadIdx.x; asm volatile("" : "+v"(t)); return t; }
#define VBL(nvb, vbsz) for (int _t = otid(), vb = (int)blockIdx.x * (512 / (vbsz)) + _t / (vbsz), vt = _t % (vbsz); vb < (nvb); vb += (int)gridDim.x * (512 / (vbsz)))
#define VBL2(nx, ny) for (int _t = otid(), vq = (int)blockIdx.x * 2 + _t / 256, vt = _t % 256; vq < (nx) * (ny); vq += (int)gridDim.x * 2)

__device__ __forceinline__ void phase_weights(const Args& a, int l) {
    unsigned char* ws = a.ws; const float* const* in = a.in;
    auto BF = [&](size_t off) { return (bf16_t*)(ws + off); };
    auto F32 = [&](size_t off) { return (float*)(ws + off); };
    { const float* w_in = in[1] + (size_t)l * D * NPROJ; VBL(D * NPROJ / 256, 256) k_cvt(vb, vt, w_in, NPROJ, D, NPROJ, BF(WS_WT_IN), 0, 0); }
    { const float* glu_w = in[21] + (size_t)l * DSS * 2 * DSS;
      VBL(DSS * DSS / 256, 256) { k_cvt(vb, vt, glu_w, 2 * DSS, DSS, DSS, BF(WS_WT_GLU), 1, 0); k_cvt(vb, vt, glu_w + DSS, 2 * DSS, DSS, DSS, BF(WS_WT_GLU), 1, 128); } }
    VBL(DR * D / 256, 256) { k_cvt(vb, vt, in[23] + (size_t)l * DR * D, D, DR, D, BF(WS_WT_UPA), 0, 0); k_cvt(vb, vt, in[24] + (size_t)l * DR * D, D, DR, D, BF(WS_WT_UPB), 0, 0);
                             k_cvt(vb, vt, in[25] + (size_t)l * DR * D, D, DR, D, BF(WS_WT_UPC), 0, 0); }
    VBL(D * D / 256, 256) k_cvt(vb, vt, in[27] + (size_t)l * D * D, D, D, D, BF(WS_WT_OUT), 0, 0);
    VBL(NE * (D * DE / 256), 256) { const int e = vb / (D * DE / 256), v2 = vb % (D * DE / 256); const size_t eo = ((size_t)l * NE + e) * D * DE;
        k_cvt(v2, vt, in[34] + eo, DE, D, DE, BF(WS_WT_EGU) + (size_t)e * 512 * D, 1, 0);
        k_cvt(v2, vt, in[35] + eo, DE, D, DE, BF(WS_WT_EGU) + (size_t)e * 512 * D, 1, 128);
        k_cvt(v2, vt, in[36] + eo, D, DE, D, BF(WS_WT_ED) + (size_t)e * D * DE, 0, 0); }
    VBL(36 * 1024 / 256, 256) k_rtw(vb, vt, in[30] + (size_t)l * D * 4, in[32] + (size_t)l * D * 32, F32(WS_SMALL + SM_RTW));
    VBL(NGR * SST / 256, 256) k_s5tab(vb, vt, in[13] + (size_t)l * NGR * SST, in[14] + (size_t)l * NGR * SST, in[15] + (size_t)l * NGR * SST * SGRP,
                                      in[16] + (size_t)l * NGR * SST * SGRP, in[20] + (size_t)l * NGR, F32(WS_SMALL + SM_LAM), F32(WS_SMALL + SM_BB));
}

__global__ void __launch_bounds__(512, 2) mega(Args a) {
    __shared__ unsigned bar_st[4];
    unsigned char* ws = a.ws; const float* const* in = a.in; float* X = a.out;
    auto BF = [&](size_t off) { return (bf16_t*)(ws + off); };
    auto F32 = [&](size_t off) { return (float*)(ws + off); };
    unsigned* ctl = (unsigned*)(ws + WS_CTL);
    if (threadIdx.x < 4) bar_st[threadIdx.x] = 0u;
    __syncthreads();
    XcdBarrier bar = xcd_barrier_post(ctl + CW_BAR, (volatile LAS unsigned*)bar_st);
#define GB() xcd_barrier(bar)
    float* LAM = F32(WS_SMALL + SM_LAM); float* BBt = F32(WS_SMALL + SM_BB); float* KM = F32(WS_SMALL + SM_KMEAN); float* RTW = F32(WS_SMALL + SM_RTW);
    int* EID = (int*)(ws + WS_ROUTE + RT_EID); int* POS = (int*)(ws + WS_ROUTE + RT_POS); int* SLOT = (int*)(ws + WS_ROUTE + RT_SLOT); float* WGT = (float*)(ws + WS_ROUTE + RT_WGT);
    VBL(T * D / 256, 256) k_x0(vb, vt, in[0], X, BF(WS_XN));
    phase_weights(a, 0);
    GB();
    for (int l = 0; l < DEPTH; ++l) {
        { EProj E; E.P = BF(WS_PROJ); VBL2(NPROJ / 64, T / 64) k_gemm<EProj, false>(vq % (NPROJ / 64), vq / (NPROJ / 64), vt, BF(WS_XN), BF(WS_WT_IN), D, E); }
        GB();
        VBL(T, 512) k_prep(vb, vt, BF(WS_PROJ), in[2] + (size_t)l * 1792, in[3] + (size_t)l * DR, in[4] + (size_t)l * 64 * DR, in[5] + (size_t)l * DR, in[6] + (size_t)l * 64 * DR,
                           in[7] + (size_t)l * 128 * DR, in[8] + (size_t)l * DR, in[9] + (size_t)l * DR, BF(WS_R), BF(WS_KP), BF(WS_V), BF(WS_KK), BF(WS_AA), BF(WS_GG), F32(WS_LW));
        VBL(NB * MH * NBLK * HD / 256, 256) k_kmean(vb, vt, BF(WS_PROJ), KM);
        GB();
        VBL(NB * RH * 64 / 4, 256) k_wkv(vb, vt, BF(WS_R), BF(WS_KP), BF(WS_V), BF(WS_KK), BF(WS_AA), F32(WS_LW), F32(WS_YRAW));
        VBL(NB * NGR, 64) k_s5(vb, vt, BF(WS_PROJ), LAM, BBt, in[17] + (size_t)l * NGR * SGRP * SST, in[18] + (size_t)l * NGR * SGRP * SST, in[19] + (size_t)l * DSS, BF(WS_YCPRE));
        VBL(T * MH / 4, 256) k_moba(vb, vt, BF(WS_PROJ), KM, BF(WS_YB));
        GB();
        VBL(T, 512) k_wkvpost(vb, vt, F32(WS_YRAW), BF(WS_R), BF(WS_KP), BF(WS_V), BF(WS_GG), in[10] + (size_t)l * DR, in[11] + (size_t)l * DR, in[12] + (size_t)l * DR, BF(WS_YA));
        { EGlu E; E.YC = BF(WS_YC); E.bias = in[22] + (size_t)l * 2 * DSS; VBL2(DSS / 64, T / 64) k_gemm<EGlu, true>(vq % (DSS / 64), vq / (DSS / 64), vt, BF(WS_YCPRE), BF(WS_WT_GLU), DSS, E); }
        GB();
        for (int br = 0; br < 3; ++br) {
            EUp E; E.P = BF(WS_PROJ); E.gate_b = in[26] + (size_t)l * 3 * D; E.M = F32(WS_MERGED); E.MB = BF(WS_MERGEDB); E.br = br;
            const bf16_t* Ab = BF(br == 0 ? WS_YA : br == 1 ? WS_YB : WS_YC); const bf16_t* Wb = BF(br == 0 ? WS_WT_UPA : br == 1 ? WS_WT_UPB : WS_WT_UPC);
            VBL2(D / 64, T / 64) k_gemm<EUp, false>(vq % (D / 64), vq / (D / 64), vt, Ab, Wb, DR, E);
        }
        GB();
        { EOut E; E.X = X; E.S = F32(WS_S); VBL2(D / 64, T / 64) k_gemm<EOut, false>(vq % (D / 64), vq / (D / 64), vt, BF(WS_MERGEDB), BF(WS_WT_OUT), D, E); }
        GB();
        unsigned* cnt = ctl + CW_CNT + l * 64;
        VBL(T / 4, 256) k_ln1route(vb, vt, F32(WS_S), in[28] + (size_t)l * D, in[29] + (size_t)l * D, X, BF(WS_XN), RTW, in[31] + (size_t)l * 4, in[33] + (size_t)l * 32, cnt, EID, POS, WGT);
        GB();
        VBL(T / 4, 256) k_gather(vb, vt, BF(WS_XN), cnt, EID, POS, SLOT, BF(WS_XG));
        GB();
        { ESwi E; E.cnt = cnt; E.rows_per_e = 512; E.HID = BF(WS_HID); VBL2(DE / 64, MAXSLOT / 64) k_gemm<ESwi, true>(vq % (DE / 64), vq / (DE / 64), vt, BF(WS_XG), BF(WS_WT_EGU), D, E); }
        GB();
        { EDown E; E.cnt = cnt; E.rows_per_e = D; E.YG = BF(WS_YG); VBL2(D / 64, MAXSLOT / 64) k_gemm<EDown, false>(vq % (D / 64), vq / (D / 64), vt, BF(WS_HID), BF(WS_WT_ED), DE, E); }
        GB();
        VBL(T / 4, 256) k_ln2(vb, vt, BF(WS_YG), SLOT, WGT, in[37] + (size_t)l * D, in[38] + (size_t)l * D, X, BF(WS_XN));
        if (l + 1 < DEPTH) phase_weights(a, l + 1);
        GB();
    }
}

extern "C" void kernel_launch(void* const* d_in, const int* in_sizes, int n_in, void* d_out, int out_size, void* d_ws, size_t ws_size, hipStream_t stream) {
    static int grid = 0;
    if (grid == 0) {
        if (n_in != 39 || out_size != T * D || ws_size < WS_END) { fprintf(stderr, "kernel_launch: unexpected shapes n_in %d out %d ws %zu\n", n_in, out_size, ws_size); grid = -1; return; }
        int dev = 0, cus = 0, per_cu = 0;
        if (hipGetDevice(&dev) != hipSuccess || hipDeviceGetAttribute(&cus, hipDeviceAttributeMultiprocessorCount, dev) != hipSuccess) { grid = -1; return; }
        if (hipOccupancyMaxActiveBlocksPerMultiprocessor(&per_cu, (const void*)mega, 512, 0) != hipSuccess || per_cu < 1) per_cu = 1;
        (void)hipGetLastError();
        if (per_cu > 2) per_cu = 2;
        grid = cus * per_cu;
        fprintf(stderr, "kernel_launch: grid %d (%d CUs x %d), ws %zu\n", grid, cus, per_cu, ws_size);
    }
    if (grid < 0) return;
    (void)hipMemsetAsync((char*)d_ws + WS_CTL, 0, CTL_BYTES, stream);
    Args a{};
    for (int i = 0; i < 39; ++i) a.in[i] = (const float*)d_in[i];
    a.out = (float*)d_out; a.ws = (unsigned char*)d_ws;
    hipLaunchKernelGGL(mega, dim3(grid), dim3(512), 0, stream, a);
}
```

```cpp
#include <hip/hip_runtime.h>
#include <cstdio>
#include <cstdint>
#include <cmath>

typedef unsigned short bf16_t;
typedef short bf16x8 __attribute__((ext_vector_type(8)));
typedef float f32x4 __attribute__((ext_vector_type(4)));

constexpr int NB = 4, SEQ = 4096, T = NB * SEQ, D = 1024, DEPTH = 4, HD = 64;
constexpr int DR = 512, RH = 8, DMO = 512, MH = 8, DSS = 512, SGRP = 16, NGR = 32, SST = 64;
constexpr int OFF_MOBA = 1792, OFF_SSM = 3328, OFF_GATE = 3840, NPROJ = 6912;
constexpr int MBLK = 256, NBLK = SEQ / MBLK;
constexpr int NE = 32, EPG = 8, NGRP = 4, DE = 256;
constexpr int MAXSLOT = 40960;
constexpr float LN_EPS = 1e-5f, GN_EPS = 64e-5f;
constexpr float ALPHA = 1.6817928305074290f;

constexpr size_t MiB = 1u << 20;
constexpr size_t WS_CTL = 0, CTL_BYTES = 1 * MiB;
constexpr size_t WS_SMALL = 1 * MiB;
constexpr size_t WS_WT_IN = 4 * MiB, WS_WT_GLU = 18 * MiB, WS_WT_UPA = 19 * MiB, WS_WT_UPB = 20 * MiB, WS_WT_UPC = 21 * MiB,
                 WS_WT_OUT = 22 * MiB, WS_WT_EGU = 24 * MiB, WS_WT_ED = 56 * MiB;
constexpr size_t WS_PROJ = 72 * MiB;
constexpr size_t WS_XN = 288 * MiB;
constexpr size_t WS_R = 320 * MiB, WS_KP = 336 * MiB, WS_V = 352 * MiB, WS_KK = 368 * MiB, WS_AA = 384 * MiB, WS_GG = 400 * MiB;
constexpr size_t WS_LW = 416 * MiB;
constexpr size_t WS_YRAW = 448 * MiB;
constexpr size_t WS_YA = 480 * MiB, WS_YB = 496 * MiB, WS_YC = 512 * MiB, WS_YCPRE = 528 * MiB;
constexpr size_t WS_ROUTE = 544 * MiB;
constexpr size_t WS_END = 548 * MiB;
constexpr size_t WS_MERGED = 320 * MiB;
constexpr size_t WS_MERGEDB = 384 * MiB;
constexpr size_t WS_S = 416 * MiB;
constexpr size_t WS_XG = 72 * MiB;
constexpr size_t WS_HID = 152 * MiB;
constexpr size_t WS_YG = 172 * MiB;
constexpr size_t SM_LAM = 0;
constexpr size_t SM_BB = 16384;
constexpr size_t SM_KMEAN = 16384 + 262144;
constexpr size_t SM_RTW = SM_KMEAN + 131072;
constexpr size_t RT_EID = 0, RT_POS = 131072, RT_SLOT = 262144, RT_WGT = 393216;
constexpr int CW_CNT = 1024;

__device__ __forceinline__ float bf2f(bf16_t h) { return __uint_as_float(((unsigned)h) << 16); }
__device__ __forceinline__ bf16_t f2bf(float f) { unsigned u = __float_as_uint(f); return (bf16_t)((u + 0x7fffu + ((u >> 16) & 1u)) >> 16); }
template <int CTRL, int RMASK> __device__ __forceinline__ float dpp_f(float oldv, float v) {
    return __builtin_bit_cast(float, __builtin_amdgcn_update_dpp(__builtin_bit_cast(int, oldv), __builtin_bit_cast(int, v), CTRL, RMASK, 0xF, false)); }
__device__ __forceinline__ float wave_allsum(float v) {
    v += dpp_f<0xB1, 0xF>(0.f, v);
    v += dpp_f<0x4E, 0xF>(0.f, v);
    v += dpp_f<0x141, 0xF>(0.f, v);
    v += dpp_f<0x140, 0xF>(0.f, v);
    v += dpp_f<0x142, 0xA>(0.f, v);
    v += dpp_f<0x143, 0xC>(0.f, v);
    return __builtin_bit_cast(float, __builtin_amdgcn_readlane(__builtin_bit_cast(int, v), 63));
}
__device__ __forceinline__ float wave_allmax(float v) {
    v = fmaxf(v, dpp_f<0xB1, 0xF>(v, v)); v = fmaxf(v, dpp_f<0x4E, 0xF>(v, v)); v = fmaxf(v, dpp_f<0x141, 0xF>(v, v)); v = fmaxf(v, dpp_f<0x140, 0xF>(v, v));
    v = fmaxf(v, dpp_f<0x142, 0xA>(v, v)); v = fmaxf(v, dpp_f<0x143, 0xC>(v, v));
    return __builtin_bit_cast(float, __builtin_amdgcn_readlane(__builtin_bit_cast(int, v), 63));
}
__device__ __forceinline__ float lane_bcast(float v, int l) { return __builtin_bit_cast(float, __builtin_amdgcn_readlane(__builtin_bit_cast(int, v), l)); }
__device__ __forceinline__ float sigmoidf_(float x) { return 1.f / (1.f + __expf(-x)); }
__device__ __forceinline__ float gelu_tanh(float x) { const float u = 0.7978845608028654f * (x + 0.044715f * x * x * x); return 0.5f * x * (1.f + tanhf(u)); }

__device__ __forceinline__ void k_cvt(int vb, int vt, const float* __restrict__ W, int ldw, int K, int Nsub, bf16_t* __restrict__ WT, int interleave, int row_off) {
    const long i = (long)vb * 256 + vt;
    if (i >= (long)K * Nsub) return;
    const int n = (int)(i / K), k = (int)(i % K);
    const int dr = interleave ? ((n >> 7) * 256 + (n & 127) + row_off) : (n + row_off);
    WT[(size_t)dr * K + k] = f2bf(W[(size_t)k * ldw + n]);
}
__device__ __forceinline__ void k_rtw(int vb, int vt, const float* __restrict__ gw, const float* __restrict__ ew, float* __restrict__ RTW) {
    const int i = vb * 256 + vt;
    if (i >= 36 * 1024) return;
    const int j = i / 1024, k = i % 1024;
    RTW[i] = j < 4 ? gw[k * 4 + j] : ew[k * 32 + (j - 4)];
}
__device__ __forceinline__ void k_s5tab(int vb, int vt, const float* __restrict__ a_re, const float* __restrict__ a_im, const float* __restrict__ b_re, const float* __restrict__ b_im,
                        const float* __restrict__ log_dt, float* __restrict__ LAM, float* __restrict__ BB) {
    const int i = vb * 256 + vt;
    if (i >= NGR * SST) return;
    const int g = i / SST;
    const float dt = expf(log_dt[g]);
    const float are = a_re[i], aim = a_im[i];
    const float mag = expf(are * dt);
    const float ang = aim * dt;
    const float lre = mag * cosf(ang), lim = mag * sinf(ang);
    const float den = are * are + aim * aim, nr = lre - 1.0f;
    const float cre = (nr * are + lim * aim) / den, cim = (lim * are - nr * aim) / den;
    LAM[i * 2] = lre; LAM[i * 2 + 1] = lim;
    for (int h = 0; h < SGRP; ++h) {
        const float bre = b_re[i * SGRP + h], bim = b_im[i * SGRP + h];
        BB[(i * SGRP + h) * 2] = cre * bre - cim * bim;
        BB[(i * SGRP + h) * 2 + 1] = cre * bim + cim * bre;
    }
}
__device__ __forceinline__ void k_x0(int vb, int vt, const float* __restrict__ x, float* __restrict__ X, bf16_t* __restrict__ XN) {
    const long i = (long)vb * 256 + vt;
    if (i >= (long)T * D) return;
    const float v = x[i]; X[i] = v; XN[i] = f2bf(v);
}

template <class Epi, bool PAIR>
__device__ __forceinline__ void k_gemm(int vbx, int vby, int vt, const bf16_t* __restrict__ A, const bf16_t* __restrict__ Bt, int K, Epi E) {
    const int wave = vt >> 6, lane = vt & 63, fr = lane & 15, fq = lane >> 4;
    const int rt = vby;
    if (!E.active(rt)) return;
    const bf16_t* B2 = Bt + E.bt_off(rt);
    const int row0 = rt * 64 + (wave >> 1) * 32;
    int colA, colB = 0, ch0 = 0;
    if (PAIR) { ch0 = vbx * 64 + (wave & 1) * 32; colA = (ch0 >> 7) * 256 + (ch0 & 127); colB = colA + 128; }
    else colA = vbx * 64 + (wave & 1) * 32;
    f32x4 acc[2][2], acc2[2][2];
#pragma unroll
    for (int i = 0; i < 2; ++i)
#pragma unroll
        for (int j = 0; j < 2; ++j) { acc[i][j] = (f32x4){0.f, 0.f, 0.f, 0.f}; acc2[i][j] = (f32x4){0.f, 0.f, 0.f, 0.f}; }
    for (int k0 = 0; k0 < K; k0 += 32) {
        bf16x8 a[2], b[2], b2[2];
#pragma unroll
        for (int i = 0; i < 2; ++i) a[i] = *(const bf16x8*)(A + (size_t)(row0 + i * 16 + fr) * K + k0 + fq * 8);
#pragma unroll
        for (int j = 0; j < 2; ++j) b[j] = *(const bf16x8*)(B2 + (size_t)(colA + j * 16 + fr) * K + k0 + fq * 8);
        if (PAIR) {
#pragma unroll
            for (int j = 0; j < 2; ++j) b2[j] = *(const bf16x8*)(B2 + (size_t)(colB + j * 16 + fr) * K + k0 + fq * 8);
        }
#pragma unroll
        for (int i = 0; i < 2; ++i)
#pragma unroll
            for (int j = 0; j < 2; ++j) {
                acc[i][j] = __builtin_amdgcn_mfma_f32_16x16x32_bf16(a[i], b[j], acc[i][j], 0, 0, 0);
                if (PAIR) acc2[i][j] = __builtin_amdgcn_mfma_f32_16x16x32_bf16(a[i], b2[j], acc2[i][j], 0, 0, 0);
            }
    }
#pragma unroll
    for (int i = 0; i < 2; ++i)
#pragma unroll
        for (int j = 0; j < 2; ++j)
#pragma unroll
            for (int r = 0; r < 4; ++r) {
                const int row = row0 + i * 16 + fq * 4 + r;
                if (PAIR) E.store2(row, ch0 + j * 16 + fr, acc[i][j][r], acc2[i][j][r]);
                else E.store(row, colA + j * 16 + fr, acc[i][j][r]);
            }
}
struct EDense { __device__ bool active(int) const { return true; } __device__ size_t bt_off(int) const { return 0; } };
struct EProj : EDense { bf16_t* P; __device__ void store(int r, int c, float v) const { P[(size_t)r * NPROJ + c] = f2bf(v); } __device__ void store2(int, int, float, float) const {} };
struct EGlu : EDense { bf16_t* YC; const float* bias;
    __device__ void store(int, int, float) const {}
    __device__ void store2(int r, int ch, float v, float g) const { YC[(size_t)r * DSS + ch] = f2bf((v + bias[ch]) * sigmoidf_(g + bias[DSS + ch])); } };
struct EUp : EDense { const bf16_t* P; const float* gate_b; float* M; bf16_t* MB; int br;
    __device__ void store2(int, int, float, float) const {}
    __device__ void store(int r, int c, float v) const {
        const float gl = bf2f(P[(size_t)r * NPROJ + OFF_GATE + br * D + c]) + gate_b[br * D + c];
        float m = sigmoidf_(gl) * v; const size_t o = (size_t)r * D + c;
        if (br > 0) m += M[o];
        M[o] = m; if (br == 2) MB[o] = f2bf(m); } };
struct EOut : EDense { const float* X; float* S;
    __device__ void store2(int, int, float, float) const {}
    __device__ void store(int r, int c, float v) const { const size_t o = (size_t)r * D + c; S[o] = ALPHA * X[o] + v; } };
struct EGrouped { const unsigned* cnt; int rows_per_e;
    __device__ int expert_of(int rt, bool& ok) const {
        int off = 0; const int r0 = rt * 64;
        for (int e = 0; e < NE; ++e) { const int p = ((int)cnt[e] + 255) & ~255; if (r0 < off + p) { ok = true; return e; } off += p; }
        ok = false; return 0; }
    __device__ bool active(int rt) const { bool ok; expert_of(rt, ok); return ok; }
};
struct ESwi : EGrouped { bf16_t* HID;
    __device__ size_t bt_off(int rt) const { bool ok; const int e = expert_of(rt, ok); return (size_t)e * 512 * D; }
    __device__ void store(int, int, float) const {}
    __device__ void store2(int r, int ch, float g, float u) const { HID[(size_t)r * DE + ch] = f2bf(g * sigmoidf_(g) * u); } };
struct EDown : EGrouped { bf16_t* YG;
    __device__ size_t bt_off(int rt) const { bool ok; const int e = expert_of(rt, ok); return (size_t)e * D * DE; }
    __device__ void store2(int, int, float, float) const {}
    __device__ void store(int r, int c, float v) const { YG[(size_t)r * D + c] = f2bf(v); } };

__device__ __forceinline__ void k_prep(int vb, int vt, const bf16_t* __restrict__ P, const float* __restrict__ mu, const float* __restrict__ w0, const float* __restrict__ w2,
        const float* __restrict__ a0, const float* __restrict__ a2, const float* __restrict__ g2, const float* __restrict__ k_k, const float* __restrict__ k_a,
        bf16_t* R, bf16_t* KP, bf16_t* V, bf16_t* KK, bf16_t* AA, bf16_t* GG, float* LW, float* act) {
    const int t = vb, c = vt;
    const bool first = (t % SEQ) == 0;
    const bf16_t* row = P + (size_t)t * NPROJ; const bf16_t* prow = row - NPROJ;
    auto zs = [&](int col) -> float { const float z = bf2f(row[col]); const float zp = first ? 0.f : bf2f(prow[col]); return z + (zp - z) * mu[col]; };
    if (c < 256) { const float z = zs(1536 + c); act[c] = c < 64 ? tanhf(z) : (c < 128 ? z : sigmoidf_(z)); }
    __syncthreads();
    const float r = zs(c), k = zs(512 + c), v = zs(1024 + c);
    float sw = 0.f, sa = 0.f, sg = 0.f;
#pragma unroll 4
    for (int i = 0; i < 64; ++i) { sw += act[i] * w2[i * DR + c]; sa += act[64 + i] * a2[i * DR + c]; }
#pragma unroll 4
    for (int i = 0; i < 128; ++i) sg += act[128 + i] * g2[i * DR + c];
    const float xx = -(w0[c] + sw);
    const float sp = fmaxf(xx, 0.f) + log1pf(expf(-fabsf(xx)));
    const float wl = -sp - 0.5f;
    const float lw = -expf(wl);
    const float a = sigmoidf_(a0[c] + sa);
    const float kk = k * k_k[c];
    const float ss = wave_allsum(kk * kk);
    const float kkn = kk * rsqrtf(fmaxf(ss, 1e-24f));
    const float kp = k * (1.f + (a - 1.f) * k_a[c]);
    const size_t o = (size_t)t * DR + c;
    R[o] = f2bf(r); KP[o] = f2bf(kp); V[o] = f2bf(v); KK[o] = f2bf(kkn); AA[o] = f2bf(a); GG[o] = f2bf(sg); LW[o] = lw;
    __syncthreads();
}
__device__ __forceinline__ void k_wkv(int vb, int vt, const bf16_t* __restrict__ R, const bf16_t* __restrict__ KP, const bf16_t* __restrict__ V, const bf16_t* __restrict__ KK,
        const bf16_t* __restrict__ AA, const float* __restrict__ LW, float* __restrict__ YRAW) {
    const int gwv = vb * 4 + (vt >> 6), j = vt & 63;
    const int i = gwv & 63, h = (gwv >> 6) & 7, b = gwv >> 9;
    float S = 0.f;
    for (int t = 0; t < SEQ; ++t) {
        const size_t o = (size_t)(b * SEQ + t) * DR + h * 64;
        const float r = bf2f(R[o + j]), w = __expf(LW[o + j]), k = bf2f(KP[o + j]), kk = bf2f(KK[o + j]), a = bf2f(AA[o + j]), v = bf2f(V[o + i]);
        const float sa = wave_allsum(S * (-kk));
        S = S * w + sa * (kk * a) + v * k;
        const float y = wave_allsum(S * r);
        if (j == 0) YRAW[o + i] = y;
    }
}
__device__ __forceinline__ void k_wkvpost(int vb, int vt, const float* __restrict__ YRAW, const bf16_t* __restrict__ R, const bf16_t* __restrict__ KP, const bf16_t* __restrict__ V,
        const bf16_t* __restrict__ GG, const float* __restrict__ r_k, const float* __restrict__ ln_w, const float* __restrict__ ln_b, bf16_t* __restrict__ YA) {
    const int t = vb, c = vt; const size_t o = (size_t)t * DR + c;
    const float y = YRAW[o];
    const float mean = wave_allsum(y) * (1.f / 64.f);
    const float dv = y - mean;
    const float var = wave_allsum(dv * dv) * (1.f / 64.f);
    const float yn = dv * rsqrtf(var + GN_EPS) * ln_w[c] + ln_b[c];
    const float bonus = wave_allsum(bf2f(R[o]) * bf2f(KP[o]) * r_k[c]) * bf2f(V[o]);
    YA[o] = f2bf((yn + bonus) * bf2f(GG[o]));
}
__device__ __forceinline__ void k_kmean(int vb, int vt, const bf16_t* __restrict__ P, float* __restrict__ KM) {
    const int i = vb * 256 + vt;
    if (i >= NB * MH * NBLK * HD) return;
    const int d = i & 63, n = (i >> 6) & 15, h = (i >> 10) & 7, b = i >> 13;
    float s = 0.f;
    for (int q = 0; q < MBLK; ++q) s += bf2f(P[(size_t)(b * SEQ + n * MBLK + q) * NPROJ + OFF_MOBA + 512 + h * 64 + d]);
    KM[i] = s * (1.f / MBLK);
}
__device__ __forceinline__ void k_moba(int vb, int vt, const bf16_t* __restrict__ P, const float* __restrict__ KM, bf16_t* __restrict__ YB) {
    const int gwv = vb * 4 + (vt >> 6), lane = vt & 63;
    const int h = gwv & 7, tt = gwv >> 3;
    const int b = tt / SEQ, tpos = tt % SEQ, blk = tpos / MBLK;
    const float slope = exp2f(-(float)(h + 1));
    const bf16_t* qrow = P + (size_t)tt * NPROJ + OFF_MOBA + h * 64;
    const float qd = bf2f(qrow[lane]) * 0.125f;
    float q[64];
#pragma unroll
    for (int d = 0; d < 64; ++d) q[d] = lane_bcast(qd, d);
    int sel[3] = {-1, -1, -1};
    {
        float gate[16];
#pragma unroll
        for (int n = 0; n < 16; ++n) { const float km = KM[((b * MH + h) * NBLK + n) * HD + lane]; gate[n] = wave_allsum(qd * km); }
#pragma unroll
        for (int s = 0; s < 3; ++s) {
            int best = -1; float bv = 0.f;
#pragma unroll
            for (int n = 0; n < 16; ++n) { const bool ok = n < blk && n != sel[0] && n != sel[1]; if (ok && (best < 0 || gate[n] > bv)) { best = n; bv = gate[n]; } }
            sel[s] = best;
        }
    }
    float m = -INFINITY, l = 0.f, o = 0.f;
    for (int s = 0; s < 4; ++s) {
        const int n = s < 3 ? sel[s] : blk;
        if (n < 0) continue;
        for (int c0 = 0; c0 < MBLK; c0 += 64) {
            const int sp = n * MBLK + c0 + lane;
            const bool valid = sp <= tpos;
            if (n * MBLK + c0 > tpos) break;
            const bf16_t* krow = P + (size_t)(b * SEQ + sp) * NPROJ + OFF_MOBA + 512 + h * 64;
            float sc = 0.f;
#pragma unroll
            for (int d8 = 0; d8 < 8; ++d8) { const bf16x8 kv = *(const bf16x8*)(krow + d8 * 8);
#pragma unroll
                for (int e = 0; e < 8; ++e) sc += q[d8 * 8 + e] * bf2f((bf16_t)kv[e]); }
            sc -= slope * (float)(tpos - sp);
            if (!valid) sc = -INFINITY;
            const float mx = wave_allmax(sc);
            const float mn = fmaxf(m, mx);
            const float scale = __expf(m - mn);
            const float p = valid ? __expf(sc - mn) : 0.f;
            l = l * scale + wave_allsum(p);
            o *= scale;
            const bf16_t* vbase = P + (size_t)(b * SEQ + n * MBLK + c0) * NPROJ + OFF_MOBA + 1024 + h * 64 + lane;
#pragma unroll
            for (int e = 0; e < 64; ++e) { const float pe = lane_bcast(p, e); o += pe * bf2f(vbase[(size_t)e * NPROJ]); }
            m = mn;
        }
    }
    YB[(size_t)tt * DMO + h * 64 + lane] = f2bf(o / l);
}
__device__ __forceinline__ void k_s5(int vb, int vt, const bf16_t* __restrict__ P, const float* __restrict__ LAM, const float* __restrict__ BB, const float* __restrict__ c_re,
        const float* __restrict__ c_im, const float* __restrict__ dvec, bf16_t* __restrict__ YCPRE) {
    const int b = vb / NGR, g = vb % NGR, p = vt;
    const float lre = LAM[(g * SST + p) * 2], lim = LAM[(g * SST + p) * 2 + 1];
    float bre[16], bim[16], cre[16], cim[16], dd[16];
#pragma unroll
    for (int h = 0; h < 16; ++h) { bre[h] = BB[((g * SST + p) * 16 + h) * 2]; bim[h] = BB[((g * SST + p) * 16 + h) * 2 + 1];
        cre[h] = c_re[(g * 16 + h) * SST + p]; cim[h] = c_im[(g * 16 + h) * SST + p]; dd[h] = dvec[g * 16 + h]; }
    float hre = 0.f, him = 0.f;
    for (int t = 0; t < SEQ; ++t) {
        const bf16_t* ur = P + (size_t)(b * SEQ + t) * NPROJ + OFF_SSM + g * 16;
        float u[16];
#pragma unroll
        for (int h = 0; h < 16; ++h) u[h] = bf2f(ur[h]);
        float bur = 0.f, bui = 0.f;
#pragma unroll
        for (int h = 0; h < 16; ++h) { bur += bre[h] * u[h]; bui += bim[h] * u[h]; }
        const float nre = lre * hre - lim * him + bur, nim = lre * him + lim * hre + bui;
        hre = nre; him = nim;
        float myy = 0.f;
#pragma unroll
        for (int h = 0; h < 16; ++h) { const float y = wave_allsum(cre[h] * hre - cim[h] * him) + dd[h] * u[h]; if (p == h) myy = y; }
        if (p < 16) YCPRE[(size_t)(b * SEQ + t) * DSS + g * 16 + p] = f2bf(gelu_tanh(myy));
    }
}
__device__ __forceinline__ void k_ln1route(int vb, int vt, const float* __restrict__ S, const float* __restrict__ lw, const float* __restrict__ lb, float* __restrict__ X, bf16_t* __restrict__ XN,
        const float* __restrict__ RTW, const float* __restrict__ gb, const float* __restrict__ eb, unsigned* __restrict__ cnt,
        int* __restrict__ EID, int* __restrict__ POS, float* __restrict__ WGT, float* rlog) {
    const int t = vb * 4 + (vt >> 6), lane = vt & 63;
    float v[16]; float s = 0.f;
#pragma unroll
    for (int i = 0; i < 16; ++i) { v[i] = S[(size_t)t * D + i * 64 + lane]; s += v[i]; }
    const float mean = wave_allsum(s) * (1.f / D);
    float q = 0.f;
#pragma unroll
    for (int i = 0; i < 16; ++i) { v[i] -= mean; q += v[i] * v[i]; }
    const float rstd = rsqrtf(wave_allsum(q) * (1.f / D) + LN_EPS);
#pragma unroll
    for (int i = 0; i < 16; ++i) { const int c = i * 64 + lane; v[i] = v[i] * rstd * lw[c] + lb[c]; X[(size_t)t * D + c] = v[i]; XN[(size_t)t * D + c] = f2bf(v[i]); }
    float* lg = rlog + ((vb & 1) * 4 + (vt >> 6)) * 40;
    for (int j = 0; j < 36; ++j) { float a = 0.f;
#pragma unroll
        for (int i = 0; i < 16; ++i) a += v[i] * RTW[j * 1024 + i * 64 + lane];
        a = wave_allsum(a); if (lane == 0) lg[j] = a; }
    if (lane == 0) {
        int gs = 0; float gm = lg[0] + gb[0];
        for (int j = 1; j < 4; ++j) { const float x = lg[j] + gb[j]; if (x > gm) { gm = x; gs = j; } }
        float den = 0.f;
        for (int j = 0; j < 4; ++j) den += __expf(lg[j] + gb[j] - gm);
        const float pg = 1.f / den;
        int i0 = 0; float m0 = lg[4 + gs * 8] + eb[gs * 8];
        for (int j = 1; j < 8; ++j) { const float x = lg[4 + gs * 8 + j] + eb[gs * 8 + j]; if (x > m0) { m0 = x; i0 = j; } }
        int i1 = -1; float m1 = 0.f;
        for (int j = 0; j < 8; ++j) { const float x = lg[4 + gs * 8 + j] + eb[gs * 8 + j]; if (j != i0 && (i1 < 0 || x > m1)) { m1 = x; i1 = j; } }
        const float e1 = __expf(m1 - m0);
        const float p0 = 1.f / (1.f + e1), p1 = e1 / (1.f + e1);
        const int ex0 = gs * 8 + i0, ex1 = gs * 8 + i1;
        EID[t * 2] = ex0; EID[t * 2 + 1] = ex1;
        WGT[t * 2] = pg * p0; WGT[t * 2 + 1] = pg * p1;
        POS[t * 2] = (int)atomicAdd(&cnt[ex0], 1u);
        POS[t * 2 + 1] = (int)atomicAdd(&cnt[ex1], 1u);
    }
}
__device__ __forceinline__ void k_gather(int vb, int vt, const bf16_t* __restrict__ XN, const unsigned* __restrict__ cnt, const int* __restrict__ EID, const int* __restrict__ POS,
        int* __restrict__ SLOT, bf16_t* __restrict__ XG) {
    const int t = vb * 4 + (vt >> 6), lane = vt & 63;
    for (int k = 0; k < 2; ++k) {
        const int e = EID[t * 2 + k]; int off = 0;
        for (int j = 0; j < e; ++j) off += ((int)cnt[j] + 255) & ~255;
        const int slot = off + POS[t * 2 + k];
        if (lane == 0) SLOT[t * 2 + k] = slot;
        const uint4* src = (const uint4*)(XN + (size_t)t * D); uint4* dst = (uint4*)(XG + (size_t)slot * D);
        dst[lane] = src[lane]; dst[lane + 64] = src[lane + 64];
    }
}
__device__ __forceinline__ void k_ln2(int vb, int vt, const bf16_t* __restrict__ YG, const int* __restrict__ SLOT, const float* __restrict__ WGT, const float* __restrict__ lw, const float* __restrict__ lb,
        float* __restrict__ X, bf16_t* __restrict__ XN) {
    const int t = vb * 4 + (vt >> 6), lane = vt & 63;
    const int s0 = SLOT[t * 2], s1 = SLOT[t * 2 + 1]; const float w0 = WGT[t * 2], w1 = WGT[t * 2 + 1];
    float v[16]; float s = 0.f;
#pragma unroll
    for (int i = 0; i < 16; ++i) { const int c = i * 64 + lane;
        const float y = bf2f(YG[(size_t)s0 * D + c]) * w0 + bf2f(YG[(size_t)s1 * D + c]) * w1;
        v[i] = ALPHA * X[(size_t)t * D + c] + y; s += v[i]; }
    const float mean = wave_allsum(s) * (1.f / D);
    float q = 0.f;
#pragma unroll
    for (int i = 0; i < 16; ++i) { v[i] -= mean; q += v[i] * v[i]; }
    const float rstd = rsqrtf(wave_allsum(q) * (1.f / D) + LN_EPS);
#pragma unroll
    for (int i = 0; i < 16; ++i) { const int c = i * 64 + lane; const float o = v[i] * rstd * lw[c] + lb[c]; X[(size_t)t * D + c] = o; XN[(size_t)t * D + c] = f2bf(o); }
}

namespace pg8 {
#define PG8_LAS __attribute__((address_space(3)))
typedef unsigned short bf16_t;
typedef short bf16x8 __attribute__((ext_vector_type(8)));
typedef float f32x4 __attribute__((ext_vector_type(4)));
typedef unsigned u32x4 __attribute__((ext_vector_type(4)));
constexpr int BM = 256, BK = 64, HALF = 128, HTB = HALF * BK * 2  , STAGE_BYTES = 8 * HTB, NXCD = 8, WGM = 8;

__host__ __device__ __forceinline__ int lds_byte(int r, int c) { const int st = (r >> 4) * 2 + (c >> 5), rr = r & 15, cc = c & 31, ob = rr * 64 + cc * 2; return st * 1024 + (ob ^ (((ob >> 9) & 1) << 5)); }
__host__ __device__ __forceinline__ void stage_rc(int b, int& R, int& C) { const int st = b / 1024, sb = b % 1024, swz = sb ^ (((sb >> 9) & 1) << 5); R = (st >> 1) * 16 + swz / 64; C = (st & 1) * 32 + (swz % 64) / 2; }
__host__ __device__ __forceinline__ int perm32(int rho) { const int n = rho >> 4, i = rho & 15; return 8 * (i >> 2) + 4 * n + (i & 3); }

struct Unit { int pm, pn; };
struct Gemm { const bf16_t* A; const bf16_t* Bt; int M, N, K; };

struct StaticOrder {
    int nM, nN, nwg, G, c;
    __host__ __device__ void init(int M, int N, int G_, int c_) { nM = M / BM; nN = N / BM; nwg = nM * nN; G = G_; c = c_; }
    __host__ __device__ bool next(int i, Unit& u) const {
        const long L = (long)i * G + c; if (L >= nwg) return false;
        int wgid = (int)L; { const int q = nwg / NXCD, r = nwg % NXCD, xcd = wgid % NXCD, off = wgid / NXCD; wgid = (xcd < r ? xcd * (q + 1) : r * (q + 1) + (xcd - r) * q) + off; }
        const int nig = WGM * nN, gid = wgid / nig, fm = gid * WGM, gsz = (nM - fm) < WGM ? (nM - fm) : WGM;
        u.pm = fm + ((wgid % nig) % gsz); u.pn = (wgid % nig) / gsz; return true;
    }
    __device__ __forceinline__ void a_ready(const Unit&) const {}
    __device__ __forceinline__ void done(const Unit&) const {}
};

__device__ __forceinline__ unsigned cvt_pk_bf16(float lo, float hi) { unsigned r; asm volatile("v_cvt_pk_bf16_f32 %0, %1, %2" : "=v"(r) : "v"(lo), "v"(hi)); return r; }
typedef float f32x2 __attribute__((ext_vector_type(2)));
__device__ __forceinline__ f32x2 gelu_pk(f32x2 v) {
    const f32x2 av = __builtin_elementwise_abs(v), d = av * 0.2316418882f + 1.0f;
    f32x2 t; t.x = __builtin_amdgcn_rcpf(d.x); t.y = __builtin_amdgcn_rcpf(d.y);
    f32x2 q = t * 0.5307027145f + (-0.7265760135f); q = q * t + 0.7107068705f; q = q * t + (-0.142248368f); q = q * t + 0.127414796f; q = q * t;
    const f32x2 s = (v * v) * (-0.72134752044f);
    f32x2 e; e.x = __builtin_amdgcn_exp2f(s.x); e.y = __builtin_amdgcn_exp2f(s.y);
    const f32x2 m = v * (q * e), r = v - m;
    f32x2 o; o.x = v.x < 0.f ? m.x : r.x; o.y = v.y < 0.f ? m.y : r.y; return o;
}

template <int ACT  > struct EpiBf16 {
    static constexpr bool PERM = true, AFTER_DRAIN = false; static_assert(ACT == 0 || ACT == 1, "EpiBf16: ACT is 0 (none) or 1 (gelu_pk)");
    bf16_t* O; int ldc; const float* bias; int split_cols; size_t split_stride; float scale0;
    __device__ __forceinline__ void operator()(const f32x4 (&acc)[2][2][4][2], const Unit& u, int wr, int wc, int fr, int fq) const {
        const int row0 = u.pm * BM + wr * 64 + fr; int colt = u.pn * BM; bf16_t* base = O;
        float sc = 1.f; if (split_cols) { const int t = colt / split_cols; base += (size_t)t * split_stride; colt -= t * split_cols; if (t == 0) sc = scale0; }
        const int col0 = colt + wc * 32 + 8 * fq, bcol0 = u.pn * BM + wc * 32 + 8 * fq;
        f32x4 bv[2][2];
#pragma unroll
        for (int bj = 0; bj < 2; ++bj)
#pragma unroll
            for (int n = 0; n < 2; ++n) bv[bj][n] = bias ? *(const f32x4*)(bias + bcol0 + bj * HALF + 4 * n) : (f32x4){0.f, 0.f, 0.f, 0.f};
#pragma unroll
        for (int ai = 0; ai < 2; ++ai)
#pragma unroll
            for (int m = 0; m < 4; ++m) { bf16_t* rowp = base + (size_t)(row0 + ai * HALF + m * 16) * ldc + col0;
#pragma unroll
                for (int bj = 0; bj < 2; ++bj) { f32x4 v0 = acc[ai][bj][m][0] + bv[bj][0], v1 = acc[ai][bj][m][1] + bv[bj][1];
                    if (ACT == 1) { f32x2 a = gelu_pk((f32x2){v0[0], v0[1]}), b = gelu_pk((f32x2){v0[2], v0[3]}), c = gelu_pk((f32x2){v1[0], v1[1]}), d = gelu_pk((f32x2){v1[2], v1[3]});
                        v0 = (f32x4){a.x, a.y, b.x, b.y}; v1 = (f32x4){c.x, c.y, d.x, d.y}; }
                    v0 = v0 * sc; v1 = v1 * sc; u32x4 w; w.x = cvt_pk_bf16(v0[0], v0[1]); w.y = cvt_pk_bf16(v0[2], v0[3]); w.z = cvt_pk_bf16(v1[0], v1[1]); w.w = cvt_pk_bf16(v1[2], v1[3]);
                    *(u32x4*)(rowp + bj * HALF) = w; } }
    }
};

typedef unsigned u32x2 __attribute__((ext_vector_type(2)));
__device__ __forceinline__ float sigm(float x) { return __builtin_amdgcn_rcpf(1.f + __expf(-x)); }
__device__ __forceinline__ float bflo(unsigned w) { return __uint_as_float(w << 16); }
__device__ __forceinline__ float bfhi(unsigned w) { return __uint_as_float(w & 0xffff0000u); }
template <int MODE> struct EpiGated {
    static constexpr bool PERM = true, AFTER_DRAIN = false;
    bf16_t* O; int ldc; const float* bias; int bias1_off; int pn_mask;
    __device__ __forceinline__ void operator()(const f32x4 (&acc)[2][2][4][2], const Unit& u, int wr, int wc, int fr, int fq) const {
        const int row0 = u.pm * BM + wr * 64 + fr, ch0 = (u.pn & pn_mask) * 128 + wc * 32 + 8 * fq;
        f32x4 b0[2], b1[2];
#pragma unroll
        for (int n = 0; n < 2; ++n) { if (MODE == 0) { b0[n] = *(const f32x4*)(bias + ch0 + 4 * n); b1[n] = *(const f32x4*)(bias + bias1_off + ch0 + 4 * n); } else { b0[n] = (f32x4){0.f, 0.f, 0.f, 0.f}; b1[n] = b0[n]; } }
#pragma unroll
        for (int ai = 0; ai < 2; ++ai)
#pragma unroll
            for (int m = 0; m < 4; ++m) { bf16_t* rowp = O + (size_t)(row0 + ai * HALF + m * 16) * ldc + ch0; float r[8];
#pragma unroll
                for (int n = 0; n < 2; ++n) { const f32x4 a0 = acc[ai][0][m][n] + b0[n], a1 = acc[ai][1][m][n] + b1[n];
#pragma unroll
                    for (int j = 0; j < 4; ++j) r[4 * n + j] = MODE == 0 ? a0[j] * sigm(a1[j]) : a0[j] * sigm(a0[j]) * a1[j]; }
                u32x4 w; w.x = cvt_pk_bf16(r[0], r[1]); w.y = cvt_pk_bf16(r[2], r[3]); w.z = cvt_pk_bf16(r[4], r[5]); w.w = cvt_pk_bf16(r[6], r[7]);
                *(u32x4*)rowp = w; }
    }
};
struct EpiUp {
    static constexpr bool PERM = true, AFTER_DRAIN = false;
    const bf16_t* P; int ldp; const float* gb; float* M; bf16_t* MB; int ldc; int br;
    __device__ __forceinline__ void operator()(const f32x4 (&acc)[2][2][4][2], const Unit& u, int wr, int wc, int fr, int fq) const {
        const int row0 = u.pm * BM + wr * 64 + fr, col0 = u.pn * BM + wc * 32 + 8 * fq;
#pragma unroll
        for (int ai = 0; ai < 2; ++ai)
#pragma unroll
            for (int m = 0; m < 4; ++m) { const size_t row = (size_t)(row0 + ai * HALF + m * 16);
#pragma unroll
                for (int bj = 0; bj < 2; ++bj) { const int c = col0 + bj * HALF;
                    const u32x4 gl = *(const u32x4*)(P + row * ldp + c);
                    const f32x4 g0 = *(const f32x4*)(gb + c), g1 = *(const f32x4*)(gb + c + 4);
                    const f32x4 a0 = acc[ai][bj][m][0], a1 = acc[ai][bj][m][1];
                    f32x4 m0, m1;
                    m0[0] = sigm(bflo(gl.x) + g0[0]) * a0[0]; m0[1] = sigm(bfhi(gl.x) + g0[1]) * a0[1]; m0[2] = sigm(bflo(gl.y) + g0[2]) * a0[2]; m0[3] = sigm(bfhi(gl.y) + g0[3]) * a0[3];
                    m1[0] = sigm(bflo(gl.z) + g1[0]) * a1[0]; m1[1] = sigm(bfhi(gl.z) + g1[1]) * a1[1]; m1[2] = sigm(bflo(gl.w) + g1[2]) * a1[2]; m1[3] = sigm(bfhi(gl.w) + g1[3]) * a1[3];
                    float* mp = M + row * ldc + c;
                    if (br > 0) { m0 += *(const f32x4*)mp; m1 += *(const f32x4*)(mp + 4); }
                    if (br < 2) { *(f32x4*)mp = m0; *(f32x4*)(mp + 4) = m1; }
                    else { u32x4 w; w.x = cvt_pk_bf16(m0[0], m0[1]); w.y = cvt_pk_bf16(m0[2], m0[3]); w.z = cvt_pk_bf16(m1[0], m1[1]); w.w = cvt_pk_bf16(m1[2], m1[3]); *(u32x4*)(MB + row * ldc + c) = w; } } }
    }
};
struct EpiOut {
    static constexpr bool PERM = false, AFTER_DRAIN = false;
    const float* X; float* S; int ldc; float alpha;
    __device__ __forceinline__ void operator()(const f32x4 (&acc)[2][2][4][2], const Unit& u, int wr, int wc, int fr, int fq) const {
        const int row0 = u.pm * BM + wr * 64 + fr, col0 = u.pn * BM + wc * 32 + 4 * fq;
#pragma unroll
        for (int ai = 0; ai < 2; ++ai)
#pragma unroll
            for (int m = 0; m < 4; ++m) { const size_t off = (size_t)(row0 + ai * HALF + m * 16) * ldc + col0;
#pragma unroll
                for (int bj = 0; bj < 2; ++bj)
#pragma unroll
                    for (int n = 0; n < 2; ++n) { const f32x4 x = *(const f32x4*)(X + off + bj * HALF + n * 16); *(f32x4*)(S + off + bj * HALF + n * 16) = x * alpha + acc[ai][bj][m][n]; } }
    }
};
struct EpiBf16Grp {
    static constexpr bool PERM = true, AFTER_DRAIN = false;
    bf16_t* O; int ldc; int pn_mask;
    __device__ __forceinline__ void operator()(const f32x4 (&acc)[2][2][4][2], const Unit& u, int wr, int wc, int fr, int fq) const {
        const int row0 = u.pm * BM + wr * 64 + fr, col0 = (u.pn & pn_mask) * BM + wc * 32 + 8 * fq;
#pragma unroll
        for (int ai = 0; ai < 2; ++ai)
#pragma unroll
            for (int m = 0; m < 4; ++m) { bf16_t* rowp = O + (size_t)(row0 + ai * HALF + m * 16) * ldc + col0;
#pragma unroll
                for (int bj = 0; bj < 2; ++bj) { const f32x4 v0 = acc[ai][bj][m][0], v1 = acc[ai][bj][m][1];
                    u32x4 w; w.x = cvt_pk_bf16(v0[0], v0[1]); w.y = cvt_pk_bf16(v0[2], v0[3]); w.z = cvt_pk_bf16(v1[0], v1[1]); w.w = cvt_pk_bf16(v1[2], v1[3]);
                    *(u32x4*)(rowp + bj * HALF) = w; } }
    }
};
template <int NCOL> struct GroupedOrder {
    const PG8_LAS int* tile_e; int ntiles, G, c;
    __device__ __forceinline__ bool next(int i, Unit& u) const {
        const int L = i * G + c; if (L >= ntiles * NCOL) return false;
        const int tile = L / NCOL, j = L % NCOL; u.pm = tile; u.pn = __builtin_amdgcn_readfirstlane(tile_e[tile]) * NCOL + j; return true; }
    __device__ __forceinline__ void a_ready(const Unit&) const {}
    __device__ __forceinline__ void done(const Unit&) const {}
};
template <class Epi, class Sched, bool ALIGN_EPI = false, bool SP2 = false>
__device__ __forceinline__ void gemm_phase(PG8_LAS unsigned char* lds, const Gemm g, const Sched& S, const Epi& E, int wv_) {
    int tid_; asm volatile("v_mbcnt_lo_u32_b32 %0, -1, 0\n\tv_mbcnt_hi_u32_b32 %0, -1, %0\n\tv_lshl_add_u32 %0, %1, 6, %0" : "=&v"(tid_) : "s"(wv_));
    const int tid = tid_, wid = __builtin_amdgcn_readfirstlane(tid >> 6), lane = tid & 63, wr = wid >> 2, wc = wid & 3, fr = lane & 15, fq = lane >> 4;
    const int K = g.K, nt = K / BK;
    unsigned voffA[2], voffB[2];
#pragma unroll
    for (int i = 0; i < 2; ++i) { int R, C; stage_rc(tid * 16 + i * 8192, R, C); const int Rb = Epi::PERM ? ((R & ~31) + perm32(R & 31)) : R;
        voffA[i] = (unsigned)(R * K + C) * 2u; voffB[i] = (unsigned)(Rb * K + C) * 2u; }
    const size_t kstep = (size_t)(BK * 2);
    const size_t hstep = (size_t)HALF * K * 2;
    const size_t tstep = 2 * hstep;
    const unsigned ldsw = (unsigned)wid * 1024u;
    const int aoff = lds_byte(wr * 64 + fr, fq * 8), boff = lds_byte(wc * 32 + fr, fq * 8);
#define PG8_SA(b, h) (((b) * 2 + (h)) * HTB)
#define PG8_SB(b, h) ((4 + (b) * 2 + (h)) * HTB)
#define PG8_STAGE(bufoff, gbase, voff) do { _Pragma("unroll") for (int _i = 0; _i < 2; ++_i) \
        __builtin_amdgcn_global_load_lds((const unsigned*)((const char*)(gbase) + (voff)[_i]), (PG8_LAS unsigned*)(lds + (bufoff) + ldsw + _i * 8192), 16, 0, 0); } while (0)
#define PG8_LDA(dst, b, h) do { _Pragma("unroll") for (int m = 0; m < 4; ++m) _Pragma("unroll") for (int k = 0; k < 2; ++k) dst[m][k] = *(const PG8_LAS bf16x8*)(lds + PG8_SA(b, h) + aoff + m * 2048 + k * 1024); } while (0)
#define PG8_LDB(dst, b, h) do { _Pragma("unroll") for (int n = 0; n < 2; ++n) _Pragma("unroll") for (int k = 0; k < 2; ++k) dst[n][k] = *(const PG8_LAS bf16x8*)(lds + PG8_SB(b, h) + boff + n * 2048 + k * 1024); } while (0)
#define PG8_MMA(ai, bj, At, Bt) do { __builtin_amdgcn_s_setprio(1); _Pragma("unroll") for (int m = 0; m < 4; ++m) _Pragma("unroll") for (int n = 0; n < 2; ++n) _Pragma("unroll") for (int k = 0; k < 2; ++k) \
        acc[ai][bj][m][n] = __builtin_amdgcn_mfma_f32_16x16x32_bf16(Bt[n][k], At[m][k], acc[ai][bj][m][n], 0, 0, 0); __builtin_amdgcn_s_setprio(0); } while (0)
#define PG8_WAIT_V(n) asm volatile("s_waitcnt vmcnt(" #n ")" ::: "memory")
#define PG8_WAIT_L(n) asm volatile("s_waitcnt lgkmcnt(" #n ")" ::: "memory")
#define PG8_BAR __builtin_amdgcn_s_barrier()
#define PG8_SCHED __builtin_amdgcn_sched_barrier(0)
    Unit cur, nxt; int ui = 0;
    if (!S.next(0, cur)) return;
    f32x4 acc[2][2][4][2];
#pragma unroll
    for (int a = 0; a < 2; ++a)
#pragma unroll
        for (int b = 0; b < 2; ++b)
#pragma unroll
            for (int m = 0; m < 4; ++m)
#pragma unroll
                for (int n = 0; n < 2; ++n) acc[a][b][m][n] = (f32x4){0.f, 0.f, 0.f, 0.f};
    bf16x8 At[4][2], B0[2][2], B1[2][2];
    const char* cA = (const char*)g.A + (size_t)cur.pm * tstep; const char* cB = (const char*)g.Bt + (size_t)cur.pn * tstep;
    S.a_ready(cur);
    if constexpr (SP2) {
        PG8_STAGE(PG8_SB(0, 0), cB, voffB); PG8_STAGE(PG8_SB(0, 1), cB + hstep, voffB); PG8_STAGE(PG8_SA(0, 0), cA, voffA); PG8_STAGE(PG8_SA(0, 1), cA + hstep, voffA);
        if (wr == 1) PG8_BAR;
        PG8_WAIT_V(2); PG8_BAR;
        PG8_STAGE(PG8_SB(1, 0), cB + kstep, voffB); PG8_STAGE(PG8_SA(1, 0), cA + kstep, voffA); PG8_STAGE(PG8_SB(1, 1), cB + hstep + kstep, voffB);
        PG8_WAIT_V(6); PG8_BAR;
    } else {
        PG8_STAGE(PG8_SB(0, 0), cB, voffB); PG8_STAGE(PG8_SA(0, 0), cA, voffA); PG8_STAGE(PG8_SB(0, 1), cB + hstep, voffB); PG8_STAGE(PG8_SA(0, 1), cA + hstep, voffA);
        if (wr == 1) PG8_BAR;
        PG8_WAIT_V(4); PG8_BAR;
        PG8_STAGE(PG8_SB(1, 0), cB + kstep, voffB); PG8_STAGE(PG8_SA(1, 0), cA + kstep, voffA); PG8_STAGE(PG8_SB(1, 1), cB + hstep + kstep, voffB);
        PG8_WAIT_V(6); PG8_BAR;
    }
    for (;;) {
        const bool has_next = S.next(ui + 1, nxt);
        const char* nA = has_next ? (const char*)g.A + (size_t)nxt.pm * tstep : cA; const char* nB = has_next ? (const char*)g.Bt + (size_t)nxt.pn * tstep : cB;
#pragma nounroll
        for (int t = 0; t < nt; t += 2) {
            const bool last = (t == nt - 2);
            const char* a1 = cA + (size_t)(t + 1) * kstep;
            const char* a2 = last ? nA : cA + (size_t)(t + 2) * kstep; const char* b2 = last ? nB : cB + (size_t)(t + 2) * kstep;
            const char* a3 = a2 + kstep; const char* b3 = b2 + kstep;
            if (last && has_next) S.a_ready(nxt);
            if constexpr (SP2) {
            PG8_LDB(B0, 0, 0); PG8_LDB(B1, 0, 1); PG8_SCHED; PG8_LDA(At, 0, 0); PG8_STAGE(PG8_SA(1, 1), a1 + hstep, voffA);
            PG8_WAIT_V(8); PG8_WAIT_L(0); PG8_BAR; PG8_MMA(0, 0, At, B0); PG8_MMA(0, 1, At, B1); PG8_BAR; PG8_SCHED;
            PG8_LDA(At, 0, 1); PG8_STAGE(PG8_SB(0, 0), b2, voffB); PG8_STAGE(PG8_SB(0, 1), b2 + hstep, voffB); PG8_STAGE(PG8_SA(0, 0), a2, voffA);
            PG8_WAIT_V(8); PG8_WAIT_L(0); PG8_BAR; PG8_MMA(1, 0, At, B0); PG8_MMA(1, 1, At, B1); PG8_BAR; PG8_SCHED;
            PG8_LDB(B0, 1, 0); PG8_LDB(B1, 1, 1); PG8_SCHED; PG8_LDA(At, 1, 0); PG8_STAGE(PG8_SA(0, 1), a2 + hstep, voffA);
            PG8_WAIT_V(8); PG8_WAIT_L(0); PG8_BAR; PG8_MMA(0, 0, At, B0); PG8_MMA(0, 1, At, B1); PG8_BAR; PG8_SCHED;
            PG8_LDA(At, 1, 1); PG8_STAGE(PG8_SB(1, 0), b3, voffB); PG8_STAGE(PG8_SB(1, 1), b3 + hstep, voffB); PG8_STAGE(PG8_SA(1, 0), a3, voffA);
            PG8_WAIT_V(8); PG8_WAIT_L(0); PG8_BAR; PG8_MMA(1, 0, At, B0); PG8_MMA(1, 1, At, B1); PG8_BAR; PG8_SCHED;
            } else {
            PG8_LDB(B0, 0, 0); PG8_SCHED; PG8_LDA(At, 0, 0); PG8_STAGE(PG8_SA(1, 1), a1 + hstep, voffA);
            PG8_WAIT_L(8); PG8_BAR; PG8_WAIT_L(0); PG8_MMA(0, 0, At, B0); PG8_BAR; PG8_SCHED;
            PG8_LDB(B1, 0, 1); PG8_STAGE(PG8_SB(0, 0), b2, voffB);
            PG8_BAR; PG8_WAIT_L(0); PG8_MMA(0, 1, At, B1); PG8_BAR;
            PG8_LDA(At, 0, 1); PG8_STAGE(PG8_SA(0, 0), a2, voffA);
            PG8_BAR; PG8_WAIT_L(0); PG8_MMA(1, 0, At, B0); PG8_BAR; PG8_SCHED;
            PG8_STAGE(PG8_SB(0, 1), b2 + hstep, voffB);
            PG8_WAIT_V(6); PG8_BAR; PG8_MMA(1, 1, At, B1); PG8_BAR;
            PG8_LDB(B0, 1, 0); PG8_SCHED; PG8_LDA(At, 1, 0); PG8_STAGE(PG8_SA(0, 1), a2 + hstep, voffA);
            PG8_WAIT_L(8); PG8_BAR; PG8_WAIT_L(0); PG8_MMA(0, 0, At, B0); PG8_BAR; PG8_SCHED;
            PG8_LDB(B1, 1, 1); PG8_STAGE(PG8_SB(1, 0), b3, voffB);
            PG8_BAR; PG8_WAIT_L(0); PG8_MMA(0, 1, At, B1); PG8_BAR;
            PG8_LDA(At, 1, 1); PG8_STAGE(PG8_SA(1, 0), a3, voffA);
            PG8_BAR; PG8_WAIT_L(0); PG8_MMA(1, 0, At, B0); PG8_BAR; PG8_SCHED;
            PG8_STAGE(PG8_SB(1, 1), b3 + hstep, voffB);
            PG8_WAIT_V(6); PG8_BAR; PG8_MMA(1, 1, At, B1); PG8_BAR;
            }
        }
        if constexpr (ALIGN_EPI) { if (wr == 0) PG8_BAR; }
        if constexpr (!Epi::AFTER_DRAIN) { E(acc, cur, wr, wc, fr, fq); S.done(cur); }
        if (!has_next) break;
#pragma unroll
        for (int a = 0; a < 2; ++a)
#pragma unroll
            for (int b = 0; b < 2; ++b)
#pragma unroll
                for (int m = 0; m < 4; ++m)
#pragma unroll
                    for (int n = 0; n < 2; ++n) acc[a][b][m][n] = (f32x4){0.f, 0.f, 0.f, 0.f};
        cur = nxt; cA = nA; cB = nB; ++ui;
        if constexpr (ALIGN_EPI) { if (wr == 1) PG8_BAR; }
    }
    PG8_WAIT_V(0);
    if constexpr (!ALIGN_EPI) { if (wr == 0) PG8_BAR; }
    PG8_BAR;
    if constexpr (Epi::AFTER_DRAIN) { E.fused(acc, cur, wr, wc, fr, fq, lds, wid, lane); S.done(cur); }
#undef PG8_SA
#undef PG8_SB
#undef PG8_STAGE
#undef PG8_LDA
#undef PG8_LDB
#undef PG8_MMA
#undef PG8_WAIT_V
#undef PG8_WAIT_L
#undef PG8_BAR
#undef PG8_SCHED
}
}

#define LAS __attribute__((address_space(3)))
#define XB_TMO      128
#define XB_XCNT(j)  (256  + 64 * (j))
#define XB_XSUB(j)  (1280 + 64 * (j))
#define XB_XGEN(j)  (2304 + 64 * (j))
#define XB_TOP      3328
#define XB_TOPGEN   3392
#define XCD_BAR_WORDS 3456
#define XB_SPIN_CAP (1u << 18)
__device__ __forceinline__ unsigned xb_ld(unsigned* p)              { return __hip_atomic_load(p, __ATOMIC_RELAXED, __HIP_MEMORY_SCOPE_AGENT); }
__device__ __forceinline__ unsigned xb_add(unsigned* p, unsigned v) { return __hip_atomic_fetch_add(p, v, __ATOMIC_RELAXED, __HIP_MEMORY_SCOPE_AGENT); }
__device__ __forceinline__ unsigned xb_xcc_id() { return (unsigned)__builtin_amdgcn_s_getreg((3 << 11) | 20) & 0xFu; }
#define XB_SPIN(cond, bar) do { unsigned _sp = 0; while (cond) { __builtin_amdgcn_s_sleep(1); \
    if ((++_sp & 255u) == 0u) { if (xb_ld(&(bar)[XB_TMO])) break; if (_sp > XB_SPIN_CAP) { atomicAdd(&(bar)[XB_TMO], 1u); break; } } } } while (0)
__device__ __forceinline__ int otid(int wv) { int t; asm volatile("v_mbcnt_lo_u32_b32 %0, -1, 0\n\tv_mbcnt_hi_u32_b32 %0, -1, %0\n\tv_lshl_add_u32 %0, %1, 6, %0" : "=&v"(t) : "s"(wv)); return t; }
struct XcdBarrier { unsigned* bar; unsigned x; volatile LAS unsigned* st; int wv; };
__device__ __forceinline__ XcdBarrier xcd_barrier_post(unsigned* bar, volatile LAS unsigned* st, int wv) {
    XcdBarrier b; b.bar = bar; b.x = xb_xcc_id(); b.st = st; b.wv = wv;
    if (threadIdx.x == 0) { (void)xb_add(&bar[XB_XCNT(b.x)], 1u); st[2] = b.x; }
    return b;
}
__device__ __forceinline__ void xcd_barrier_complete(unsigned* bar, unsigned x, unsigned& nloc, unsigned& nx) {
    const unsigned G = gridDim.x * gridDim.y * gridDim.z;
    unsigned sum, cnt, mine, sp = 0u;
    for (;;) {
        sum = 0u; cnt = 0u; mine = 0u;
#pragma unroll
        for (unsigned j = 0; j < 16; ++j) { const unsigned c = xb_ld(&bar[XB_XCNT(j)]); sum += c; cnt += (c > 0u) ? 1u : 0u; mine = (j == x) ? c : mine; }
        if (sum == G) break;
        __builtin_amdgcn_s_sleep(1);
        if ((++sp & 255u) == 0u) { if (xb_ld(&bar[XB_TMO])) break; if (sp > XB_SPIN_CAP) { atomicAdd(&bar[XB_TMO], 1u); break; } }
    }
    nloc = mine > 0u ? mine : 1u; nx = cnt > 0u ? cnt : 1u;
}
__device__ __forceinline__ void xcd_barrier(const XcdBarrier& b) {
    asm volatile("s_waitcnt vmcnt(0)" ::: "memory");
    __syncthreads();
    if (otid(b.wv) == 0) {
        unsigned* bar = b.bar;
        __builtin_amdgcn_s_waitcnt(0);
        unsigned nloc = b.st[0], nx = b.st[1]; const unsigned bx = b.st[2];
        if (nloc == 0u) { xcd_barrier_complete(bar, bx, nloc, nx); b.st[0] = nloc; b.st[1] = nx; }
        const unsigned old = xb_add(&bar[XB_XSUB(bx)], 1u);
        const unsigned gen = old / nloc;
        if (old + 1u == (gen + 1u) * nloc) {
            __builtin_amdgcn_fence(__ATOMIC_RELEASE, "agent");
            asm volatile("s_waitcnt vmcnt(0)" ::: "memory");
            const unsigned og = xb_add(&bar[XB_TOP], 1u);
            const unsigned tg = og / nx;
            if (og + 1u == (tg + 1u) * nx) xb_add(&bar[XB_TOPGEN], 1u);
            else XB_SPIN(xb_ld(&bar[XB_TOPGEN]) == tg, bar);
            __builtin_amdgcn_fence(__ATOMIC_ACQUIRE, "agent");
            xb_add(&bar[XB_XGEN(bx)], 1u);
            asm volatile("s_waitcnt vmcnt(0)" ::: "memory");
        } else {
            XB_SPIN(xb_ld(&bar[XB_XGEN(bx)]) == gen, bar);
            __builtin_amdgcn_fence(__ATOMIC_ACQUIRE, "agent");
            asm volatile("s_waitcnt vmcnt(0)" ::: "memory");
        }
    }
    __syncthreads();
}
constexpr int CW_BAR = 4096;

constexpr int RING_BYTES = 131072;
constexpr int MISC_OFF = RING_BYTES;
constexpr int LDS_BYTES = 147456;

struct Args { const float* in[39]; float* out; unsigned char* ws; };
__device__ __forceinline__ int lnd(int v) { asm volatile("" : "+s"(v)); return v; }
#ifdef GEMM_ONLY
#define VBL(nvb, vbsz) for (int vb = 0, vt = 0; vb < 0;)
#else
#define VBL(nvb, vbsz) for (int _t = otid(c.wv), _g = lnd((int)gridDim.x), vb = lnd((int)blockIdx.x) * (512 / (vbsz)) + _t / (vbsz), vt = _t % (vbsz); vb < (nvb); vb += _g * (512 / (vbsz)))
#endif

__device__ __forceinline__ void tr_item(const float* __restrict__ W, int ldw, int K, int nblk, bf16_t* __restrict__ WT, int interleave, int row_off, LAS float* scr, int item, int lane) {
    const int kb = item / nblk, nb = item % nblk, k0 = 64 * kb, n0 = 32 * nb;
#pragma unroll 8
    for (int i = 0; i < 32; ++i) { const int kk = 2 * i + (lane >> 5); scr[kk * 33 + (lane & 31)] = W[(size_t)(k0 + kk) * ldw + n0 + (lane & 31)]; }
    asm volatile("s_waitcnt lgkmcnt(0)" ::: "memory");
    const int c = lane & 7;
    const int dr0 = interleave ? ((n0 >> 7) * 256 + (n0 & 127) + row_off) : (n0 + row_off);
#pragma unroll
    for (int j = 0; j < 4; ++j) { const int n = (lane >> 3) + 8 * j; const LAS float* sp = scr + (8 * c) * 33 + n;
        uint4 o; o.x = (unsigned)f2bf(sp[0 * 33]) | ((unsigned)f2bf(sp[1 * 33]) << 16); o.y = (unsigned)f2bf(sp[2 * 33]) | ((unsigned)f2bf(sp[3 * 33]) << 16);
        o.z = (unsigned)f2bf(sp[4 * 33]) | ((unsigned)f2bf(sp[5 * 33]) << 16); o.w = (unsigned)f2bf(sp[6 * 33]) | ((unsigned)f2bf(sp[7 * 33]) << 16);
        *(uint4*)(WT + (size_t)(dr0 + n) * K + k0 + 8 * c) = o; }
    asm volatile("s_waitcnt lgkmcnt(0)" ::: "memory");
}
struct Ctx { volatile LAS unsigned long long* tab; unsigned char* ws0; float* X; LAS unsigned char* lds; int wv; };
__device__ __forceinline__ const float* inp(const Ctx& c, int k) { volatile LAS unsigned long long* tp = c.tab; asm volatile("" : "+s"(tp)); const unsigned long long v = tp[k]; const unsigned lo = __builtin_amdgcn_readfirstlane((unsigned)v), hi = __builtin_amdgcn_readfirstlane((unsigned)(v >> 32));
    return (const float*)(((unsigned long long)hi << 32) | lo); }
__device__ __forceinline__ unsigned char* wsl(const Ctx& c) { unsigned char* w = c.ws0; asm volatile("" : "+s"(w)); return w; }
#define WBF(off) ((bf16_t*)(w + (off)))
#define WF32(off) ((float*)(w + (off)))

__device__ __forceinline__ void phase_weights(const Ctx& c, int l) {
    unsigned char* w = wsl(c);
    const int tid = otid(c.wv), lane = tid & 63, wave = tid >> 6;
    LAS float* scr = (LAS float*)(c.lds + wave * 16384);
    const int gw = lnd((int)blockIdx.x) * 8 + wave, NGW = lnd((int)gridDim.x) * 8;
    constexpr int I_IN = (D / 64) * (NPROJ / 32), I_GLU = (DSS / 64) * (DSS / 32), I_UP = (DR / 64) * (D / 32), I_OUT = (D / 64) * (D / 32), I_EG = (D / 64) * (DE / 32), I_ED = (DE / 64) * (D / 32);
    constexpr int I_E = 2 * I_EG + I_ED;
    constexpr int NITEMS = I_IN + 2 * I_GLU + 3 * I_UP + I_OUT + NE * I_E;
    for (int it = gw; it < NITEMS; it += NGW) {
        int r = it;
        if (r < I_IN) { tr_item(inp(c, 1) + (size_t)l * D * NPROJ, NPROJ, D, NPROJ / 32, WBF(WS_WT_IN), 0, 0, scr, r, lane); continue; } r -= I_IN;
        if (r < 2 * I_GLU) { const int hf = r / I_GLU; tr_item(inp(c, 21) + (size_t)l * DSS * 2 * DSS + hf * DSS, 2 * DSS, DSS, DSS / 32, WBF(WS_WT_GLU), 1, hf * 128, scr, r % I_GLU, lane); continue; } r -= 2 * I_GLU;
        if (r < 3 * I_UP) { const int br = r / I_UP; tr_item(inp(c, 23 + br) + (size_t)l * DR * D, D, DR, D / 32, WBF(WS_WT_UPA + (size_t)br * MiB), 0, 0, scr, r % I_UP, lane); continue; } r -= 3 * I_UP;
        if (r < I_OUT) { tr_item(inp(c, 27) + (size_t)l * D * D, D, D, D / 32, WBF(WS_WT_OUT), 0, 0, scr, r, lane); continue; } r -= I_OUT;
        const int e = r / I_E; r %= I_E; const size_t eo = ((size_t)l * NE + e) * D * DE;
        if (r < 2 * I_EG) { const int hf = r / I_EG; tr_item(inp(c, 34 + hf) + eo, DE, D, DE / 32, WBF(WS_WT_EGU) + (size_t)e * 512 * D, 1, hf * 128, scr, r % I_EG, lane); continue; } r -= 2 * I_EG;
        tr_item(inp(c, 36) + eo, D, DE, D / 32, WBF(WS_WT_ED) + (size_t)e * D * DE, 0, 0, scr, r, lane);
    }
    VBL(36 * 1024 / 256, 256) k_rtw(vb, vt, inp(c, 30) + (size_t)l * D * 4, inp(c, 32) + (size_t)l * D * 32, WF32(WS_SMALL + SM_RTW));
    VBL(NGR * SST / 256, 256) k_s5tab(vb, vt, inp(c, 13) + (size_t)l * NGR * SST, inp(c, 14) + (size_t)l * NGR * SST, inp(c, 15) + (size_t)l * NGR * SST * SGRP,
                                      inp(c, 16) + (size_t)l * NGR * SST * SGRP, inp(c, 20) + (size_t)l * NGR, WF32(WS_SMALL + SM_LAM), WF32(WS_SMALL + SM_BB));
}

#define GB() xcd_barrier(bar)
template <int l> __device__ __forceinline__ void layer_body(const Ctx& c, const XcdBarrier& bar, LAS unsigned char* lds, unsigned char* lds_raw, volatile LAS unsigned* MISC, int G) {
        { unsigned char* w = wsl(c);
          pg8::Gemm g{WBF(WS_XN), WBF(WS_WT_IN), T, NPROJ, D}; pg8::StaticOrder S; S.init(T, NPROJ, lnd(G), lnd((int)blockIdx.x));
          pg8::EpiBf16<0> E{WBF(WS_PROJ), NPROJ, nullptr, 0, 0, 1.f};
          pg8::gemm_phase<pg8::EpiBf16<0>, pg8::StaticOrder, true, true>(lds, g, S, E, c.wv); }
        GB();
        { unsigned char* w = wsl(c);
          VBL(T, 512) k_prep(vb, vt, WBF(WS_PROJ), inp(c, 2) + (size_t)l * 1792, inp(c, 3) + (size_t)l * DR, inp(c, 4) + (size_t)l * 64 * DR, inp(c, 5) + (size_t)l * DR, inp(c, 6) + (size_t)l * 64 * DR,
                           inp(c, 7) + (size_t)l * 128 * DR, inp(c, 8) + (size_t)l * DR, inp(c, 9) + (size_t)l * DR, WBF(WS_R), WBF(WS_KP), WBF(WS_V), WBF(WS_KK), WBF(WS_AA), WBF(WS_GG), WF32(WS_LW), (float*)lds_raw);
          VBL(NB * MH * NBLK * HD / 256, 256) k_kmean(vb, vt, WBF(WS_PROJ), WF32(WS_SMALL + SM_KMEAN)); }
        GB();
        { unsigned char* w = wsl(c);
          VBL(NB * RH * 64 / 4, 256) k_wkv(vb, vt, WBF(WS_R), WBF(WS_KP), WBF(WS_V), WBF(WS_KK), WBF(WS_AA), WF32(WS_LW), WF32(WS_YRAW)); }
        { unsigned char* w = wsl(c);
          VBL(NB * NGR, 64) k_s5(vb, vt, WBF(WS_PROJ), WF32(WS_SMALL + SM_LAM), WF32(WS_SMALL + SM_BB), inp(c, 17) + (size_t)l * NGR * SGRP * SST, inp(c, 18) + (size_t)l * NGR * SGRP * SST, inp(c, 19) + (size_t)l * DSS, WBF(WS_YCPRE)); }
        { unsigned char* w = wsl(c);
          VBL(T * MH / 4, 256) k_moba(vb, vt, WBF(WS_PROJ), WF32(WS_SMALL + SM_KMEAN), WBF(WS_YB)); }
        GB();
        { unsigned char* w = wsl(c);
          VBL(T, 512) k_wkvpost(vb, vt, WF32(WS_YRAW), WBF(WS_R), WBF(WS_KP), WBF(WS_V), WBF(WS_GG), inp(c, 10) + (size_t)l * DR, inp(c, 11) + (size_t)l * DR, inp(c, 12) + (size_t)l * DR, WBF(WS_YA)); }
        { unsigned char* w = wsl(c);
          pg8::Gemm g{WBF(WS_YCPRE), WBF(WS_WT_GLU), T, 2 * DSS, DSS}; pg8::StaticOrder S; S.init(T, 2 * DSS, lnd(G), lnd((int)blockIdx.x));
          pg8::EpiGated<0> E{WBF(WS_YC), DSS, inp(c, 22) + (size_t)l * 2 * DSS, DSS, 3};
          pg8::gemm_phase<pg8::EpiGated<0>, pg8::StaticOrder, true, true>(lds, g, S, E, c.wv); }
        GB();
        for (int br = 0; br < 3; ++br) { unsigned char* w = wsl(c);
            pg8::Gemm g{WBF(WS_YA + (size_t)br * 16 * MiB), WBF(WS_WT_UPA + (size_t)br * MiB), T, D, DR}; pg8::StaticOrder S; S.init(T, D, lnd(G), lnd((int)blockIdx.x));
            pg8::EpiUp E{WBF(WS_PROJ) + OFF_GATE + br * D, NPROJ, inp(c, 26) + (size_t)l * 3 * D + br * D, WF32(WS_MERGED), WBF(WS_MERGEDB), D, br};
            pg8::gemm_phase<pg8::EpiUp, pg8::StaticOrder, true, true>(lds, g, S, E, c.wv);
        }
        GB();
        { unsigned char* w = wsl(c);
          pg8::Gemm g{WBF(WS_MERGEDB), WBF(WS_WT_OUT), T, D, D}; pg8::StaticOrder S; S.init(T, D, lnd(G), lnd((int)blockIdx.x));
          pg8::EpiOut E{c.X, WF32(WS_S), D, ALPHA};
          pg8::gemm_phase<pg8::EpiOut, pg8::StaticOrder, true, true>(lds, g, S, E, c.wv); }
        GB();
        { unsigned char* w = wsl(c); unsigned* cnt = (unsigned*)(w + WS_CTL) + CW_CNT + l * 64;
          VBL(T / 4, 256) k_ln1route(vb, vt, WF32(WS_S), inp(c, 28) + (size_t)l * D, inp(c, 29) + (size_t)l * D, c.X, WBF(WS_XN), WF32(WS_SMALL + SM_RTW), inp(c, 31) + (size_t)l * 4, inp(c, 33) + (size_t)l * 32, cnt,
                                     (int*)(w + WS_ROUTE + RT_EID), (int*)(w + WS_ROUTE + RT_POS), (float*)(w + WS_ROUTE + RT_WGT), (float*)lds_raw); }
        GB();
        { unsigned char* w = wsl(c); unsigned* cnt = (unsigned*)(w + WS_CTL) + CW_CNT + l * 64;
          VBL(T / 4, 256) k_gather(vb, vt, WBF(WS_XN), cnt, (int*)(w + WS_ROUTE + RT_EID), (int*)(w + WS_ROUTE + RT_POS), (int*)(w + WS_ROUTE + RT_SLOT), WBF(WS_XG));
          if (otid(c.wv) == 0) { int nt = 0;
#pragma unroll 1
              for (int e = 0; e < NE; ++e) { const int te = ((int)cnt[e] + 255) >> 8;
#pragma unroll 1
                  for (int q = 0; q < te; ++q) MISC[16 + nt + q] = (unsigned)e;
                  nt += te; }
              MISC[8] = (unsigned)nt; } }
        GB();
        { unsigned char* w = wsl(c); const int ntiles = (int)MISC[8];
          pg8::Gemm g{WBF(WS_XG), WBF(WS_WT_EGU), MAXSLOT, NE * 512, D}; pg8::GroupedOrder<2> S{(const LAS int*)(lds + MISC_OFF + 64), ntiles, lnd(G), lnd((int)blockIdx.x)};
          pg8::EpiGated<1> E{WBF(WS_HID), DE, nullptr, 0, 1};
          pg8::gemm_phase<pg8::EpiGated<1>, pg8::GroupedOrder<2>, true, true>(lds, g, S, E, c.wv); }
        GB();
        { unsigned char* w = wsl(c); const int ntiles = (int)MISC[8];
          pg8::Gemm g{WBF(WS_HID), WBF(WS_WT_ED), MAXSLOT, NE * D, DE}; pg8::GroupedOrder<4> S{(const LAS int*)(lds + MISC_OFF + 64), ntiles, lnd(G), lnd((int)blockIdx.x)};
          pg8::EpiBf16Grp E{WBF(WS_YG), D, 3};
          pg8::gemm_phase<pg8::EpiBf16Grp, pg8::GroupedOrder<4>, true, true>(lds, g, S, E, c.wv); }
        GB();
        { unsigned char* w = wsl(c);
          VBL(T / 4, 256) k_ln2(vb, vt, WBF(WS_YG), (int*)(w + WS_ROUTE + RT_SLOT), (float*)(w + WS_ROUTE + RT_WGT), inp(c, 37) + (size_t)l * D, inp(c, 38) + (size_t)l * D, c.X, WBF(WS_XN)); }
        if (l + 1 < DEPTH) phase_weights(c, l + 1);
        GB();
}

__global__ void __launch_bounds__(512, 2) mega(Args a) {
    extern __shared__ __attribute__((aligned(16))) unsigned char lds_raw[];
    LAS unsigned char* lds = (LAS unsigned char*)lds_raw;
    volatile LAS unsigned* MISC = (volatile LAS unsigned*)(lds + MISC_OFF);
    Ctx c; c.tab = (volatile LAS unsigned long long*)(lds + MISC_OFF + 1024); c.ws0 = a.ws; c.X = a.out; c.lds = lds;
    c.wv = __builtin_amdgcn_readfirstlane((int)threadIdx.x >> 6);
    if (threadIdx.x < 16) MISC[threadIdx.x] = 0u;
    if (threadIdx.x < 39) c.tab[threadIdx.x] = (unsigned long long)a.in[threadIdx.x];
    __syncthreads();
    XcdBarrier bar = xcd_barrier_post((unsigned*)(a.ws + WS_CTL) + CW_BAR, MISC, c.wv);
    const int G = (int)gridDim.x;
    { unsigned char* w = wsl(c); VBL(T * D / 256, 256) k_x0(vb, vt, inp(c, 0), c.X, WBF(WS_XN)); }
    phase_weights(c, 0);
    GB();
    layer_body<0>(c, bar, lds, lds_raw, MISC, G);
    layer_body<1>(c, bar, lds, lds_raw, MISC, G);
    layer_body<2>(c, bar, lds, lds_raw, MISC, G);
    layer_body<3>(c, bar, lds, lds_raw, MISC, G);
}

extern "C" void kernel_launch(void* const* d_in, const int* in_sizes, int n_in, void* d_out, int out_size, void* d_ws, size_t ws_size, hipStream_t stream) {
    static int grid = 0;
    if (grid == 0) {
        if (n_in != 39 || out_size != T * D || ws_size < WS_END) { fprintf(stderr, "kernel_launch: unexpected shapes n_in %d out %d ws %zu\n", n_in, out_size, ws_size); grid = -1; return; }
        int dev = 0, cus = 0, per_cu = 0;
        if (hipGetDevice(&dev) != hipSuccess || hipDeviceGetAttribute(&cus, hipDeviceAttributeMultiprocessorCount, dev) != hipSuccess) { grid = -1; return; }
        if (hipFuncSetAttribute((const void*)mega, hipFuncAttributeMaxDynamicSharedMemorySize, LDS_BYTES) != hipSuccess) { fprintf(stderr, "kernel_launch: hipFuncSetAttribute failed\n"); grid = -1; return; }
        if (hipOccupancyMaxActiveBlocksPerMultiprocessor(&per_cu, (const void*)mega, 512, LDS_BYTES) != hipSuccess || per_cu < 1) fprintf(stderr, "kernel_launch: occupancy query says %d\n", per_cu);
        (void)hipGetLastError();
        grid = cus;
        fprintf(stderr, "kernel_launch: grid %d, ws %zu\n", grid, ws_size);
    }
    if (grid < 0) return;
    (void)hipMemsetAsync((char*)d_ws + WS_CTL, 0, CTL_BYTES, stream);
    Args a{};
    for (int i = 0; i < 39; ++i) a.in[i] = (const float*)d_in[i];
    a.out = (float*)d_out; a.ws = (unsigned char*)d_ws;
    hipLaunchKernelGGL(mega, dim3(grid), dim3(512), LDS_BYTES, stream, a);
}
```

```cpp
#include <hip/hip_runtime.h>
#include <cstdio>
#include <cstdint>
#include <cmath>

typedef unsigned short bf16_t;
typedef short bf16x8 __attribute__((ext_vector_type(8)));
typedef float f32x4 __attribute__((ext_vector_type(4)));
typedef unsigned u32x4_t __attribute__((ext_vector_type(4)));

constexpr int NB = 4, SEQ = 4096, T = NB * SEQ, D = 1024, DEPTH = 4, HD = 64;
constexpr int DR = 512, RH = 8, DMO = 512, MH = 8, DSS = 512, SGRP = 16, NGR = 32, SST = 64;
constexpr int OFF_MOBA = 1792, OFF_SSM = 3328, OFF_GATE = 3840, NPROJ = 6912;
constexpr int MBLK = 256, NBLK = SEQ / MBLK;
constexpr int NE = 32, EPG = 8, NGRP = 4, DE = 256;
constexpr int MAXSLOT = 40960;
constexpr float LN_EPS = 1e-5f, GN_EPS = 64e-5f;
constexpr float ALPHA = 1.6817928305074290f;

constexpr size_t MiB = 1u << 20;
constexpr size_t WS_CTL = 0, CTL_BYTES = 1 * MiB;
constexpr size_t WS_SMALL = 1 * MiB;
constexpr size_t WS_WT_IN = 4 * MiB, WS_WT_GLU = 18 * MiB, WS_WT_UPA = 19 * MiB, WS_WT_UPB = 20 * MiB, WS_WT_UPC = 21 * MiB,
                 WS_WT_OUT = 22 * MiB, WS_WT_EGU = 24 * MiB, WS_WT_ED = 56 * MiB;
constexpr size_t WS_PROJ = 72 * MiB;
constexpr size_t WS_XN = 288 * MiB;
constexpr size_t WS_R = 320 * MiB, WS_KP = 336 * MiB, WS_V = 352 * MiB, WS_KK = 368 * MiB, WS_AA = 384 * MiB, WS_GG = 400 * MiB;
constexpr size_t WS_LW = 416 * MiB;
constexpr size_t WS_YRAW = 448 * MiB;
constexpr size_t WS_YA = 480 * MiB, WS_YB = 496 * MiB, WS_YC = 512 * MiB, WS_YCPRE = 528 * MiB;
constexpr size_t WS_ROUTE = 544 * MiB;
constexpr size_t WS_END = 548 * MiB;
constexpr size_t WS_MERGED = 320 * MiB;
constexpr size_t WS_MERGEDB = 384 * MiB;
constexpr size_t WS_S = 416 * MiB;
constexpr size_t WS_XG = 72 * MiB;
constexpr size_t WS_HID = 152 * MiB;
constexpr size_t WS_YG = 172 * MiB;
constexpr size_t SM_LAM = 0;
constexpr size_t SM_BB = 16384;
constexpr size_t SM_KMEAN = 16384 + 262144;
constexpr size_t SM_RTW = SM_KMEAN + 131072;
constexpr size_t RT_EID = 0, RT_POS = 131072, RT_SLOT = 262144, RT_WGT = 393216;
constexpr int CW_CNT = 1024;

__device__ __forceinline__ float bf2f(bf16_t h) { return __uint_as_float(((unsigned)h) << 16); }
__device__ __forceinline__ bf16_t f2bf(float f) { unsigned u = __float_as_uint(f); return (bf16_t)((u + 0x7fffu + ((u >> 16) & 1u)) >> 16); }
template <int CTRL, int RMASK> __device__ __forceinline__ float dpp_f(float oldv, float v) {
    return __builtin_bit_cast(float, __builtin_amdgcn_update_dpp(__builtin_bit_cast(int, oldv), __builtin_bit_cast(int, v), CTRL, RMASK, 0xF, false)); }
__device__ __forceinline__ float wave_allsum(float v) {
    v += dpp_f<0xB1, 0xF>(0.f, v);
    v += dpp_f<0x4E, 0xF>(0.f, v);
    v += dpp_f<0x141, 0xF>(0.f, v);
    v += dpp_f<0x140, 0xF>(0.f, v);
    v += dpp_f<0x142, 0xA>(0.f, v);
    v += dpp_f<0x143, 0xC>(0.f, v);
    return __builtin_bit_cast(float, __builtin_amdgcn_readlane(__builtin_bit_cast(int, v), 63));
}
__device__ __forceinline__ float wave_allmax(float v) {
    v = fmaxf(v, dpp_f<0xB1, 0xF>(v, v)); v = fmaxf(v, dpp_f<0x4E, 0xF>(v, v)); v = fmaxf(v, dpp_f<0x141, 0xF>(v, v)); v = fmaxf(v, dpp_f<0x140, 0xF>(v, v));
    v = fmaxf(v, dpp_f<0x142, 0xA>(v, v)); v = fmaxf(v, dpp_f<0x143, 0xC>(v, v));
    return __builtin_bit_cast(float, __builtin_amdgcn_readlane(__builtin_bit_cast(int, v), 63));
}
__device__ __forceinline__ float lane_bcast(float v, int l) { return __builtin_bit_cast(float, __builtin_amdgcn_readlane(__builtin_bit_cast(int, v), l)); }
__device__ __forceinline__ float sigmoidf_(float x) { return 1.f / (1.f + __expf(-x)); }
__device__ __forceinline__ float gelu_tanh(float x) { const float u = 0.7978845608028654f * (x + 0.044715f * x * x * x); return 0.5f * x * (1.f + tanhf(u)); }

__device__ __forceinline__ void k_cvt(int vb, int vt, const float* __restrict__ W, int ldw, int K, int Nsub, bf16_t* __restrict__ WT, int interleave, int row_off) {
    const long i = (long)vb * 256 + vt;
    if (i >= (long)K * Nsub) return;
    const int n = (int)(i / K), k = (int)(i % K);
    const int dr = interleave ? ((n >> 7) * 256 + (n & 127) + row_off) : (n + row_off);
    WT[(size_t)dr * K + k] = f2bf(W[(size_t)k * ldw + n]);
}
__device__ __forceinline__ void k_rtw(int vb, int vt, const float* __restrict__ gw, const float* __restrict__ ew, float* __restrict__ RTW) {
    const int i = vb * 256 + vt;
    if (i >= 36 * 1024) return;
    const int j = i / 1024, k = i % 1024;
    RTW[i] = j < 4 ? gw[k * 4 + j] : ew[k * 32 + (j - 4)];
}
__device__ __forceinline__ void k_s5tab(int vb, int vt, const float* __restrict__ a_re, const float* __restrict__ a_im, const float* __restrict__ b_re, const float* __restrict__ b_im,
                        const float* __restrict__ log_dt, float* __restrict__ LAM, float* __restrict__ BB) {
    const int i = vb * 256 + vt;
    if (i >= NGR * SST) return;
    const int g = i / SST;
    const float dt = expf(log_dt[g]);
    const float are = a_re[i], aim = a_im[i];
    const float mag = expf(are * dt);
    const float ang = aim * dt;
    const float lre = mag * cosf(ang), lim = mag * sinf(ang);
    const float den = are * are + aim * aim, nr = lre - 1.0f;
    const float cre = (nr * are + lim * aim) / den, cim = (lim * are - nr * aim) / den;
    LAM[i * 2] = lre; LAM[i * 2 + 1] = lim;
    for (int h = 0; h < SGRP; ++h) {
        const float bre = b_re[i * SGRP + h], bim = b_im[i * SGRP + h];
        BB[(i * SGRP + h) * 2] = cre * bre - cim * bim;
        BB[(i * SGRP + h) * 2 + 1] = cre * bim + cim * bre;
    }
}
__device__ __forceinline__ void k_x0(int vb, int vt, const float* __restrict__ x, float* __restrict__ X, bf16_t* __restrict__ XN) {
    const long i = (long)vb * 256 + vt;
    if (i >= (long)T * D) return;
    const float v = x[i]; X[i] = v; XN[i] = f2bf(v);
}

template <class Epi, bool PAIR>
__device__ __forceinline__ void k_gemm(int vbx, int vby, int vt, const bf16_t* __restrict__ A, const bf16_t* __restrict__ Bt, int K, Epi E) {
    const int wave = vt >> 6, lane = vt & 63, fr = lane & 15, fq = lane >> 4;
    const int rt = vby;
    if (!E.active(rt)) return;
    const bf16_t* B2 = Bt + E.bt_off(rt);
    const int row0 = rt * 64 + (wave >> 1) * 32;
    int colA, colB = 0, ch0 = 0;
    if (PAIR) { ch0 = vbx * 64 + (wave & 1) * 32; colA = (ch0 >> 7) * 256 + (ch0 & 127); colB = colA + 128; }
    else colA = vbx * 64 + (wave & 1) * 32;
    f32x4 acc[2][2], acc2[2][2];
#pragma unroll
    for (int i = 0; i < 2; ++i)
#pragma unroll
        for (int j = 0; j < 2; ++j) { acc[i][j] = (f32x4){0.f, 0.f, 0.f, 0.f}; acc2[i][j] = (f32x4){0.f, 0.f, 0.f, 0.f}; }
    for (int k0 = 0; k0 < K; k0 += 32) {
        bf16x8 a[2], b[2], b2[2];
#pragma unroll
        for (int i = 0; i < 2; ++i) a[i] = *(const bf16x8*)(A + (size_t)(row0 + i * 16 + fr) * K + k0 + fq * 8);
#pragma unroll
        for (int j = 0; j < 2; ++j) b[j] = *(const bf16x8*)(B2 + (size_t)(colA + j * 16 + fr) * K + k0 + fq * 8);
        if (PAIR) {
#pragma unroll
            for (int j = 0; j < 2; ++j) b2[j] = *(const bf16x8*)(B2 + (size_t)(colB + j * 16 + fr) * K + k0 + fq * 8);
        }
#pragma unroll
        for (int i = 0; i < 2; ++i)
#pragma unroll
            for (int j = 0; j < 2; ++j) {
                acc[i][j] = __builtin_amdgcn_mfma_f32_16x16x32_bf16(a[i], b[j], acc[i][j], 0, 0, 0);
                if (PAIR) acc2[i][j] = __builtin_amdgcn_mfma_f32_16x16x32_bf16(a[i], b2[j], acc2[i][j], 0, 0, 0);
            }
    }
#pragma unroll
    for (int i = 0; i < 2; ++i)
#pragma unroll
        for (int j = 0; j < 2; ++j)
#pragma unroll
            for (int r = 0; r < 4; ++r) {
                const int row = row0 + i * 16 + fq * 4 + r;
                if (PAIR) E.store2(row, ch0 + j * 16 + fr, acc[i][j][r], acc2[i][j][r]);
                else E.store(row, colA + j * 16 + fr, acc[i][j][r]);
            }
}
struct EDense { __device__ bool active(int) const { return true; } __device__ size_t bt_off(int) const { return 0; } };
struct EProj : EDense { bf16_t* P; __device__ void store(int r, int c, float v) const { P[(size_t)r * NPROJ + c] = f2bf(v); } __device__ void store2(int, int, float, float) const {} };
struct EGlu : EDense { bf16_t* YC; const float* bias;
    __device__ void store(int, int, float) const {}
    __device__ void store2(int r, int ch, float v, float g) const { YC[(size_t)r * DSS + ch] = f2bf((v + bias[ch]) * sigmoidf_(g + bias[DSS + ch])); } };
struct EUp : EDense { const bf16_t* P; const float* gate_b; float* M; bf16_t* MB; int br;
    __device__ void store2(int, int, float, float) const {}
    __device__ void store(int r, int c, float v) const {
        const float gl = bf2f(P[(size_t)r * NPROJ + OFF_GATE + br * D + c]) + gate_b[br * D + c];
        float m = sigmoidf_(gl) * v; const size_t o = (size_t)r * D + c;
        if (br > 0) m += M[o];
        M[o] = m; if (br == 2) MB[o] = f2bf(m); } };
struct EOut : EDense { const float* X; float* S;
    __device__ void store2(int, int, float, float) const {}
    __device__ void store(int r, int c, float v) const { const size_t o = (size_t)r * D + c; S[o] = ALPHA * X[o] + v; } };
struct EGrouped { const unsigned* cnt; int rows_per_e;
    __device__ int expert_of(int rt, bool& ok) const {
        int off = 0; const int r0 = rt * 64;
        for (int e = 0; e < NE; ++e) { const int p = ((int)cnt[e] + 255) & ~255; if (r0 < off + p) { ok = true; return e; } off += p; }
        ok = false; return 0; }
    __device__ bool active(int rt) const { bool ok; expert_of(rt, ok); return ok; }
};
struct ESwi : EGrouped { bf16_t* HID;
    __device__ size_t bt_off(int rt) const { bool ok; const int e = expert_of(rt, ok); return (size_t)e * 512 * D; }
    __device__ void store(int, int, float) const {}
    __device__ void store2(int r, int ch, float g, float u) const { HID[(size_t)r * DE + ch] = f2bf(g * sigmoidf_(g) * u); } };
struct EDown : EGrouped { bf16_t* YG;
    __device__ size_t bt_off(int rt) const { bool ok; const int e = expert_of(rt, ok); return (size_t)e * D * DE; }
    __device__ void store2(int, int, float, float) const {}
    __device__ void store(int r, int c, float v) const { YG[(size_t)r * D + c] = f2bf(v); } };

__device__ __forceinline__ void k_prep(int vb, int vt, const bf16_t* __restrict__ P, const float* __restrict__ mu, const float* __restrict__ w0, const float* __restrict__ w2,
        const float* __restrict__ a0, const float* __restrict__ a2, const float* __restrict__ g2, const float* __restrict__ k_k, const float* __restrict__ k_a,
        bf16_t* R, bf16_t* KP, bf16_t* V, bf16_t* KK, bf16_t* AA, bf16_t* GG, float* LW, float* act) {
    const int t = vb, c = vt;
    const bool first = (t % SEQ) == 0;
    const bf16_t* row = P + (size_t)t * NPROJ; const bf16_t* prow = row - NPROJ;
    auto zs = [&](int col) -> float { const float z = bf2f(row[col]); const float zp = first ? 0.f : bf2f(prow[col]); return z + (zp - z) * mu[col]; };
    if (c < 256) { const float z = zs(1536 + c); act[c] = c < 64 ? tanhf(z) : (c < 128 ? z : sigmoidf_(z)); }
    __syncthreads();
    const float r = zs(c), k = zs(512 + c), v = zs(1024 + c);
    float sw = 0.f, sa = 0.f, sg = 0.f;
#pragma unroll 4
    for (int i = 0; i < 64; ++i) { sw += act[i] * w2[i * DR + c]; sa += act[64 + i] * a2[i * DR + c]; }
#pragma unroll 4
    for (int i = 0; i < 128; ++i) sg += act[128 + i] * g2[i * DR + c];
    const float xx = -(w0[c] + sw);
    const float sp = fmaxf(xx, 0.f) + log1pf(expf(-fabsf(xx)));
    const float wl = -sp - 0.5f;
    const float lw = -expf(wl);
    const float a = sigmoidf_(a0[c] + sa);
    const float kk = k * k_k[c];
    const float ss = wave_allsum(kk * kk);
    const float kkn = kk * rsqrtf(fmaxf(ss, 1e-24f));
    const float kp = k * (1.f + (a - 1.f) * k_a[c]);
    const size_t o = (size_t)t * DR + c;
    R[o] = f2bf(r); KP[o] = f2bf(kp); V[o] = f2bf(v); KK[o] = f2bf(kkn); AA[o] = f2bf(a); GG[o] = f2bf(sg); LW[o] = lw;
    __syncthreads();
}
__device__ __forceinline__ void k_wkv(int vb, int vt, const bf16_t* __restrict__ R, const bf16_t* __restrict__ KP, const bf16_t* __restrict__ V, const bf16_t* __restrict__ KK,
        const bf16_t* __restrict__ AA, const float* __restrict__ LW, float* __restrict__ YRAW) {
    const int gwv = vb * 4 + (vt >> 6), j = vt & 63;
    const int i = gwv & 63, h = (gwv >> 6) & 7, b = gwv >> 9;
    float S = 0.f;
    for (int t = 0; t < SEQ; ++t) {
        const size_t o = (size_t)(b * SEQ + t) * DR + h * 64;
        const float r = bf2f(R[o + j]), w = __expf(LW[o + j]), k = bf2f(KP[o + j]), kk = bf2f(KK[o + j]), a = bf2f(AA[o + j]), v = bf2f(V[o + i]);
        const float sa = wave_allsum(S * (-kk));
        S = S * w + sa * (kk * a) + v * k;
        const float y = wave_allsum(S * r);
        if (j == 0) YRAW[o + i] = y;
    }
}
__device__ __forceinline__ void k_wkvpost(int vb, int vt, const float* __restrict__ YRAW, const bf16_t* __restrict__ R, const bf16_t* __restrict__ KP, const bf16_t* __restrict__ V,
        const bf16_t* __restrict__ GG, const float* __restrict__ r_k, const float* __restrict__ ln_w, const float* __restrict__ ln_b, bf16_t* __restrict__ YA) {
    const int t = vb, c = vt; const size_t o = (size_t)t * DR + c;
    const float y = YRAW[o];
    const float mean = wave_allsum(y) * (1.f / 64.f);
    const float dv = y - mean;
    const float var = wave_allsum(dv * dv) * (1.f / 64.f);
    const float yn = dv * rsqrtf(var + GN_EPS) * ln_w[c] + ln_b[c];
    const float bonus = wave_allsum(bf2f(R[o]) * bf2f(KP[o]) * r_k[c]) * bf2f(V[o]);
    YA[o] = f2bf((yn + bonus) * bf2f(GG[o]));
}
__device__ __forceinline__ void k_kmean(int vb, int vt, const bf16_t* __restrict__ P, float* __restrict__ KM) {
    const int i = vb * 256 + vt;
    if (i >= NB * MH * NBLK * HD) return;
    const int d = i & 63, n = (i >> 6) & 15, h = (i >> 10) & 7, b = i >> 13;
    float s = 0.f;
    for (int q = 0; q < MBLK; ++q) s += bf2f(P[(size_t)(b * SEQ + n * MBLK + q) * NPROJ + OFF_MOBA + 512 + h * 64 + d]);
    KM[i] = s * (1.f / MBLK);
}
__device__ __forceinline__ void k_moba(int vb, int vt, const bf16_t* __restrict__ P, const float* __restrict__ KM, bf16_t* __restrict__ YB) {
    const int gwv = vb * 4 + (vt >> 6), lane = vt & 63;
    const int h = gwv & 7, tt = gwv >> 3;
    const int b = tt / SEQ, tpos = tt % SEQ, blk = tpos / MBLK;
    const float slope = exp2f(-(float)(h + 1));
    const bf16_t* qrow = P + (size_t)tt * NPROJ + OFF_MOBA + h * 64;
    const float qd = bf2f(qrow[lane]) * 0.125f;
    float q[64];
#pragma unroll
    for (int d = 0; d < 64; ++d) q[d] = lane_bcast(qd, d);
    int sel[3] = {-1, -1, -1};
    {
        float gate[16];
#pragma unroll
        for (int n = 0; n < 16; ++n) { const float km = KM[((b * MH + h) * NBLK + n) * HD + lane]; gate[n] = wave_allsum(qd * km); }
#pragma unroll
        for (int s = 0; s < 3; ++s) {
            int best = -1; float bv = 0.f;
#pragma unroll
            for (int n = 0; n < 16; ++n) { const bool ok = n < blk && n != sel[0] && n != sel[1]; if (ok && (best < 0 || gate[n] > bv)) { best = n; bv = gate[n]; } }
            sel[s] = best;
        }
    }
    float m = -INFINITY, l = 0.f, o = 0.f;
    for (int s = 0; s < 4; ++s) {
        const int n = s < 3 ? sel[s] : blk;
        if (n < 0) continue;
        for (int c0 = 0; c0 < MBLK; c0 += 64) {
            const int sp = n * MBLK + c0 + lane;
            const bool valid = sp <= tpos;
            if (n * MBLK + c0 > tpos) break;
            const bf16_t* krow = P + (size_t)(b * SEQ + sp) * NPROJ + OFF_MOBA + 512 + h * 64;
            float sc = 0.f;
#pragma unroll
            for (int d8 = 0; d8 < 8; ++d8) { const bf16x8 kv = *(const bf16x8*)(krow + d8 * 8);
#pragma unroll
                for (int e = 0; e < 8; ++e) sc += q[d8 * 8 + e] * bf2f((bf16_t)kv[e]); }
            sc -= slope * (float)(tpos - sp);
            if (!valid) sc = -INFINITY;
            const float mx = wave_allmax(sc);
            const float mn = fmaxf(m, mx);
            const float scale = __expf(m - mn);
            const float p = valid ? __expf(sc - mn) : 0.f;
            l = l * scale + wave_allsum(p);
            o *= scale;
            const bf16_t* vbase = P + (size_t)(b * SEQ + n * MBLK + c0) * NPROJ + OFF_MOBA + 1024 + h * 64 + lane;
#pragma unroll
            for (int e = 0; e < 64; ++e) { const float pe = lane_bcast(p, e); o += pe * bf2f(vbase[(size_t)e * NPROJ]); }
            m = mn;
        }
    }
    YB[(size_t)tt * DMO + h * 64 + lane] = f2bf(o / l);
}
__device__ __forceinline__ void k_s5(int vb, int vt, const bf16_t* __restrict__ P, const float* __restrict__ LAM, const float* __restrict__ BB, const float* __restrict__ c_re,
        const float* __restrict__ c_im, const float* __restrict__ dvec, bf16_t* __restrict__ YCPRE) {
    const int b = vb / NGR, g = vb % NGR, p = vt;
    const float lre = LAM[(g * SST + p) * 2], lim = LAM[(g * SST + p) * 2 + 1];
    float bre[16], bim[16], cre[16], cim[16], dd[16];
#pragma unroll
    for (int h = 0; h < 16; ++h) { bre[h] = BB[((g * SST + p) * 16 + h) * 2]; bim[h] = BB[((g * SST + p) * 16 + h) * 2 + 1];
        cre[h] = c_re[(g * 16 + h) * SST + p]; cim[h] = c_im[(g * 16 + h) * SST + p]; dd[h] = dvec[g * 16 + h]; }
    float hre = 0.f, him = 0.f;
    for (int t = 0; t < SEQ; ++t) {
        const bf16_t* ur = P + (size_t)(b * SEQ + t) * NPROJ + OFF_SSM + g * 16;
        float u[16];
#pragma unroll
        for (int h = 0; h < 16; ++h) u[h] = bf2f(ur[h]);
        float bur = 0.f, bui = 0.f;
#pragma unroll
        for (int h = 0; h < 16; ++h) { bur += bre[h] * u[h]; bui += bim[h] * u[h]; }
        const float nre = lre * hre - lim * him + bur, nim = lre * him + lim * hre + bui;
        hre = nre; him = nim;
        float myy = 0.f;
#pragma unroll
        for (int h = 0; h < 16; ++h) { const float y = wave_allsum(cre[h] * hre - cim[h] * him) + dd[h] * u[h]; if (p == h) myy = y; }
        if (p < 16) YCPRE[(size_t)(b * SEQ + t) * DSS + g * 16 + p] = f2bf(gelu_tanh(myy));
    }
}
__device__ __forceinline__ void k_ln1route(int vb, int vt, const float* __restrict__ S, const float* __restrict__ lw, const float* __restrict__ lb, float* __restrict__ X, bf16_t* __restrict__ XN,
        const float* __restrict__ RTW, const float* __restrict__ gb, const float* __restrict__ eb, unsigned* __restrict__ cnt,
        int* __restrict__ EID, int* __restrict__ POS, float* __restrict__ WGT, float* rlog) {
    const int t = vb * 4 + (vt >> 6), lane = vt & 63;
    float v[16]; float s = 0.f;
#pragma unroll
    for (int i = 0; i < 16; ++i) { v[i] = S[(size_t)t * D + i * 64 + lane]; s += v[i]; }
    const float mean = wave_allsum(s) * (1.f / D);
    float q = 0.f;
#pragma unroll
    for (int i = 0; i < 16; ++i) { v[i] -= mean; q += v[i] * v[i]; }
    const float rstd = rsqrtf(wave_allsum(q) * (1.f / D) + LN_EPS);
#pragma unroll
    for (int i = 0; i < 16; ++i) { const int c = i * 64 + lane; v[i] = v[i] * rstd * lw[c] + lb[c]; X[(size_t)t * D + c] = v[i]; XN[(size_t)t * D + c] = f2bf(v[i]); }
    float* lg = rlog + ((vb & 1) * 4 + (vt >> 6)) * 40;
    for (int j = 0; j < 36; ++j) { float a = 0.f;
#pragma unroll
        for (int i = 0; i < 16; ++i) a += v[i] * RTW[j * 1024 + i * 64 + lane];
        a = wave_allsum(a); if (lane == 0) lg[j] = a; }
    if (lane == 0) {
        int gs = 0; float gm = lg[0] + gb[0];
        for (int j = 1; j < 4; ++j) { const float x = lg[j] + gb[j]; if (x > gm) { gm = x; gs = j; } }
        float den = 0.f;
        for (int j = 0; j < 4; ++j) den += __expf(lg[j] + gb[j] - gm);
        const float pg = 1.f / den;
        int i0 = 0; float m0 = lg[4 + gs * 8] + eb[gs * 8];
        for (int j = 1; j < 8; ++j) { const float x = lg[4 + gs * 8 + j] + eb[gs * 8 + j]; if (x > m0) { m0 = x; i0 = j; } }
        int i1 = -1; float m1 = 0.f;
        for (int j = 0; j < 8; ++j) { const float x = lg[4 + gs * 8 + j] + eb[gs * 8 + j]; if (j != i0 && (i1 < 0 || x > m1)) { m1 = x; i1 = j; } }
        const float e1 = __expf(m1 - m0);
        const float p0 = 1.f / (1.f + e1), p1 = e1 / (1.f + e1);
        const int ex0 = gs * 8 + i0, ex1 = gs * 8 + i1;
        EID[t * 2] = ex0; EID[t * 2 + 1] = ex1;
        WGT[t * 2] = pg * p0; WGT[t * 2 + 1] = pg * p1;
        POS[t * 2] = (int)atomicAdd(&cnt[ex0], 1u);
        POS[t * 2 + 1] = (int)atomicAdd(&cnt[ex1], 1u);
    }
}
__device__ __forceinline__ void k_gather(int vb, int vt, const bf16_t* __restrict__ XN, const unsigned* __restrict__ cnt, const int* __restrict__ EID, const int* __restrict__ POS,
        int* __restrict__ SLOT, bf16_t* __restrict__ XG) {
    const int t = vb * 4 + (vt >> 6), lane = vt & 63;
    for (int k = 0; k < 2; ++k) {
        const int e = EID[t * 2 + k]; int off = 0;
        for (int j = 0; j < e; ++j) off += ((int)cnt[j] + 255) & ~255;
        const int slot = off + POS[t * 2 + k];
        if (lane == 0) SLOT[t * 2 + k] = slot;
        const uint4* src = (const uint4*)(XN + (size_t)t * D); uint4* dst = (uint4*)(XG + (size_t)slot * D);
        dst[lane] = src[lane]; dst[lane + 64] = src[lane + 64];
    }
}
__device__ __forceinline__ void k_ln2(int vb, int vt, const bf16_t* __restrict__ YG, const int* __restrict__ SLOT, const float* __restrict__ WGT, const float* __restrict__ lw, const float* __restrict__ lb,
        float* __restrict__ X, bf16_t* __restrict__ XN) {
    const int t = vb * 4 + (vt >> 6), lane = vt & 63;
    const int s0 = SLOT[t * 2], s1 = SLOT[t * 2 + 1]; const float w0 = WGT[t * 2], w1 = WGT[t * 2 + 1];
    float v[16]; float s = 0.f;
#pragma unroll
    for (int i = 0; i < 16; ++i) { const int c = i * 64 + lane;
        const float y = bf2f(YG[(size_t)s0 * D + c]) * w0 + bf2f(YG[(size_t)s1 * D + c]) * w1;
        v[i] = ALPHA * X[(size_t)t * D + c] + y; s += v[i]; }
    const float mean = wave_allsum(s) * (1.f / D);
    float q = 0.f;
#pragma unroll
    for (int i = 0; i < 16; ++i) { v[i] -= mean; q += v[i] * v[i]; }
    const float rstd = rsqrtf(wave_allsum(q) * (1.f / D) + LN_EPS);
#pragma unroll
    for (int i = 0; i < 16; ++i) { const int c = i * 64 + lane; const float o = v[i] * rstd * lw[c] + lb[c]; X[(size_t)t * D + c] = o; XN[(size_t)t * D + c] = f2bf(o); }
}

namespace pg8 {
#define PG8_LAS __attribute__((address_space(3)))
typedef unsigned short bf16_t;
typedef short bf16x8 __attribute__((ext_vector_type(8)));
typedef float f32x4 __attribute__((ext_vector_type(4)));
typedef unsigned u32x4 __attribute__((ext_vector_type(4)));
constexpr int BM = 256, BK = 64, HALF = 128, HTB = HALF * BK * 2  , STAGE_BYTES = 8 * HTB, NXCD = 8, WGM = 8;

__host__ __device__ __forceinline__ int lds_byte(int r, int c) { const int st = (r >> 4) * 2 + (c >> 5), rr = r & 15, cc = c & 31, ob = rr * 64 + cc * 2; return st * 1024 + (ob ^ (((ob >> 9) & 1) << 5)); }
__host__ __device__ __forceinline__ void stage_rc(int b, int& R, int& C) { const int st = b / 1024, sb = b % 1024, swz = sb ^ (((sb >> 9) & 1) << 5); R = (st >> 1) * 16 + swz / 64; C = (st & 1) * 32 + (swz % 64) / 2; }
__host__ __device__ __forceinline__ int perm32(int rho) { const int n = rho >> 4, i = rho & 15; return 8 * (i >> 2) + 4 * n + (i & 3); }

struct Unit { int pm, pn; };
struct Gemm { const bf16_t* A; const bf16_t* Bt; int M, N, K; };

struct StaticOrder {
    int nM, nN, nwg, G, c;
    __host__ __device__ void init(int M, int N, int G_, int c_) { nM = M / BM; nN = N / BM; nwg = nM * nN; G = G_; c = c_; }
    __host__ __device__ bool next(int i, Unit& u) const {
        const long L = (long)i * G + c; if (L >= nwg) return false;
        int wgid = (int)L; { const int q = nwg / NXCD, r = nwg % NXCD, xcd = wgid % NXCD, off = wgid / NXCD; wgid = (xcd < r ? xcd * (q + 1) : r * (q + 1) + (xcd - r) * q) + off; }
        const int nig = WGM * nN, gid = wgid / nig, fm = gid * WGM, gsz = (nM - fm) < WGM ? (nM - fm) : WGM;
        u.pm = fm + ((wgid % nig) % gsz); u.pn = (wgid % nig) / gsz; return true;
    }
    __device__ __forceinline__ void a_ready(const Unit&) const {}
    __device__ __forceinline__ void done(const Unit&) const {}
};

__device__ __forceinline__ unsigned cvt_pk_bf16(float lo, float hi) { unsigned r; asm volatile("v_cvt_pk_bf16_f32 %0, %1, %2" : "=v"(r) : "v"(lo), "v"(hi)); return r; }
typedef float f32x2 __attribute__((ext_vector_type(2)));
__device__ __forceinline__ f32x2 gelu_pk(f32x2 v) {
    const f32x2 av = __builtin_elementwise_abs(v), d = av * 0.2316418882f + 1.0f;
    f32x2 t; t.x = __builtin_amdgcn_rcpf(d.x); t.y = __builtin_amdgcn_rcpf(d.y);
    f32x2 q = t * 0.5307027145f + (-0.7265760135f); q = q * t + 0.7107068705f; q = q * t + (-0.142248368f); q = q * t + 0.127414796f; q = q * t;
    const f32x2 s = (v * v) * (-0.72134752044f);
    f32x2 e; e.x = __builtin_amdgcn_exp2f(s.x); e.y = __builtin_amdgcn_exp2f(s.y);
    const f32x2 m = v * (q * e), r = v - m;
    f32x2 o; o.x = v.x < 0.f ? m.x : r.x; o.y = v.y < 0.f ? m.y : r.y; return o;
}

template <int ACT  > struct EpiBf16 {
    static constexpr bool PERM = true, AFTER_DRAIN = false; static_assert(ACT == 0 || ACT == 1, "EpiBf16: ACT is 0 (none) or 1 (gelu_pk)");
    bf16_t* O; int ldc; const float* bias; int split_cols; size_t split_stride; float scale0;
    __device__ __forceinline__ void operator()(const f32x4 (&acc)[2][2][4][2], const Unit& u, int wr, int wc, int fr, int fq) const {
        const int row0 = u.pm * BM + wr * 64 + fr; int colt = u.pn * BM; bf16_t* base = O;
        float sc = 1.f; if (split_cols) { const int t = colt / split_cols; base += (size_t)t * split_stride; colt -= t * split_cols; if (t == 0) sc = scale0; }
        const int col0 = colt + wc * 32 + 8 * fq, bcol0 = u.pn * BM + wc * 32 + 8 * fq;
        f32x4 bv[2][2];
#pragma unroll
        for (int bj = 0; bj < 2; ++bj)
#pragma unroll
            for (int n = 0; n < 2; ++n) bv[bj][n] = bias ? *(const f32x4*)(bias + bcol0 + bj * HALF + 4 * n) : (f32x4){0.f, 0.f, 0.f, 0.f};
#pragma unroll
        for (int ai = 0; ai < 2; ++ai)
#pragma unroll
            for (int m = 0; m < 4; ++m) { bf16_t* rowp = base + (size_t)(row0 + ai * HALF + m * 16) * ldc + col0;
#pragma unroll
                for (int bj = 0; bj < 2; ++bj) { f32x4 v0 = acc[ai][bj][m][0] + bv[bj][0], v1 = acc[ai][bj][m][1] + bv[bj][1];
                    if (ACT == 1) { f32x2 a = gelu_pk((f32x2){v0[0], v0[1]}), b = gelu_pk((f32x2){v0[2], v0[3]}), c = gelu_pk((f32x2){v1[0], v1[1]}), d = gelu_pk((f32x2){v1[2], v1[3]});
                        v0 = (f32x4){a.x, a.y, b.x, b.y}; v1 = (f32x4){c.x, c.y, d.x, d.y}; }
                    v0 = v0 * sc; v1 = v1 * sc; u32x4 w; w.x = cvt_pk_bf16(v0[0], v0[1]); w.y = cvt_pk_bf16(v0[2], v0[3]); w.z = cvt_pk_bf16(v1[0], v1[1]); w.w = cvt_pk_bf16(v1[2], v1[3]);
                    *(u32x4*)(rowp + bj * HALF) = w; } }
    }
};

typedef unsigned u32x2 __attribute__((ext_vector_type(2)));
__device__ __forceinline__ float sigm(float x) { return __builtin_amdgcn_rcpf(1.f + __expf(-x)); }
__device__ __forceinline__ float bflo(unsigned w) { return __uint_as_float(w << 16); }
__device__ __forceinline__ float bfhi(unsigned w) { return __uint_as_float(w & 0xffff0000u); }
template <int MODE> struct EpiGated {
    static constexpr bool PERM = true, AFTER_DRAIN = false;
    bf16_t* O; int ldc; const float* bias; int bias1_off; int pn_mask;
    __device__ __forceinline__ void operator()(const f32x4 (&acc)[2][2][4][2], const Unit& u, int wr, int wc, int fr, int fq) const {
        const int row0 = u.pm * BM + wr * 64 + fr, ch0 = (u.pn & pn_mask) * 128 + wc * 32 + 8 * fq;
        f32x4 b0[2], b1[2];
#pragma unroll
        for (int n = 0; n < 2; ++n) { if (MODE == 0) { b0[n] = *(const f32x4*)(bias + ch0 + 4 * n); b1[n] = *(const f32x4*)(bias + bias1_off + ch0 + 4 * n); } else { b0[n] = (f32x4){0.f, 0.f, 0.f, 0.f}; b1[n] = b0[n]; } }
#pragma unroll
        for (int ai = 0; ai < 2; ++ai)
#pragma unroll
            for (int m = 0; m < 4; ++m) { bf16_t* rowp = O + (size_t)(row0 + ai * HALF + m * 16) * ldc + ch0; float r[8];
#pragma unroll
                for (int n = 0; n < 2; ++n) { const f32x4 a0 = acc[ai][0][m][n] + b0[n], a1 = acc[ai][1][m][n] + b1[n];
#pragma unroll
                    for (int j = 0; j < 4; ++j) r[4 * n + j] = MODE == 0 ? a0[j] * sigm(a1[j]) : a0[j] * sigm(a0[j]) * a1[j]; }
                u32x4 w; w.x = cvt_pk_bf16(r[0], r[1]); w.y = cvt_pk_bf16(r[2], r[3]); w.z = cvt_pk_bf16(r[4], r[5]); w.w = cvt_pk_bf16(r[6], r[7]);
                *(u32x4*)rowp = w; }
    }
};
struct EpiUp {
    static constexpr bool PERM = true, AFTER_DRAIN = false;
    const bf16_t* P; int ldp; const float* gb; float* M; bf16_t* MB; int ldc; int br;
    __device__ __forceinline__ void operator()(const f32x4 (&acc)[2][2][4][2], const Unit& u, int wr, int wc, int fr, int fq) const {
        const int row0 = u.pm * BM + wr * 64 + fr, col0 = u.pn * BM + wc * 32 + 8 * fq;
#pragma unroll
        for (int ai = 0; ai < 2; ++ai)
#pragma unroll
            for (int m = 0; m < 4; ++m) { const size_t row = (size_t)(row0 + ai * HALF + m * 16);
#pragma unroll
                for (int bj = 0; bj < 2; ++bj) { const int c = col0 + bj * HALF;
                    const u32x4 gl = *(const u32x4*)(P + row * ldp + c);
                    const f32x4 g0 = *(const f32x4*)(gb + c), g1 = *(const f32x4*)(gb + c + 4);
                    const f32x4 a0 = acc[ai][bj][m][0], a1 = acc[ai][bj][m][1];
                    f32x4 m0, m1;
                    m0[0] = sigm(bflo(gl.x) + g0[0]) * a0[0]; m0[1] = sigm(bfhi(gl.x) + g0[1]) * a0[1]; m0[2] = sigm(bflo(gl.y) + g0[2]) * a0[2]; m0[3] = sigm(bfhi(gl.y) + g0[3]) * a0[3];
                    m1[0] = sigm(bflo(gl.z) + g1[0]) * a1[0]; m1[1] = sigm(bfhi(gl.z) + g1[1]) * a1[1]; m1[2] = sigm(bflo(gl.w) + g1[2]) * a1[2]; m1[3] = sigm(bfhi(gl.w) + g1[3]) * a1[3];
                    float* mp = M + row * ldc + c;
                    if (br > 0) { m0 += *(const f32x4*)mp; m1 += *(const f32x4*)(mp + 4); }
                    if (br < 2) { *(f32x4*)mp = m0; *(f32x4*)(mp + 4) = m1; }
                    else { u32x4 w; w.x = cvt_pk_bf16(m0[0], m0[1]); w.y = cvt_pk_bf16(m0[2], m0[3]); w.z = cvt_pk_bf16(m1[0], m1[1]); w.w = cvt_pk_bf16(m1[2], m1[3]); *(u32x4*)(MB + row * ldc + c) = w; } } }
    }
};
struct EpiOut {
    static constexpr bool PERM = false, AFTER_DRAIN = false;
    const float* X; float* S; int ldc; float alpha;
    __device__ __forceinline__ void operator()(const f32x4 (&acc)[2][2][4][2], const Unit& u, int wr, int wc, int fr, int fq) const {
        const int row0 = u.pm * BM + wr * 64 + fr, col0 = u.pn * BM + wc * 32 + 4 * fq;
#pragma unroll
        for (int ai = 0; ai < 2; ++ai)
#pragma unroll
            for (int m = 0; m < 4; ++m) { const size_t off = (size_t)(row0 + ai * HALF + m * 16) * ldc + col0;
#pragma unroll
                for (int bj = 0; bj < 2; ++bj)
#pragma unroll
                    for (int n = 0; n < 2; ++n) { const f32x4 x = *(const f32x4*)(X + off + bj * HALF + n * 16); *(f32x4*)(S + off + bj * HALF + n * 16) = x * alpha + acc[ai][bj][m][n]; } }
    }
};
struct EpiBf16Grp {
    static constexpr bool PERM = true, AFTER_DRAIN = false;
    bf16_t* O; int ldc; int pn_mask;
    __device__ __forceinline__ void operator()(const f32x4 (&acc)[2][2][4][2], const Unit& u, int wr, int wc, int fr, int fq) const {
        const int row0 = u.pm * BM + wr * 64 + fr, col0 = (u.pn & pn_mask) * BM + wc * 32 + 8 * fq;
#pragma unroll
        for (int ai = 0; ai < 2; ++ai)
#pragma unroll
            for (int m = 0; m < 4; ++m) { bf16_t* rowp = O + (size_t)(row0 + ai * HALF + m * 16) * ldc + col0;
#pragma unroll
                for (int bj = 0; bj < 2; ++bj) { const f32x4 v0 = acc[ai][bj][m][0], v1 = acc[ai][bj][m][1];
                    u32x4 w; w.x = cvt_pk_bf16(v0[0], v0[1]); w.y = cvt_pk_bf16(v0[2], v0[3]); w.z = cvt_pk_bf16(v1[0], v1[1]); w.w = cvt_pk_bf16(v1[2], v1[3]);
                    *(u32x4*)(rowp + bj * HALF) = w; } }
    }
};
template <int NCOL> struct GroupedOrder {
    const PG8_LAS int* tile_e; int ntiles, G, c;
    __device__ __forceinline__ bool next(int i, Unit& u) const {
        const int L = i * G + c; if (L >= ntiles * NCOL) return false;
        const int tile = L / NCOL, j = L % NCOL; u.pm = tile; u.pn = __builtin_amdgcn_readfirstlane(tile_e[tile]) * NCOL + j; return true; }
    __device__ __forceinline__ void a_ready(const Unit&) const {}
    __device__ __forceinline__ void done(const Unit&) const {}
};
template <class Epi, class Sched, bool ALIGN_EPI = false, bool SP2 = false>
__device__ __forceinline__ void gemm_phase(PG8_LAS unsigned char* lds, const Gemm g, const Sched& S, const Epi& E, int wv_) {
    int tid_; asm volatile("v_mbcnt_lo_u32_b32 %0, -1, 0\n\tv_mbcnt_hi_u32_b32 %0, -1, %0\n\tv_lshl_add_u32 %0, %1, 6, %0" : "=&v"(tid_) : "s"(wv_));
    const int tid = tid_, wid = __builtin_amdgcn_readfirstlane(tid >> 6), lane = tid & 63, wr = wid >> 2, wc = wid & 3, fr = lane & 15, fq = lane >> 4;
    const int K = g.K, nt = K / BK;
    unsigned voffA[2], voffB[2];
#pragma unroll
    for (int i = 0; i < 2; ++i) { int R, C; stage_rc(tid * 16 + i * 8192, R, C); const int Rb = Epi::PERM ? ((R & ~31) + perm32(R & 31)) : R;
        voffA[i] = (unsigned)(R * K + C) * 2u; voffB[i] = (unsigned)(Rb * K + C) * 2u; }
    const size_t kstep = (size_t)(BK * 2);
    const size_t hstep = (size_t)HALF * K * 2;
    const size_t tstep = 2 * hstep;
    const unsigned ldsw = (unsigned)wid * 1024u;
    const int aoff = lds_byte(wr * 64 + fr, fq * 8), boff = lds_byte(wc * 32 + fr, fq * 8);
#define PG8_SA(b, h) (((b) * 2 + (h)) * HTB)
#define PG8_SB(b, h) ((4 + (b) * 2 + (h)) * HTB)
#define PG8_STAGE(bufoff, gbase, voff) do { _Pragma("unroll") for (int _i = 0; _i < 2; ++_i) \
        __builtin_amdgcn_global_load_lds((const unsigned*)((const char*)(gbase) + (voff)[_i]), (PG8_LAS unsigned*)(lds + (bufoff) + ldsw + _i * 8192), 16, 0, 0); } while (0)
#define PG8_LDA(dst, b, h) do { _Pragma("unroll") for (int m = 0; m < 4; ++m) _Pragma("unroll") for (int k = 0; k < 2; ++k) dst[m][k] = *(const PG8_LAS bf16x8*)(lds + PG8_SA(b, h) + aoff + m * 2048 + k * 1024); } while (0)
#define PG8_LDB(dst, b, h) do { _Pragma("unroll") for (int n = 0; n < 2; ++n) _Pragma("unroll") for (int k = 0; k < 2; ++k) dst[n][k] = *(const PG8_LAS bf16x8*)(lds + PG8_SB(b, h) + boff + n * 2048 + k * 1024); } while (0)
#define PG8_MMA(ai, bj, At, Bt) do { __builtin_amdgcn_s_setprio(1); _Pragma("unroll") for (int m = 0; m < 4; ++m) _Pragma("unroll") for (int n = 0; n < 2; ++n) _Pragma("unroll") for (int k = 0; k < 2; ++k) \
        acc[ai][bj][m][n] = __builtin_amdgcn_mfma_f32_16x16x32_bf16(Bt[n][k], At[m][k], acc[ai][bj][m][n], 0, 0, 0); __builtin_amdgcn_s_setprio(0); } while (0)
#define PG8_WAIT_V(n) asm volatile("s_waitcnt vmcnt(" #n ")" ::: "memory")
#define PG8_WAIT_L(n) asm volatile("s_waitcnt lgkmcnt(" #n ")" ::: "memory")
#define PG8_BAR __builtin_amdgcn_s_barrier()
#define PG8_SCHED __builtin_amdgcn_sched_barrier(0)
    Unit cur, nxt; int ui = 0;
    if (!S.next(0, cur)) return;
    f32x4 acc[2][2][4][2];
#pragma unroll
    for (int a = 0; a < 2; ++a)
#pragma unroll
        for (int b = 0; b < 2; ++b)
#pragma unroll
            for (int m = 0; m < 4; ++m)
#pragma unroll
                for (int n = 0; n < 2; ++n) acc[a][b][m][n] = (f32x4){0.f, 0.f, 0.f, 0.f};
    bf16x8 At[4][2], B0[2][2], B1[2][2];
    const char* cA = (const char*)g.A + (size_t)cur.pm * tstep; const char* cB = (const char*)g.Bt + (size_t)cur.pn * tstep;
    S.a_ready(cur);
    if constexpr (SP2) {
        PG8_STAGE(PG8_SB(0, 0), cB, voffB); PG8_STAGE(PG8_SB(0, 1), cB + hstep, voffB); PG8_STAGE(PG8_SA(0, 0), cA, voffA); PG8_STAGE(PG8_SA(0, 1), cA + hstep, voffA);
        if (wr == 1) PG8_BAR;
        PG8_WAIT_V(2); PG8_BAR;
        PG8_STAGE(PG8_SB(1, 0), cB + kstep, voffB); PG8_STAGE(PG8_SA(1, 0), cA + kstep, voffA); PG8_STAGE(PG8_SB(1, 1), cB + hstep + kstep, voffB);
        PG8_WAIT_V(6); PG8_BAR;
    } else {
        PG8_STAGE(PG8_SB(0, 0), cB, voffB); PG8_STAGE(PG8_SA(0, 0), cA, voffA); PG8_STAGE(PG8_SB(0, 1), cB + hstep, voffB); PG8_STAGE(PG8_SA(0, 1), cA + hstep, voffA);
        if (wr == 1) PG8_BAR;
        PG8_WAIT_V(4); PG8_BAR;
        PG8_STAGE(PG8_SB(1, 0), cB + kstep, voffB); PG8_STAGE(PG8_SA(1, 0), cA + kstep, voffA); PG8_STAGE(PG8_SB(1, 1), cB + hstep + kstep, voffB);
        PG8_WAIT_V(6); PG8_BAR;
    }
    for (;;) {
        const bool has_next = S.next(ui + 1, nxt);
        const char* nA = has_next ? (const char*)g.A + (size_t)nxt.pm * tstep : cA; const char* nB = has_next ? (const char*)g.Bt + (size_t)nxt.pn * tstep : cB;
#pragma nounroll
        for (int t = 0; t < nt; t += 2) {
            const bool last = (t == nt - 2);
            const char* a1 = cA + (size_t)(t + 1) * kstep;
            const char* a2 = last ? nA : cA + (size_t)(t + 2) * kstep; const char* b2 = last ? nB : cB + (size_t)(t + 2) * kstep;
            const char* a3 = a2 + kstep; const char* b3 = b2 + kstep;
            if (last && has_next) S.a_ready(nxt);
            if constexpr (SP2) {
            PG8_LDB(B0, 0, 0); PG8_LDB(B1, 0, 1); PG8_SCHED; PG8_LDA(At, 0, 0); PG8_STAGE(PG8_SA(1, 1), a1 + hstep, voffA);
            PG8_WAIT_V(8); PG8_WAIT_L(0); PG8_BAR; PG8_MMA(0, 0, At, B0); PG8_MMA(0, 1, At, B1); PG8_BAR; PG8_SCHED;
            PG8_LDA(At, 0, 1); PG8_STAGE(PG8_SB(0, 0), b2, voffB); PG8_STAGE(PG8_SB(0, 1), b2 + hstep, voffB); PG8_STAGE(PG8_SA(0, 0), a2, voffA);
            PG8_WAIT_V(8); PG8_WAIT_L(0); PG8_BAR; PG8_MMA(1, 0, At, B0); PG8_MMA(1, 1, At, B1); PG8_BAR; PG8_SCHED;
            PG8_LDB(B0, 1, 0); PG8_LDB(B1, 1, 1); PG8_SCHED; PG8_LDA(At, 1, 0); PG8_STAGE(PG8_SA(0, 1), a2 + hstep, voffA);
            PG8_WAIT_V(8); PG8_WAIT_L(0); PG8_BAR; PG8_MMA(0, 0, At, B0); PG8_MMA(0, 1, At, B1); PG8_BAR; PG8_SCHED;
            PG8_LDA(At, 1, 1); PG8_STAGE(PG8_SB(1, 0), b3, voffB); PG8_STAGE(PG8_SB(1, 1), b3 + hstep, voffB); PG8_STAGE(PG8_SA(1, 0), a3, voffA);
            PG8_WAIT_V(8); PG8_WAIT_L(0); PG8_BAR; PG8_MMA(1, 0, At, B0); PG8_MMA(1, 1, At, B1); PG8_BAR; PG8_SCHED;
            } else {
            PG8_LDB(B0, 0, 0); PG8_SCHED; PG8_LDA(At, 0, 0); PG8_STAGE(PG8_SA(1, 1), a1 + hstep, voffA);
            PG8_WAIT_L(8); PG8_BAR; PG8_WAIT_L(0); PG8_MMA(0, 0, At, B0); PG8_BAR; PG8_SCHED;
            PG8_LDB(B1, 0, 1); PG8_STAGE(PG8_SB(0, 0), b2, voffB);
            PG8_BAR; PG8_WAIT_L(0); PG8_MMA(0, 1, At, B1); PG8_BAR;
            PG8_LDA(At, 0, 1); PG8_STAGE(PG8_SA(0, 0), a2, voffA);
            PG8_BAR; PG8_WAIT_L(0); PG8_MMA(1, 0, At, B0); PG8_BAR; PG8_SCHED;
            PG8_STAGE(PG8_SB(0, 1), b2 + hstep, voffB);
            PG8_WAIT_V(6); PG8_BAR; PG8_MMA(1, 1, At, B1); PG8_BAR;
            PG8_LDB(B0, 1, 0); PG8_SCHED; PG8_LDA(At, 1, 0); PG8_STAGE(PG8_SA(0, 1), a2 + hstep, voffA);
            PG8_WAIT_L(8); PG8_BAR; PG8_WAIT_L(0); PG8_MMA(0, 0, At, B0); PG8_BAR; PG8_SCHED;
            PG8_LDB(B1, 1, 1); PG8_STAGE(PG8_SB(1, 0), b3, voffB);
            PG8_BAR; PG8_WAIT_L(0); PG8_MMA(0, 1, At, B1); PG8_BAR;
            PG8_LDA(At, 1, 1); PG8_STAGE(PG8_SA(1, 0), a3, voffA);
            PG8_BAR; PG8_WAIT_L(0); PG8_MMA(1, 0, At, B0); PG8_BAR; PG8_SCHED;
            PG8_STAGE(PG8_SB(1, 1), b3 + hstep, voffB);
            PG8_WAIT_V(6); PG8_BAR; PG8_MMA(1, 1, At, B1); PG8_BAR;
            }
        }
        if constexpr (ALIGN_EPI) { if (wr == 0) PG8_BAR; }
        if constexpr (!Epi::AFTER_DRAIN) { E(acc, cur, wr, wc, fr, fq); S.done(cur); }
        if (!has_next) break;
#pragma unroll
        for (int a = 0; a < 2; ++a)
#pragma unroll
            for (int b = 0; b < 2; ++b)
#pragma unroll
                for (int m = 0; m < 4; ++m)
#pragma unroll
                    for (int n = 0; n < 2; ++n) acc[a][b][m][n] = (f32x4){0.f, 0.f, 0.f, 0.f};
        cur = nxt; cA = nA; cB = nB; ++ui;
        if constexpr (ALIGN_EPI) { if (wr == 1) PG8_BAR; }
    }
    PG8_WAIT_V(0);
    if constexpr (!ALIGN_EPI) { if (wr == 0) PG8_BAR; }
    PG8_BAR;
    if constexpr (Epi::AFTER_DRAIN) { E.fused(acc, cur, wr, wc, fr, fq, lds, wid, lane); S.done(cur); }
#undef PG8_SA
#undef PG8_SB
#undef PG8_STAGE
#undef PG8_LDA
#undef PG8_LDB
#undef PG8_MMA
#undef PG8_WAIT_V
#undef PG8_WAIT_L
#undef PG8_BAR
#undef PG8_SCHED
}
}

#define LAS __attribute__((address_space(3)))
#define XB_TMO      128
#define XB_XCNT(j)  (256  + 64 * (j))
#define XB_XSUB(j)  (1280 + 64 * (j))
#define XB_XGEN(j)  (2304 + 64 * (j))
#define XB_TOP      3328
#define XB_TOPGEN   3392
#define XCD_BAR_WORDS 3456
#define XB_SPIN_CAP (1u << 18)
__device__ __forceinline__ unsigned xb_ld(unsigned* p)              { return __hip_atomic_load(p, __ATOMIC_RELAXED, __HIP_MEMORY_SCOPE_AGENT); }
__device__ __forceinline__ unsigned xb_add(unsigned* p, unsigned v) { return __hip_atomic_fetch_add(p, v, __ATOMIC_RELAXED, __HIP_MEMORY_SCOPE_AGENT); }
__device__ __forceinline__ unsigned xb_xcc_id() { return (unsigned)__builtin_amdgcn_s_getreg((3 << 11) | 20) & 0xFu; }
#define XB_SPIN(cond, bar) do { unsigned _sp = 0; while (cond) { __builtin_amdgcn_s_sleep(1); \
    if ((++_sp & 255u) == 0u) { if (xb_ld(&(bar)[XB_TMO])) break; if (_sp > XB_SPIN_CAP) { atomicAdd(&(bar)[XB_TMO], 1u); break; } } } } while (0)
__device__ __forceinline__ int otid(int wv) { int t; asm volatile("v_mbcnt_lo_u32_b32 %0, -1, 0\n\tv_mbcnt_hi_u32_b32 %0, -1, %0\n\tv_lshl_add_u32 %0, %1, 6, %0" : "=&v"(t) : "s"(wv)); return t; }
struct XcdBarrier { unsigned* bar; unsigned x; volatile LAS unsigned* st; int wv; };
__device__ __forceinline__ XcdBarrier xcd_barrier_post(unsigned* bar, volatile LAS unsigned* st, int wv) {
    XcdBarrier b; b.bar = bar; b.x = xb_xcc_id(); b.st = st; b.wv = wv;
    if (threadIdx.x == 0) { (void)xb_add(&bar[XB_XCNT(b.x)], 1u); st[2] = b.x; }
    return b;
}
__device__ __forceinline__ void xcd_barrier_complete(unsigned* bar, unsigned x, unsigned& nloc, unsigned& nx) {
    const unsigned G = gridDim.x * gridDim.y * gridDim.z;
    unsigned sum, cnt, mine, sp = 0u;
    for (;;) {
        sum = 0u; cnt = 0u; mine = 0u;
#pragma unroll
        for (unsigned j = 0; j < 16; ++j) { const unsigned c = xb_ld(&bar[XB_XCNT(j)]); sum += c; cnt += (c > 0u) ? 1u : 0u; mine = (j == x) ? c : mine; }
        if (sum == G) break;
        __builtin_amdgcn_s_sleep(1);
        if ((++sp & 255u) == 0u) { if (xb_ld(&bar[XB_TMO])) break; if (sp > XB_SPIN_CAP) { atomicAdd(&bar[XB_TMO], 1u); break; } }
    }
    nloc = mine > 0u ? mine : 1u; nx = cnt > 0u ? cnt : 1u;
}
__device__ __forceinline__ void xcd_barrier(const XcdBarrier& b) {
    asm volatile("s_waitcnt vmcnt(0)" ::: "memory");
    __syncthreads();
    if (otid(b.wv) == 0) {
        unsigned* bar = b.bar;
        __builtin_amdgcn_s_waitcnt(0);
        unsigned nloc = b.st[0], nx = b.st[1]; const unsigned bx = b.st[2];
        if (nloc == 0u) { xcd_barrier_complete(bar, bx, nloc, nx); b.st[0] = nloc; b.st[1] = nx; }
        const unsigned old = xb_add(&bar[XB_XSUB(bx)], 1u);
        const unsigned gen = old / nloc;
        if (old + 1u == (gen + 1u) * nloc) {
            __builtin_amdgcn_fence(__ATOMIC_RELEASE, "agent");
            asm volatile("s_waitcnt vmcnt(0)" ::: "memory");
            const unsigned og = xb_add(&bar[XB_TOP], 1u);
            const unsigned tg = og / nx;
            if (og + 1u == (tg + 1u) * nx) xb_add(&bar[XB_TOPGEN], 1u);
            else XB_SPIN(xb_ld(&bar[XB_TOPGEN]) == tg, bar);
            __builtin_amdgcn_fence(__ATOMIC_ACQUIRE, "agent");
            xb_add(&bar[XB_XGEN(bx)], 1u);
            asm volatile("s_waitcnt vmcnt(0)" ::: "memory");
        } else {
            XB_SPIN(xb_ld(&bar[XB_XGEN(bx)]) == gen, bar);
            __builtin_amdgcn_fence(__ATOMIC_ACQUIRE, "agent");
            asm volatile("s_waitcnt vmcnt(0)" ::: "memory");
        }
    }
    __syncthreads();
}
constexpr int CW_BAR = 4096;

namespace att {
typedef short s16x4 __attribute__((ext_vector_type(4)));
typedef unsigned u32x2_t __attribute__((ext_vector_type(2)));
typedef float f32x16 __attribute__((ext_vector_type(16)));
constexpr int PK = 144, PV = 192;
constexpr int KBUF = 64 * PK, VBUF = 64 * PV;
constexpr int OFF_K = 0, OFF_V = 2 * KBUF, OFF_KM = 2 * KBUF + 2 * VBUF, OFF_OST = OFF_KM + 4096, OST_W = 32 * 144, LDS_BYTES_ATT = OFF_OST + 8 * OST_W;
constexpr float NEG = -1e30f;
__device__ __forceinline__ float half_sum(float v) { auto rr = __builtin_amdgcn_permlane32_swap(__float_as_uint(v), __float_as_uint(v), false, false); return __uint_as_float(rr[0]) + __uint_as_float(rr[1]); }
__device__ __forceinline__ float half_max(float v) { auto rr = __builtin_amdgcn_permlane32_swap(__float_as_uint(v), __float_as_uint(v), false, false); return fmaxf(__uint_as_float(rr[0]), __uint_as_float(rr[1])); }
__device__ __forceinline__ unsigned pk_bf16(float lo, float hi) { typedef float f2 __attribute__((ext_vector_type(2))); typedef __bf16 b2 __attribute__((ext_vector_type(2))); f2 v = {lo, hi}; b2 b = __builtin_convertvector(v, b2); return __builtin_bit_cast(unsigned, b); }
__device__ __forceinline__ s16x4 vtr(LAS const unsigned char* p) { typedef short v4 __attribute__((ext_vector_type(4))); return __builtin_amdgcn_ds_read_tr16_b64_v4i16((LAS v4*)p); }

__device__ __forceinline__ void unit(LAS unsigned char* lds, const bf16_t* __restrict__ P, const float* __restrict__ KM, bf16_t* __restrict__ YB, int b, int h, int qb, int tid) {
    const int lane = tid & 63, w = __builtin_amdgcn_readfirstlane(tid >> 6), r32 = lane & 31, hi = lane >> 5;
    const size_t rowbase = (size_t)b * SEQ; const int q0 = qb * MBLK;
    const float cexp = exp2f(-(float)(h + 1)) * 1.4426950408889634f;
    LAS float* km = (LAS float*)(lds + OFF_KM);
    for (int i = tid; i < qb * 64; i += 512) km[i] = KM[(size_t)((b * MH + h) * NBLK) * HD + i];
    const bf16_t* qp = P + (rowbase + q0 + 32 * w + r32) * NPROJ + OFF_MOBA + h * 64 + 8 * hi;
    bf16x8 qs[4];
#pragma unroll
    for (int d0 = 0; d0 < 4; ++d0) qs[d0] = *(const bf16x8*)(qp + 16 * d0);
    __syncthreads();
    unsigned selmask = 0u;
    if (qb > 0) {
        float qf[32];
#pragma unroll
        for (int d0 = 0; d0 < 4; ++d0)
#pragma unroll
            for (int e = 0; e < 8; ++e) qf[d0 * 8 + e] = bf2f((bf16_t)qs[d0][e]);
        float gate[15];
#pragma unroll
        for (int n = 0; n < 15; ++n) { float s = 0.f;
            if (n < qb) {
#pragma unroll
                for (int d0 = 0; d0 < 4; ++d0) { const f32x4 k0 = *(const LAS f32x4*)(km + n * 64 + 16 * d0 + 8 * hi), k1 = *(const LAS f32x4*)(km + n * 64 + 16 * d0 + 8 * hi + 4);
                    s += qf[d0 * 8 + 0] * k0[0] + qf[d0 * 8 + 1] * k0[1] + qf[d0 * 8 + 2] * k0[2] + qf[d0 * 8 + 3] * k0[3] + qf[d0 * 8 + 4] * k1[0] + qf[d0 * 8 + 5] * k1[1] + qf[d0 * 8 + 6] * k1[2] + qf[d0 * 8 + 7] * k1[3]; }
                s = half_sum(s); }
            gate[n] = s; }
#pragma unroll
        for (int s = 0; s < 3; ++s) { int best = -1; float bv = 0.f;
#pragma unroll
            for (int n = 0; n < 15; ++n) { const bool ok = n < qb && !((selmask >> n) & 1u); if (ok && (best < 0 || gate[n] > bv)) { best = n; bv = gate[n]; } }
            if (best >= 0) selmask |= 1u << best; }
    }
#pragma unroll
    for (int d0 = 0; d0 < 4; ++d0) { unsigned wv_[4];
#pragma unroll
        for (int e = 0; e < 4; ++e) wv_[e] = pk_bf16(bf2f((bf16_t)qs[d0][2 * e]) * 0.18033688011112042f, bf2f((bf16_t)qs[d0][2 * e + 1]) * 0.18033688011112042f);
        u32x4_t t4 = {wv_[0], wv_[1], wv_[2], wv_[3]}; qs[d0] = __builtin_bit_cast(bf16x8, t4); }
    float ck[16];
#pragma unroll
    for (int r = 0; r < 16; ++r) ck[r] = cexp * (float)((r & 3) + 8 * (r >> 2));
    f32x16 oT0 = {}, oT1 = {};
    float mrun = NEG, lsum = 0.f;
    const int qrel = 32 * w + r32;
    const int NT = 4 + 4 * qb;
    const int srow = tid >> 3, sch = tid & 7;
    const bf16_t* kvsrc = P + rowbase * NPROJ + OFF_MOBA + 512 + h * 64 + sch * 8;
    u32x4_t kreg, vreg;
    { const bf16_t* s0 = kvsrc + (size_t)(q0 + srow) * NPROJ; kreg = *(const u32x4_t*)s0; vreg = *(const u32x4_t*)(s0 + 512); }
    *(LAS u32x4_t*)(lds + OFF_K + srow * PK + sch * 16) = kreg; *(LAS u32x4_t*)(lds + OFF_V + srow * PV + sch * 16) = vreg;
    __syncthreads();
    for (int i = 0; i < NT; ++i) {
        const int buf = i & 1;
        if (i + 1 < NT) { const int i1 = i + 1; const int kv1 = i1 < 4 ? q0 + 64 * i1 : ((i1 - 4) >> 2) * MBLK + 64 * ((i1 - 4) & 3);
            const bf16_t* s0 = kvsrc + (size_t)(kv1 + srow) * NPROJ; kreg = *(const u32x4_t*)s0; vreg = *(const u32x4_t*)(s0 + 512); }
        int n, j; bool own;
        if (i < 4) { own = true; n = qb; j = i; } else { own = false; n = (i - 4) >> 2; j = (i - 4) & 3; }
        const bool sel = own ? true : (((selmask >> n) & 1u) != 0u);
        bool docomp; int causal = 0;
        if (own) { docomp = j <= (w >> 1); causal = (j == (w >> 1)); }
        else docomp = __builtin_amdgcn_ballot_w64(sel) != 0ull;
        if (docomp) {
            LAS const unsigned char* Kb = lds + OFF_K + buf * KBUF; LAS const unsigned char* Vb = lds + OFF_V + buf * VBUF;
            const float trel = (float)((n - qb) * MBLK + 64 * j + 4 * hi);
            const float bl0 = sel ? cexp * trel : NEG, bl1 = sel ? cexp * (trel + 32.f) : NEG;
            f32x16 p0, p1;
#pragma unroll
            for (int r = 0; r < 16; ++r) { p0[r] = bl0 + ck[r]; p1[r] = bl1 + ck[r]; }
#pragma unroll
            for (int d0 = 0; d0 < 4; ++d0) {
                const bf16x8 a0 = *(const LAS bf16x8*)(Kb + r32 * PK + 32 * d0 + 16 * hi), a1 = *(const LAS bf16x8*)(Kb + (r32 + 32) * PK + 32 * d0 + 16 * hi);
                p0 = __builtin_amdgcn_mfma_f32_32x32x16_bf16(a0, qs[d0], p0, 0, 0, 0);
                p1 = __builtin_amdgcn_mfma_f32_32x32x16_bf16(a1, qs[d0], p1, 0, 0, 0); }
            if (causal) {
#pragma unroll
                for (int r = 0; r < 16; ++r) { const int kvrel = 64 * j + (r & 3) + 8 * (r >> 2) + 4 * hi; if (kvrel > qrel) p0[r] = NEG; if (kvrel + 32 > qrel) p1[r] = NEG; } }
            float mt = fmaxf(p0[0], p1[0]);
#pragma unroll
            for (int r = 1; r < 16; ++r) mt = fmaxf(mt, fmaxf(p0[r], p1[r]));
            mt = half_max(mt);
            const float mnew = fmaxf(mrun, mt), alpha = __builtin_amdgcn_exp2f(mrun - mnew);
            mrun = mnew; lsum *= alpha;
#pragma unroll
            for (int r = 0; r < 16; ++r) { oT0[r] *= alpha; oT1[r] *= alpha; }
            float ps = 0.f;
#pragma unroll
            for (int r = 0; r < 16; ++r) { p0[r] = __builtin_amdgcn_exp2f(p0[r] - mnew); p1[r] = __builtin_amdgcn_exp2f(p1[r] - mnew); ps += p0[r] + p1[r]; }
            lsum += ps;
            bf16x8 pb[4];
#pragma unroll
            for (int s = 0; s < 4; ++s) { u32x4_t t4;
#pragma unroll
                for (int e = 0; e < 4; ++e) { const int r = 8 * (s & 1) + 2 * e; t4[e] = (s < 2) ? pk_bf16(p0[r], p0[r + 1]) : pk_bf16(p1[r], p1[r + 1]); }
                pb[s] = __builtin_bit_cast(bf16x8, t4); }
            LAS const unsigned char* vb = Vb + (4 * hi + ((lane & 15) >> 2)) * PV + (16 * ((lane >> 4) & 1) + 4 * (lane & 3)) * 2;
#pragma unroll
            for (int s = 0; s < 4; ++s) {
                const s16x4 l0 = vtr(vb + (16 * s) * PV), h0 = vtr(vb + (16 * s + 8) * PV), l1 = vtr(vb + (16 * s) * PV + 64), h1 = vtr(vb + (16 * s + 8) * PV + 64);
                const bf16x8 va0 = {l0[0], l0[1], l0[2], l0[3], h0[0], h0[1], h0[2], h0[3]}, va1 = {l1[0], l1[1], l1[2], l1[3], h1[0], h1[1], h1[2], h1[3]};
                oT0 = __builtin_amdgcn_mfma_f32_32x32x16_bf16(va0, pb[s], oT0, 0, 0, 0);
                oT1 = __builtin_amdgcn_mfma_f32_32x32x16_bf16(va1, pb[s], oT1, 0, 0, 0); }
        }
        if (i + 1 < NT) { *(LAS u32x4_t*)(lds + OFF_K + (buf ^ 1) * KBUF + srow * PK + sch * 16) = kreg; *(LAS u32x4_t*)(lds + OFF_V + (buf ^ 1) * VBUF + srow * PV + sch * 16) = vreg; }
        __syncthreads();
    }
    const float inv = 1.f / half_sum(lsum);
    LAS unsigned char* ost = lds + OFF_OST + w * OST_W;
#pragma unroll
    for (int k = 0; k < 4; ++k) {
        u32x2_t a; a.x = pk_bf16(oT0[4 * k] * inv, oT0[4 * k + 1] * inv); a.y = pk_bf16(oT0[4 * k + 2] * inv, oT0[4 * k + 3] * inv);
        u32x2_t c; c.x = pk_bf16(oT1[4 * k] * inv, oT1[4 * k + 1] * inv); c.y = pk_bf16(oT1[4 * k + 2] * inv, oT1[4 * k + 3] * inv);
        *(LAS u32x2_t*)(ost + r32 * 144 + (8 * k + 4 * hi) * 2) = a; *(LAS u32x2_t*)(ost + r32 * 144 + (32 + 8 * k + 4 * hi) * 2) = c; }
    asm volatile("s_waitcnt lgkmcnt(0)" ::: "memory");
    bf16_t* yo = YB + (rowbase + q0 + 32 * w) * DMO + h * 64;
#pragma unroll
    for (int i = 0; i < 4; ++i) { const int row = i * 8 + (lane >> 3), ch = lane & 7; const u32x4_t v = *(const LAS u32x4_t*)(ost + row * 144 + ch * 16); *(u32x4_t*)(yo + (size_t)row * DMO + ch * 8) = v; }
    __syncthreads();
}
__device__ __forceinline__ void phase(LAS unsigned char* lds, const bf16_t* P, const float* KM, bf16_t* YB, int wv, int G, int bid) {
    for (int pi = bid; pi < NB * MH * 8; pi += G) {
        const int bh = pi >> 3, s = pi & 7;
        int tid; asm volatile("v_mbcnt_lo_u32_b32 %0, -1, 0\n\tv_mbcnt_hi_u32_b32 %0, -1, %0\n\tv_lshl_add_u32 %0, %1, 6, %0" : "=&v"(tid) : "s"(wv));
        unit(lds, P, KM, YB, bh >> 3, bh & 7, 15 - s, tid);
        unit(lds, P, KM, YB, bh >> 3, bh & 7, s, tid);
    }
}
}

namespace s5 {
constexpr int CS = 256, NCH = SEQ / CS;
constexpr int U_BYTES = CS * 32, HP = 272, WAVE_LDS = U_BYTES + 16 * HP;
constexpr size_t WS_S5E = WS_ROUTE + 1 * MiB;
__device__ __forceinline__ float blo(unsigned w) { return __uint_as_float(w << 16); }
__device__ __forceinline__ float bhi(unsigned w) { return __uint_as_float(w & 0xffff0000u); }
__device__ __forceinline__ void load_u(LAS unsigned char* ul, const bf16_t* __restrict__ P, size_t row0, int g, int lane) {
#pragma unroll
    for (int i = 0; i < 4; ++i) { const int t = lane + 64 * i; const bf16_t* src = P + (row0 + t) * NPROJ + OFF_SSM + g * 16;
        const u32x4_t v0 = *(const u32x4_t*)src, v1 = *(const u32x4_t*)(src + 8);
        *(LAS u32x4_t*)(ul + t * 32) = v0; *(LAS u32x4_t*)(ul + t * 32 + 16) = v1; }
}
struct Tab { float lre, lim, bre[16], bim[16]; };
__device__ __forceinline__ void load_tab(Tab& tb, const float* __restrict__ LAM, const float* __restrict__ BB, int g, int p) {
    tb.lre = LAM[(g * SST + p) * 2]; tb.lim = LAM[(g * SST + p) * 2 + 1];
#pragma unroll
    for (int h = 0; h < 16; h += 2) { const f32x4 v = *(const f32x4*)(BB + ((g * SST + p) * 16 + h) * 2); tb.bre[h] = v[0]; tb.bim[h] = v[1]; tb.bre[h + 1] = v[2]; tb.bim[h + 1] = v[3]; }
}
__device__ __forceinline__ void step(const Tab& tb, LAS const unsigned char* ul, int t, float& hre, float& him) {
    const u32x4_t a = *(const LAS u32x4_t*)(ul + t * 32), b = *(const LAS u32x4_t*)(ul + t * 32 + 16);
    float u[16] = {blo(a.x), bhi(a.x), blo(a.y), bhi(a.y), blo(a.z), bhi(a.z), blo(a.w), bhi(a.w), blo(b.x), bhi(b.x), blo(b.y), bhi(b.y), blo(b.z), bhi(b.z), blo(b.w), bhi(b.w)};
    float bur = 0.f, bui = 0.f;
#pragma unroll
    for (int h = 0; h < 16; ++h) { bur += tb.bre[h] * u[h]; bui += tb.bim[h] * u[h]; }
    const float nre = tb.lre * hre - tb.lim * him + bur, nim = tb.lre * him + tb.lim * hre + bui;
    hre = nre; him = nim;
}
__device__ __forceinline__ void part1(LAS unsigned char* wl, const bf16_t* __restrict__ P, const float* __restrict__ LAM, const float* __restrict__ BB, float* __restrict__ E, int unit, int lane) {
    const int c = unit & 15, g = (unit >> 4) & 31, b = unit >> 9;
    Tab tb; load_tab(tb, LAM, BB, g, lane);
    load_u(wl, P, (size_t)b * SEQ + c * CS, g, lane);
    float hre = 0.f, him = 0.f;
#pragma unroll 4
    for (int t = 0; t < CS; ++t) step(tb, wl, t, hre, him);
    *(float2*)(E + ((size_t)unit * SST + lane) * 2) = make_float2(hre, him);
}
__device__ __forceinline__ void part2(LAS unsigned char* wl, const bf16_t* __restrict__ P, const float* __restrict__ LAM, const float* __restrict__ BB, const float* __restrict__ E,
                                      const float* __restrict__ c_re, const float* __restrict__ c_im, const float* __restrict__ dvec, bf16_t* __restrict__ YCPRE, int unit, int lane) {
    const int c = unit & 15, g = (unit >> 4) & 31, b = unit >> 9;
    Tab tb; load_tab(tb, LAM, BB, g, lane);
    const size_t row0 = (size_t)b * SEQ + c * CS;
    load_u(wl, P, row0, g, lane);
    const int ch = lane & 15, kq = lane >> 4;
    bf16x8 cf[4];
#pragma unroll
    for (int s = 0; s < 4; ++s) { const int k0 = (32 * s + 8 * kq) & 63; const float* src = (s < 2 ? c_re : c_im) + (size_t)(g * 16 + ch) * SST + k0; const float sg = s < 2 ? 1.f : -1.f;
        const f32x4 v0 = *(const f32x4*)src, v1 = *(const f32x4*)(src + 4);
        u32x4_t t4 = {att::pk_bf16(sg * v0[0], sg * v0[1]), att::pk_bf16(sg * v0[2], sg * v0[3]), att::pk_bf16(sg * v1[0], sg * v1[1]), att::pk_bf16(sg * v1[2], sg * v1[3])};
        cf[s] = __builtin_bit_cast(bf16x8, t4); }
    const float dch = dvec[g * 16 + ch];
    float hre = 0.f, him = 0.f;
    { float pr = tb.lre, pi = tb.lim;
#pragma unroll
      for (int i = 0; i < 8; ++i) { const float nr = pr * pr - pi * pi, ni = 2.f * pr * pi; pr = nr; pi = ni; }
      const float* e0 = E + ((size_t)(unit - c) * SST + lane) * 2;
      for (int cc = 0; cc < c; ++cc) { const float2 e = *(const float2*)(e0 + (size_t)cc * SST * 2); const float nr = pr * hre - pi * him + e.x, ni = pr * him + pi * hre + e.y; hre = nr; him = ni; } }
    LAS unsigned char* ht = wl + U_BYTES;
    for (int sub = 0; sub < CS / 16; ++sub) {
#pragma unroll 4
        for (int tt = 0; tt < 16; ++tt) { step(tb, wl, sub * 16 + tt, hre, him);
            *(LAS bf16_t*)(ht + tt * HP + lane * 2) = f2bf(hre); *(LAS bf16_t*)(ht + tt * HP + (64 + lane) * 2) = f2bf(him); }
        f32x4 acc = {0.f, 0.f, 0.f, 0.f};
#pragma unroll
        for (int s = 0; s < 4; ++s) { const bf16x8 a = *(const LAS bf16x8*)(ht + ch * HP + (32 * s + 8 * kq) * 2); acc = __builtin_amdgcn_mfma_f32_16x16x32_bf16(a, cf[s], acc, 0, 0, 0); }
#pragma unroll
        for (int r = 0; r < 4; ++r) { const int t = sub * 16 + 4 * kq + r; const float u = bf2f(*(const LAS bf16_t*)(wl + t * 32 + ch * 2));
            const float y = acc[r] + dch * u; const float gl = y * pg8::sigm(1.5957691216057308f * (y + 0.044715f * y * y * y));
            YCPRE[(row0 + t) * DSS + g * 16 + ch] = f2bf(gl); }
    }
}
}

namespace wkv {
constexpr int CH = 64, NCHK = SEQ / CH;
constexpr size_t WS_GST = 320 * MiB, WS_GYT = 336 * MiB, WS_YLT = 368 * MiB, WS_SLT = 416 * MiB;
constexpr size_t WS_PEND = WS_ROUTE + 2 * MiB;
constexpr size_t WS_RK = WS_ROUTE + 3 * MiB;
constexpr size_t SM_W2T = 1 * MiB, SM_A2T = SM_W2T + 65536, SM_G2T = SM_A2T + 65536;
constexpr int PB = 144;
constexpr int L_ACT = 0, ACT_P = 528;
constexpr int L_SW = 33792, L_SA = L_SW + 16640, L_SG = L_SA + 16640, L_LW = 83712, LP = 65;
constexpr int L_PART = 33792;
constexpr int M_AT = 0, M_RT = 9216, M_BT = 18432, M_KT = 27648, M_BH = 36864, M_KH = 46080, M_VT = 55296;
constexpr int L_NABT = 64512, NAB_P = 272, L_NAK = 81920, L_NBRT = 98560, L_NKRT = 107776;
constexpr int M_W1 = M_AT, M_M2T = L_NAK;
static_assert(L_NABT + 64 * NAB_P <= L_NAK && L_NAK + 64 * 65 * 4 <= L_NBRT && L_NKRT + 9216 <= 131072 && L_LW + 16640 <= 131072, "wkv LDS map");

typedef unsigned u32x2_t __attribute__((ext_vector_type(2)));
using att::pk_bf16;
template <int CTRL> __device__ __forceinline__ float dppx(float v) { return __builtin_bit_cast(float, __builtin_amdgcn_update_dpp(0, __builtin_bit_cast(int, v), CTRL, 0xF, 0xF, false)); }
__device__ __forceinline__ float sum8(float v) { v += dppx<0xB1>(v); v += dppx<0x4E>(v); v += dppx<0x141>(v); return v; }
__device__ __forceinline__ bf16x8 ld8(LAS const unsigned char* p) { return *(const LAS bf16x8*)p; }
__device__ __forceinline__ bf16x8 ld44(LAS const unsigned char* p0, LAS const unsigned char* p1) { const u32x2_t a = *(const LAS u32x2_t*)p0, b = *(const LAS u32x2_t*)p1; u32x4_t t = {a.x, a.y, b.x, b.y}; return __builtin_bit_cast(bf16x8, t); }
__device__ __forceinline__ bf16x8 acc2b(const f32x4& x, const f32x4& y) { u32x4_t t = {pk_bf16(x[0], x[1]), pk_bf16(x[2], x[3]), pk_bf16(y[0], y[1]), pk_bf16(y[2], y[3])}; return __builtin_bit_cast(bf16x8, t); }
#define MFMA16(a, b, c) __builtin_amdgcn_mfma_f32_16x16x32_bf16(a, b, c, 0, 0, 0)

template <int TT> __device__ __forceinline__ void sub_step(float (&x)[64], LAS const unsigned char* lds) {
    float acc = x[TT];
#pragma unroll
    for (int s4 = 0; s4 < (TT + 3) / 4; ++s4) { const f32x4 nv = *(const LAS f32x4*)(lds + L_NABT + TT * NAB_P + s4 * 16);
#pragma unroll
        for (int e = 0; e < 4; ++e) if (4 * s4 + e < TT) acc += x[4 * s4 + e] * nv[e]; }
    x[TT] = acc;
}
template <int T0, int T1> struct SubRun {
    static __device__ __forceinline__ void load(float (&x)[64], LAS const unsigned char* lds, int lane, int wv) {
        x[T0] = wv == 0 ? bf2f(*(const LAS bf16_t*)(lds + M_AT + T0 * PB + lane * 2)) : *(const LAS float*)(lds + L_NAK + (lane * 65 + T0) * 4); SubRun<T0 + 1, T1>::load(x, lds, lane, wv); }
    static __device__ __forceinline__ void go(float (&x)[64], LAS const unsigned char* lds) { sub_step<T0>(x, lds); SubRun<T0 + 1, T1>::go(x, lds); }
    static __device__ __forceinline__ void store_m2t(const float (&x)[64], LAS unsigned char* lds, int lane) { *(LAS bf16_t*)(lds + M_M2T + T0 * PB + lane * 2) = f2bf(x[T0]); SubRun<T0 + 1, T1>::store_m2t(x, lds, lane); }
};
template <int T1> struct SubRun<T1, T1> {
    static __device__ __forceinline__ void load(float (&)[64], LAS const unsigned char*, int, int) {}
    static __device__ __forceinline__ void go(float (&)[64], LAS const unsigned char*) {}
    static __device__ __forceinline__ void store_m2t(const float (&)[64], LAS unsigned char*, int) {}
};
template <int G8> __device__ __forceinline__ void store_w1(const float (&x)[64], LAS unsigned char* lds, int lane) {
    u32x4_t o = {pk_bf16(x[8 * G8], x[8 * G8 + 1]), pk_bf16(x[8 * G8 + 2], x[8 * G8 + 3]), pk_bf16(x[8 * G8 + 4], x[8 * G8 + 5]), pk_bf16(x[8 * G8 + 6], x[8 * G8 + 7])};
    *(LAS u32x4_t*)(lds + M_W1 + lane * PB + G8 * 16) = o;
}

struct PreArgs { const bf16_t* P; const float *mu, *w0, *a0, *k_k, *k_a, *r_k; const bf16_t *w2t, *a2t, *g2t; bf16_t *Vo, *Go; float* RK; bf16_t *GST, *GYT; float *YLT, *SLT, *PEND; };

__device__ __forceinline__ void unit_pre(LAS unsigned char* lds, const PreArgs& A, int u, int tid) {
    const int lane = tid & 63, wv = __builtin_amdgcn_readfirstlane(tid >> 6), fr = lane & 15, q = lane >> 4;
    const int c = u & 63, h = (u >> 6) & 7, b = u >> 9;
    const size_t row0 = (size_t)b * SEQ + c * CH;
    const bool seq0 = (c == 0);
    { const int i8 = tid & 31, tr = tid >> 5; const int col = 1536 + 8 * i8;
      const f32x4 m0 = *(const f32x4*)(A.mu + col), m1 = *(const f32x4*)(A.mu + col + 4);
#pragma unroll
      for (int k = 0; k < 4; ++k) { const int t = tr + 16 * k; const bf16_t* rp = A.P + (row0 + t) * NPROJ + col;
          const u32x4_t zc = *(const u32x4_t*)rp; u32x4_t zp = {0u, 0u, 0u, 0u}; if (!(seq0 && t == 0)) zp = *(const u32x4_t*)(rp - NPROJ);
          float z[8] = {s5::blo(zc.x), s5::bhi(zc.x), s5::blo(zc.y), s5::bhi(zc.y), s5::blo(zc.z), s5::bhi(zc.z), s5::blo(zc.w), s5::bhi(zc.w)};
          const float zq[8] = {s5::blo(zp.x), s5::bhi(zp.x), s5::blo(zp.y), s5::bhi(zp.y), s5::blo(zp.z), s5::bhi(zp.z), s5::blo(zp.w), s5::bhi(zp.w)};
#pragma unroll
          for (int e = 0; e < 8; ++e) { const float mm = e < 4 ? m0[e] : m1[e - 4]; float x = z[e] + (zq[e] - z[e]) * mm;
              if (i8 < 8) x = 1.f - 2.f * __builtin_amdgcn_rcpf(1.f + __expf(2.f * x)); else if (i8 >= 16) x = pg8::sigm(x);
              z[e] = x; }
          u32x4_t o = {pk_bf16(z[0], z[1]), pk_bf16(z[2], z[3]), pk_bf16(z[4], z[5]), pk_bf16(z[6], z[7])};
          *(LAS u32x4_t*)(lds + L_ACT + t * ACT_P + i8 * 16) = o; } }
    __syncthreads();
    { const int m = wv & 3, nh = wv >> 2; f32x4 aw[2] = {{0.f, 0.f, 0.f, 0.f}, {0.f, 0.f, 0.f, 0.f}}, aa[2] = {aw[0], aw[0]}, ag[2] = {aw[0], aw[0]};
#pragma unroll
      for (int s = 0; s < 8; ++s) { const bf16x8 af = ld8(lds + L_ACT + (16 * m + fr) * ACT_P + (32 * s + 8 * q) * 2);
#pragma unroll
          for (int nn = 0; nn < 2; ++nn) { const int ch = 64 * h + 16 * (2 * nh + nn) + fr;
              if (s < 2) { const bf16x8 bf = *(const bf16x8*)(A.w2t + (size_t)ch * 64 + 32 * s + 8 * q); aw[nn] = MFMA16(af, bf, aw[nn]); }
              else if (s < 4) { const bf16x8 bf = *(const bf16x8*)(A.a2t + (size_t)ch * 64 + 32 * (s - 2) + 8 * q); aa[nn] = MFMA16(af, bf, aa[nn]); }
              else { const bf16x8 bf = *(const bf16x8*)(A.g2t + (size_t)ch * 128 + 32 * (s - 4) + 8 * q); ag[nn] = MFMA16(af, bf, ag[nn]); } } }
#pragma unroll
      for (int nn = 0; nn < 2; ++nn)
#pragma unroll
          for (int r = 0; r < 4; ++r) { const int off = ((16 * m + 4 * q + r) * LP + 16 * (2 * nh + nn) + fr) * 4;
              *(LAS float*)(lds + L_SW + off) = aw[nn][r]; *(LAS float*)(lds + L_SA + off) = aa[nn][r]; *(LAS float*)(lds + L_SG + off) = ag[nn][r]; } }
    __syncthreads();
    const int t = tid >> 3, j8 = tid & 7, j0 = 8 * j8, ch0 = 64 * h + j0;
    float r_[8], kp_[8], b_[8], an_[8], v_[8];
    { const bf16_t* rp = A.P + (row0 + t) * NPROJ + ch0; const bool first = seq0 && t == 0;
      float lw[8], g_[8]; float ss = 0.f, rk = 0.f;
#pragma unroll
      for (int part = 0; part < 3; ++part) {
          const u32x4_t zc = *(const u32x4_t*)(rp + 512 * part); u32x4_t zp = {0u, 0u, 0u, 0u}; if (!first) zp = *(const u32x4_t*)(rp + 512 * part - NPROJ);
          const f32x4 m0 = *(const f32x4*)(A.mu + 512 * part + ch0), m1 = *(const f32x4*)(A.mu + 512 * part + ch0 + 4);
          const float z[8] = {s5::blo(zc.x), s5::bhi(zc.x), s5::blo(zc.y), s5::bhi(zc.y), s5::blo(zc.z), s5::bhi(zc.z), s5::blo(zc.w), s5::bhi(zc.w)};
          const float zq[8] = {s5::blo(zp.x), s5::bhi(zp.x), s5::blo(zp.y), s5::bhi(zp.y), s5::blo(zp.z), s5::bhi(zp.z), s5::blo(zp.w), s5::bhi(zp.w)};
#pragma unroll
          for (int e = 0; e < 8; ++e) { const float x = z[e] + (zq[e] - z[e]) * (e < 4 ? m0[e] : m1[e - 4]); if (part == 0) r_[e] = x; else if (part == 1) kp_[e] = x; else v_[e] = x; } }
      const f32x4 w0a = *(const f32x4*)(A.w0 + ch0), w0b = *(const f32x4*)(A.w0 + ch0 + 4), a0a = *(const f32x4*)(A.a0 + ch0), a0b = *(const f32x4*)(A.a0 + ch0 + 4);
      const f32x4 kka = *(const f32x4*)(A.k_k + ch0), kkb = *(const f32x4*)(A.k_k + ch0 + 4), kaa = *(const f32x4*)(A.k_a + ch0), kab = *(const f32x4*)(A.k_a + ch0 + 4);
      const f32x4 rka = *(const f32x4*)(A.r_k + ch0), rkb = *(const f32x4*)(A.r_k + ch0 + 4);
      float kk[8];
#pragma unroll
      for (int e = 0; e < 8; ++e) { const int off = (t * LP + j0 + e) * 4;
          const float sw = *(const LAS float*)(lds + L_SW + off), sa = *(const LAS float*)(lds + L_SA + off); g_[e] = *(const LAS float*)(lds + L_SG + off);
          const float xx = -((e < 4 ? w0a[e] : w0b[e - 4]) + sw);
          const float sp = fmaxf(xx, 0.f) + __logf(1.f + __expf(-fabsf(xx)));
          lw[e] = -__expf(-sp - 0.5f);
          const float a = pg8::sigm((e < 4 ? a0a[e] : a0b[e - 4]) + sa);
          const float k = kp_[e];
          kk[e] = k * (e < 4 ? kka[e] : kkb[e - 4]); ss += kk[e] * kk[e];
          kp_[e] = k * (1.f + (a - 1.f) * (e < 4 ? kaa[e] : kab[e - 4]));
          rk += r_[e] * kp_[e] * (e < 4 ? rka[e] : rkb[e - 4]);
          b_[e] = a; }
      ss = sum8(ss); rk = sum8(rk);
      const float rs = rsqrtf(fmaxf(ss, 1e-24f));
#pragma unroll
      for (int e = 0; e < 8; ++e) { const float kn = kk[e] * rs; an_[e] = -kn; b_[e] = kn * b_[e]; *(LAS float*)(lds + L_LW + (t * LP + j0 + e) * 4) = lw[e]; }
      if (j8 == 0) A.RK[(row0 + t) * 8 + h] = rk;
      u32x4_t ov = {pk_bf16(v_[0], v_[1]), pk_bf16(v_[2], v_[3]), pk_bf16(v_[4], v_[5]), pk_bf16(v_[6], v_[7])}, og = {pk_bf16(g_[0], g_[1]), pk_bf16(g_[2], g_[3]), pk_bf16(g_[4], g_[5]), pk_bf16(g_[6], g_[7])};
      *(u32x4_t*)(A.Vo + (row0 + t) * DR + ch0) = ov; *(u32x4_t*)(A.Go + (row0 + t) * DR + ch0) = og; }
    __syncthreads();
    { const int j = tid & 63, part = tid >> 6; float s = 0.f;
#pragma unroll
      for (int e = 0; e < 8; ++e) { LAS float* p = (LAS float*)(lds + L_LW + ((8 * part + e) * LP + j) * 4); s += *p; *p = s; }
      *(LAS float*)(lds + L_PART + (part * 64 + j) * 4) = s;
      __syncthreads();
      float o = 0.f;
      for (int pp = 0; pp < part; ++pp) o += *(const LAS float*)(lds + L_PART + (pp * 64 + j) * 4);
#pragma unroll
      for (int e = 0; e < 8; ++e) { LAS float* p = (LAS float*)(lds + L_LW + ((8 * part + e) * LP + j) * 4); *p += o; } }
    __syncthreads();
    { float lp[8], lpm[8], lpe[8];
#pragma unroll
      for (int e = 0; e < 8; ++e) { lp[e] = *(const LAS float*)(lds + L_LW + (t * LP + j0 + e) * 4); lpm[e] = t > 0 ? *(const LAS float*)(lds + L_LW + ((t - 1) * LP + j0 + e) * 4) : 0.f;
          lpe[e] = *(const LAS float*)(lds + L_LW + (63 * LP + j0 + e) * 4); }
      __syncthreads();
      float at[8], rt[8], bt[8], kt[8], bh[8], kh[8];
#pragma unroll
      for (int e = 0; e < 8; ++e) { const float Pt = __expf(lp[e]), Pm = __expf(lpm[e]), Pi = __expf(-lp[e]), Pe = __expf(lpe[e] - lp[e]);
          at[e] = an_[e] * Pm; rt[e] = r_[e] * Pt; bt[e] = b_[e] * Pi; kt[e] = kp_[e] * Pi; bh[e] = b_[e] * Pe; kh[e] = kp_[e] * Pe;
          if (t == 0) A.PEND[(size_t)u * 64 + j0 + e] = __expf(lpe[e]); }
      auto st8 = [&](int base, const float* x) { u32x4_t o = {pk_bf16(x[0], x[1]), pk_bf16(x[2], x[3]), pk_bf16(x[4], x[5]), pk_bf16(x[6], x[7])}; *(LAS u32x4_t*)(lds + base + t * PB + j0 * 2) = o; };
      st8(M_AT, at); st8(M_RT, rt); st8(M_BT, bt); st8(M_KT, kt);
#pragma unroll
      for (int e = 0; e < 8; ++e) { *(LAS bf16_t*)(lds + M_BH + (j0 + e) * PB + t * 2) = f2bf(bh[e]); *(LAS bf16_t*)(lds + M_KH + (j0 + e) * PB + t * 2) = f2bf(kh[e]); *(LAS bf16_t*)(lds + M_VT + (j0 + e) * PB + t * 2) = f2bf(v_[e]); } }
    __syncthreads();
    { const int rt = wv >> 1;
#pragma unroll
      for (int cc = 0; cc < 2; ++cc) { const int ct = 2 * (wv & 1) + cc; f32x4 nab = {0.f, 0.f, 0.f, 0.f}, nak = nab;
#pragma unroll
          for (int kk = 0; kk < 2; ++kk) { const int ko = (32 * kk + 8 * q) * 2;
              const bf16x8 bfr = ld8(lds + M_AT + (16 * ct + fr) * PB + ko);
              nab = MFMA16(ld8(lds + M_BT + (16 * rt + fr) * PB + ko), bfr, nab); nak = MFMA16(ld8(lds + M_KT + (16 * rt + fr) * PB + ko), bfr, nak); }
          const int tt = 16 * ct + fr, s0 = 16 * rt + 4 * q;
#pragma unroll
          for (int r = 0; r < 4; ++r) { if (!(s0 + r < tt)) { nab[r] = 0.f; nak[r] = 0.f; } *(LAS float*)(lds + L_NAK + ((s0 + r) * 65 + tt) * 4) = nak[r]; }
          *(LAS f32x4*)(lds + L_NABT + tt * NAB_P + s0 * 4) = nab; } }
    __syncthreads();
    if (wv < 2) {
        float x[64];
        SubRun<0, 64>::load(x, lds, lane, wv);
        SubRun<0, 64>::go(x, lds);
        if (wv == 0) { store_w1<0>(x, lds, lane); store_w1<1>(x, lds, lane); store_w1<2>(x, lds, lane); store_w1<3>(x, lds, lane); store_w1<4>(x, lds, lane); store_w1<5>(x, lds, lane); store_w1<6>(x, lds, lane); store_w1<7>(x, lds, lane); }
        else SubRun<0, 64>::store_m2t(x, lds, lane);
    } else {
        for (int tl = wv - 2; tl < 32; tl += 6) { const int mat = tl >> 4, rt = (tl >> 2) & 3, ct = tl & 3; f32x4 nn = {0.f, 0.f, 0.f, 0.f};
#pragma unroll
            for (int kk = 0; kk < 2; ++kk) { const int ko = (32 * kk + 8 * q) * 2;
                nn = MFMA16(ld8(lds + (mat ? M_KT : M_BT) + (16 * rt + fr) * PB + ko), ld8(lds + M_RT + (16 * ct + fr) * PB + ko), nn); }
            const int tt = 16 * ct + fr, s0 = 16 * rt + 4 * q;
#pragma unroll
            for (int r = 0; r < 4; ++r) if (!(s0 + r <= tt)) nn[r] = 0.f;
            u32x2_t o = {pk_bf16(nn[0], nn[1]), pk_bf16(nn[2], nn[3])};
            *(LAS u32x2_t*)(lds + (mat ? L_NKRT : L_NBRT) + tt * PB + s0 * 2) = o; }
    }
    __syncthreads();
    {
      const int cta = wv & 3, s = wv >> 2;
      f32x4 gy[2], gs[2];
#pragma unroll
      for (int hh = 0; hh < 2; ++hh) { const int rt = 2 * s + hh;
          const u32x2_t rr = *(const LAS u32x2_t*)(lds + M_RT + (16 * cta + fr) * PB + (16 * rt + 4 * q) * 2);
          gy[hh] = (f32x4){s5::blo(rr.x), s5::bhi(rr.x), s5::blo(rr.y), s5::bhi(rr.y)}; gs[hh] = (f32x4){0.f, 0.f, 0.f, 0.f};
#pragma unroll
          for (int kk = 0; kk < 2; ++kk) { const int ko = (32 * kk + 8 * q) * 2; const bf16x8 w1 = ld8(lds + M_W1 + (16 * rt + fr) * PB + ko);
              gy[hh] = MFMA16(w1, ld8(lds + L_NBRT + (16 * cta + fr) * PB + ko), gy[hh]);
              gs[hh] = MFMA16(w1, ld8(lds + M_BH + (16 * cta + fr) * PB + ko), gs[hh]); } }
      *(bf16x8*)(A.GYT + (size_t)u * 4096 + ((cta * 2 + s) * 64 + lane) * 8) = acc2b(gy[0], gy[1]);
      *(bf16x8*)(A.GST + (size_t)u * 4096 + ((cta * 2 + s) * 64 + lane) * 8) = acc2b(gs[0], gs[1]); }
    {
      const int vi = wv & 3, mh = wv >> 2;
      f32x4 vw[4];
#pragma unroll
      for (int rt = 0; rt < 4; ++rt) { vw[rt] = (f32x4){0.f, 0.f, 0.f, 0.f};
#pragma unroll
          for (int kk = 0; kk < 2; ++kk) { const int ko = (32 * kk + 8 * q) * 2; vw[rt] = MFMA16(ld8(lds + M_M2T + (16 * rt + fr) * PB + ko), ld8(lds + M_VT + (16 * vi + fr) * PB + ko), vw[rt]); } }
      const bf16x8 vb0 = acc2b(vw[0], vw[1]), vb1 = acc2b(vw[2], vw[3]);
#pragma unroll
      for (int hh = 0; hh < 2; ++hh) { const int m = 2 * mh + hh; f32x4 yl = {0.f, 0.f, 0.f, 0.f}, sl = yl;
          LAS const unsigned char* nb = lds + L_NBRT + (16 * m + fr) * PB; LAS const unsigned char* bhp = lds + M_BH + (16 * m + fr) * PB;
          yl = MFMA16(ld44(nb + (4 * q) * 2, nb + (16 + 4 * q) * 2), vb0, yl); yl = MFMA16(ld44(nb + (32 + 4 * q) * 2, nb + (48 + 4 * q) * 2), vb1, yl);
          sl = MFMA16(ld44(bhp + (4 * q) * 2, bhp + (16 + 4 * q) * 2), vb0, sl); sl = MFMA16(ld44(bhp + (32 + 4 * q) * 2, bhp + (48 + 4 * q) * 2), vb1, sl);
#pragma unroll
          for (int kk = 0; kk < 2; ++kk) { const int ko = (32 * kk + 8 * q) * 2; const bf16x8 vf = ld8(lds + M_VT + (16 * vi + fr) * PB + ko);
              yl = MFMA16(ld8(lds + L_NKRT + (16 * m + fr) * PB + ko), vf, yl); sl = MFMA16(ld8(lds + M_KH + (16 * m + fr) * PB + ko), vf, sl); }
          *(f32x4*)(A.YLT + (size_t)u * 4096 + ((vi * 4 + m) * 64 + lane) * 4) = yl;
          *(f32x4*)(A.SLT + (size_t)u * 4096 + ((vi * 4 + m) * 64 + lane) * 4) = sl; } }
    __syncthreads();
}

__device__ __forceinline__ void seq(const bf16_t* __restrict__ GST, const bf16_t* __restrict__ GYT, const float* __restrict__ YLT, const float* __restrict__ SLT, const float* __restrict__ PEND,
                                    float* __restrict__ YRAW, int bh, int vi, int lane) {
    const int fr = lane & 15, q = lane >> 4, b = bh >> 3, h = bh & 7;
    f32x4 st[4] = {{0.f, 0.f, 0.f, 0.f}, {0.f, 0.f, 0.f, 0.f}, {0.f, 0.f, 0.f, 0.f}, {0.f, 0.f, 0.f, 0.f}};
    for (int c = 0; c < NCHK; ++c) {
        const size_t u = (size_t)bh * 64 + c;
        bf16x8 gs[4][2], gy[4][2]; f32x4 pe[4], sl[4], yl[4];
#pragma unroll
        for (int a = 0; a < 4; ++a) {
#pragma unroll
            for (int s = 0; s < 2; ++s) { gs[a][s] = *(const bf16x8*)(GST + u * 4096 + ((a * 2 + s) * 64 + lane) * 8); gy[a][s] = *(const bf16x8*)(GYT + u * 4096 + ((a * 2 + s) * 64 + lane) * 8); }
            pe[a] = *(const f32x4*)(PEND + u * 64 + 16 * a + 4 * q);
            sl[a] = *(const f32x4*)(SLT + u * 4096 + ((vi * 4 + a) * 64 + lane) * 4); yl[a] = *(const f32x4*)(YLT + u * 4096 + ((vi * 4 + a) * 64 + lane) * 4); }
        const bf16x8 sb0 = acc2b(st[0], st[1]), sb1 = acc2b(st[2], st[3]);
#pragma unroll
        for (int m = 0; m < 4; ++m) { f32x4 y = MFMA16(gy[m][0], sb0, yl[m]); y = MFMA16(gy[m][1], sb1, y);
#pragma unroll
            for (int r = 0; r < 4; ++r) YRAW[((size_t)b * SEQ + c * CH + 16 * m + 4 * q + r) * DR + h * 64 + 16 * vi + fr] = y[r]; }
#pragma unroll
        for (int a = 0; a < 4; ++a) { f32x4 n = sl[a] + pe[a] * st[a]; n = MFMA16(gs[a][0], sb0, n); n = MFMA16(gs[a][1], sb1, n); st[a] = n; }
    }
}
__device__ __forceinline__ void post(int t, int c, const float* __restrict__ YRAW, const bf16_t* __restrict__ V, const bf16_t* __restrict__ GG, const float* __restrict__ RK,
                                     const float* __restrict__ ln_w, const float* __restrict__ ln_b, bf16_t* __restrict__ YA) {
    const size_t o = (size_t)t * DR + c;
    const float y = YRAW[o];
    const float mean = wave_allsum(y) * (1.f / 64.f);
    const float dv = y - mean;
    const float var = wave_allsum(dv * dv) * (1.f / 64.f);
    const float yn = dv * rsqrtf(var + GN_EPS) * ln_w[c] + ln_b[c];
    YA[o] = f2bf((yn + RK[(size_t)t * 8 + (c >> 6)] * bf2f(V[o])) * bf2f(GG[o]));
}
}

constexpr int RING_BYTES = 131072;
constexpr int MISC_OFF = RING_BYTES;
constexpr int LDS_BYTES = 147456;

struct Args { const float* in[39]; float* out; unsigned char* ws; };
__device__ __forceinline__ int lnd(int v) { asm volatile("" : "+s"(v)); return v; }
#ifdef GEMM_ONLY
#define VBL(nvb, vbsz) for (int vb = 0, vt = 0; vb < 0;)
#else
#define VBL(nvb, vbsz) for (int _t = otid(c.wv), _g = lnd((int)gridDim.x), vb = lnd((int)blockIdx.x) * (512 / (vbsz)) + _t / (vbsz), vt = _t % (vbsz); vb < (nvb); vb += _g * (512 / (vbsz)))
#endif

__device__ __forceinline__ void tr_item(const float* __restrict__ W, int ldw, int K, int nblk, bf16_t* __restrict__ WT, int interleave, int row_off, LAS float* scr, int item, int lane) {
    const int kb = item / nblk, nb = item % nblk, k0 = 64 * kb, n0 = 32 * nb;
#pragma unroll 8
    for (int i = 0; i < 32; ++i) { const int kk = 2 * i + (lane >> 5); scr[kk * 33 + (lane & 31)] = W[(size_t)(k0 + kk) * ldw + n0 + (lane & 31)]; }
    asm volatile("s_waitcnt lgkmcnt(0)" ::: "memory");
    const int c = lane & 7;
    const int dr0 = interleave ? ((n0 >> 7) * 256 + (n0 & 127) + row_off) : (n0 + row_off);
#pragma unroll
    for (int j = 0; j < 4; ++j) { const int n = (lane >> 3) + 8 * j; const LAS float* sp = scr + (8 * c) * 33 + n;
        uint4 o; o.x = (unsigned)f2bf(sp[0 * 33]) | ((unsigned)f2bf(sp[1 * 33]) << 16); o.y = (unsigned)f2bf(sp[2 * 33]) | ((unsigned)f2bf(sp[3 * 33]) << 16);
        o.z = (unsigned)f2bf(sp[4 * 33]) | ((unsigned)f2bf(sp[5 * 33]) << 16); o.w = (unsigned)f2bf(sp[6 * 33]) | ((unsigned)f2bf(sp[7 * 33]) << 16);
        *(uint4*)(WT + (size_t)(dr0 + n) * K + k0 + 8 * c) = o; }
    asm volatile("s_waitcnt lgkmcnt(0)" ::: "memory");
}
struct Ctx { volatile LAS unsigned long long* tab; unsigned char* ws0; float* X; LAS unsigned char* lds; int wv; };
__device__ __forceinline__ const float* inp(const Ctx& c, int k) { volatile LAS unsigned long long* tp = c.tab; asm volatile("" : "+s"(tp)); const unsigned long long v = tp[k]; const unsigned lo = __builtin_amdgcn_readfirstlane((unsigned)v), hi = __builtin_amdgcn_readfirstlane((unsigned)(v >> 32));
    return (const float*)(((unsigned long long)hi << 32) | lo); }
__device__ __forceinline__ unsigned char* wsl(const Ctx& c) { unsigned char* w = c.ws0; asm volatile("" : "+s"(w)); return w; }
#define WBF(off) ((bf16_t*)(w + (off)))
#define WF32(off) ((float*)(w + (off)))

__device__ __forceinline__ void phase_weights(const Ctx& c, int l) {
    unsigned char* w = wsl(c);
    const int tid = otid(c.wv), lane = tid & 63, wave = tid >> 6;
    LAS float* scr = (LAS float*)(c.lds + wave * 16384);
    const int gw = lnd((int)blockIdx.x) * 8 + wave, NGW = lnd((int)gridDim.x) * 8;
    constexpr int I_IN = (D / 64) * (NPROJ / 32), I_GLU = (DSS / 64) * (DSS / 32), I_UP = (DR / 64) * (D / 32), I_OUT = (D / 64) * (D / 32), I_EG = (D / 64) * (DE / 32), I_ED = (DE / 64) * (D / 32);
    constexpr int I_E = 2 * I_EG + I_ED;
    constexpr int I_LORA = 16 + 16 + 32;
    constexpr int NITEMS = I_IN + 2 * I_GLU + 3 * I_UP + I_OUT + NE * I_E + I_LORA;
    for (int it = gw; it < NITEMS; it += NGW) {
        int r = it;
        if (r < I_LORA) {
            if (r < 16) tr_item(inp(c, 4) + (size_t)l * 64 * DR, DR, 64, DR / 32, WBF(WS_SMALL + wkv::SM_W2T), 0, 0, scr, r, lane);
            else if (r < 32) tr_item(inp(c, 6) + (size_t)l * 64 * DR, DR, 64, DR / 32, WBF(WS_SMALL + wkv::SM_A2T), 0, 0, scr, r - 16, lane);
            else tr_item(inp(c, 7) + (size_t)l * 128 * DR, DR, 128, DR / 32, WBF(WS_SMALL + wkv::SM_G2T), 0, 0, scr, r - 32, lane);
            continue; }
        r -= I_LORA;
        if (r < I_IN) { tr_item(inp(c, 1) + (size_t)l * D * NPROJ, NPROJ, D, NPROJ / 32, WBF(WS_WT_IN), 0, 0, scr, r, lane); continue; } r -= I_IN;
        if (r < 2 * I_GLU) { const int hf = r / I_GLU; tr_item(inp(c, 21) + (size_t)l * DSS * 2 * DSS + hf * DSS, 2 * DSS, DSS, DSS / 32, WBF(WS_WT_GLU), 1, hf * 128, scr, r % I_GLU, lane); continue; } r -= 2 * I_GLU;
        if (r < 3 * I_UP) { const int br = r / I_UP; tr_item(inp(c, 23 + br) + (size_t)l * DR * D, D, DR, D / 32, WBF(WS_WT_UPA + (size_t)br * MiB), 0, 0, scr, r % I_UP, lane); continue; } r -= 3 * I_UP;
        if (r < I_OUT) { tr_item(inp(c, 27) + (size_t)l * D * D, D, D, D / 32, WBF(WS_WT_OUT), 0, 0, scr, r, lane); continue; } r -= I_OUT;
        const int e = r / I_E; r %= I_E; const size_t eo = ((size_t)l * NE + e) * D * DE;
        if (r < 2 * I_EG) { const int hf = r / I_EG; tr_item(inp(c, 34 + hf) + eo, DE, D, DE / 32, WBF(WS_WT_EGU) + (size_t)e * 512 * D, 1, hf * 128, scr, r % I_EG, lane); continue; } r -= 2 * I_EG;
        tr_item(inp(c, 36) + eo, D, DE, D / 32, WBF(WS_WT_ED) + (size_t)e * D * DE, 0, 0, scr, r, lane);
    }
    VBL(36 * 1024 / 256, 256) k_rtw(vb, vt, inp(c, 30) + (size_t)l * D * 4, inp(c, 32) + (size_t)l * D * 32, WF32(WS_SMALL + SM_RTW));
    VBL(NGR * SST / 256, 256) k_s5tab(vb, vt, inp(c, 13) + (size_t)l * NGR * SST, inp(c, 14) + (size_t)l * NGR * SST, inp(c, 15) + (size_t)l * NGR * SST * SGRP,
                                      inp(c, 16) + (size_t)l * NGR * SST * SGRP, inp(c, 20) + (size_t)l * NGR, WF32(WS_SMALL + SM_LAM), WF32(WS_SMALL + SM_BB));
}

#define GB() xcd_barrier(bar)
template <int l> __device__ __forceinline__ void layer_body(const Ctx& c, const XcdBarrier& bar, LAS unsigned char* lds, unsigned char* lds_raw, volatile LAS unsigned* MISC, int G) {
        { unsigned char* w = wsl(c);
          pg8::Gemm g{WBF(WS_XN), WBF(WS_WT_IN), T, NPROJ, D}; pg8::StaticOrder S; S.init(T, NPROJ, lnd(G), lnd((int)blockIdx.x));
          pg8::EpiBf16<0> E{WBF(WS_PROJ), NPROJ, nullptr, 0, 0, 1.f};
          pg8::gemm_phase<pg8::EpiBf16<0>, pg8::StaticOrder, true, true>(lds, g, S, E, c.wv); }
        GB();
        { unsigned char* w = wsl(c);
          { wkv::PreArgs pa; pa.P = WBF(WS_PROJ); pa.mu = inp(c, 2) + (size_t)l * 1792; pa.w0 = inp(c, 3) + (size_t)l * DR; pa.a0 = inp(c, 5) + (size_t)l * DR; pa.k_k = inp(c, 8) + (size_t)l * DR;
            pa.k_a = inp(c, 9) + (size_t)l * DR; pa.r_k = inp(c, 10) + (size_t)l * DR; pa.w2t = WBF(WS_SMALL + wkv::SM_W2T); pa.a2t = WBF(WS_SMALL + wkv::SM_A2T); pa.g2t = WBF(WS_SMALL + wkv::SM_G2T);
            pa.Vo = WBF(WS_V); pa.Go = WBF(WS_GG); pa.RK = (float*)(w + wkv::WS_RK); pa.GST = WBF(wkv::WS_GST); pa.GYT = WBF(wkv::WS_GYT); pa.YLT = WF32(wkv::WS_YLT); pa.SLT = WF32(wkv::WS_SLT); pa.PEND = (float*)(w + wkv::WS_PEND);
            const int tid = otid(c.wv);
            for (int u = lnd((int)blockIdx.x); u < NB * RH * wkv::NCHK; u += lnd(G)) wkv::unit_pre(lds, pa, u, tid); }
          VBL(NB * MH * NBLK * HD / 256, 256) k_kmean(vb, vt, WBF(WS_PROJ), WF32(WS_SMALL + SM_KMEAN)); }
        __syncthreads();
        { unsigned char* w = wsl(c); const int tid = otid(c.wv), lane = tid & 63, wave = tid >> 6;
          for (int u = lnd((int)blockIdx.x) * 8 + wave; u < NB * NGR * s5::NCH; u += lnd(G) * 8)
              s5::part1(lds + wave * s5::WAVE_LDS, WBF(WS_PROJ), WF32(WS_SMALL + SM_LAM), WF32(WS_SMALL + SM_BB), (float*)(w + s5::WS_S5E), u, lane); }
        GB();
        { unsigned char* w = wsl(c); const int tid = otid(c.wv), lane = tid & 63, wave = tid >> 6;
          for (int su = lnd((int)blockIdx.x) * 8 + wave; su < NB * RH * 4; su += lnd(G) * 8)
              wkv::seq(WBF(wkv::WS_GST), WBF(wkv::WS_GYT), WF32(wkv::WS_YLT), WF32(wkv::WS_SLT), (const float*)(w + wkv::WS_PEND), WF32(WS_YRAW), su >> 2, su & 3, lane); }
        { unsigned char* w = wsl(c); const int tid = otid(c.wv), lane = tid & 63, wave = tid >> 6;
          for (int u = lnd((int)blockIdx.x) * 8 + wave; u < NB * NGR * s5::NCH; u += lnd(G) * 8)
              s5::part2(lds + wave * s5::WAVE_LDS, WBF(WS_PROJ), WF32(WS_SMALL + SM_LAM), WF32(WS_SMALL + SM_BB), (const float*)(w + s5::WS_S5E),
                        inp(c, 17) + (size_t)l * NGR * SGRP * SST, inp(c, 18) + (size_t)l * NGR * SGRP * SST, inp(c, 19) + (size_t)l * DSS, WBF(WS_YCPRE), u, lane); }
        __syncthreads();
        { unsigned char* w = wsl(c);
          att::phase(lds, WBF(WS_PROJ), WF32(WS_SMALL + SM_KMEAN), WBF(WS_YB), c.wv, lnd(G), lnd((int)blockIdx.x)); }
        GB();
        { unsigned char* w = wsl(c);
          VBL(T, 512) wkv::post(vb, vt, WF32(WS_YRAW), WBF(WS_V), WBF(WS_GG), (const float*)(w + wkv::WS_RK), inp(c, 11) + (size_t)l * DR, inp(c, 12) + (size_t)l * DR, WBF(WS_YA)); }
        { unsigned char* w = wsl(c);
          pg8::Gemm g{WBF(WS_YCPRE), WBF(WS_WT_GLU), T, 2 * DSS, DSS}; pg8::StaticOrder S; S.init(T, 2 * DSS, lnd(G), lnd((int)blockIdx.x));
          pg8::EpiGated<0> E{WBF(WS_YC), DSS, inp(c, 22) + (size_t)l * 2 * DSS, DSS, 3};
          pg8::gemm_phase<pg8::EpiGated<0>, pg8::StaticOrder, true, true>(lds, g, S, E, c.wv); }
        GB();
        for (int br = 0; br < 3; ++br) { unsigned char* w = wsl(c);
            pg8::Gemm g{WBF(WS_YA + (size_t)br * 16 * MiB), WBF(WS_WT_UPA + (size_t)br * MiB), T, D, DR}; pg8::StaticOrder S; S.init(T, D, lnd(G), lnd((int)blockIdx.x));
            pg8::EpiUp E{WBF(WS_PROJ) + OFF_GATE + br * D, NPROJ, inp(c, 26) + (size_t)l * 3 * D + br * D, WF32(WS_MERGED), WBF(WS_MERGEDB), D, br};
            pg8::gemm_phase<pg8::EpiUp, pg8::StaticOrder, true, true>(lds, g, S, E, c.wv);
        }
        GB();
        { unsigned char* w = wsl(c);
          pg8::Gemm g{WBF(WS_MERGEDB), WBF(WS_WT_OUT), T, D, D}; pg8::StaticOrder S; S.init(T, D, lnd(G), lnd((int)blockIdx.x));
          pg8::EpiOut E{c.X, WF32(WS_S), D, ALPHA};
          pg8::gemm_phase<pg8::EpiOut, pg8::StaticOrder, true, true>(lds, g, S, E, c.wv); }
        GB();
        { unsigned char* w = wsl(c); unsigned* cnt = (unsigned*)(w + WS_CTL) + CW_CNT + l * 64;
          VBL(T / 4, 256) k_ln1route(vb, vt, WF32(WS_S), inp(c, 28) + (size_t)l * D, inp(c, 29) + (size_t)l * D, c.X, WBF(WS_XN), WF32(WS_SMALL + SM_RTW), inp(c, 31) + (size_t)l * 4, inp(c, 33) + (size_t)l * 32, cnt,
                                     (int*)(w + WS_ROUTE + RT_EID), (int*)(w + WS_ROUTE + RT_POS), (float*)(w + WS_ROUTE + RT_WGT), (float*)lds_raw); }
        GB();
        { unsigned char* w = wsl(c); unsigned* cnt = (unsigned*)(w + WS_CTL) + CW_CNT + l * 64;
          VBL(T / 4, 256) k_gather(vb, vt, WBF(WS_XN), cnt, (int*)(w + WS_ROUTE + RT_EID), (int*)(w + WS_ROUTE + RT_POS), (int*)(w + WS_ROUTE + RT_SLOT), WBF(WS_XG));
          if (otid(c.wv) == 0) { int nt = 0;
#pragma unroll 1
              for (int e = 0; e < NE; ++e) { const int te = ((int)cnt[e] + 255) >> 8;
#pragma unroll 1
                  for (int q = 0; q < te; ++q) MISC[16 + nt + q] = (unsigned)e;
                  nt += te; }
              MISC[8] = (unsigned)nt; } }
        GB();
        { unsigned char* w = wsl(c); const int ntiles = (int)MISC[8];
          pg8::Gemm g{WBF(WS_XG), WBF(WS_WT_EGU), MAXSLOT, NE * 512, D}; pg8::GroupedOrder<2> S{(const LAS int*)(lds + MISC_OFF + 64), ntiles, lnd(G), lnd((int)blockIdx.x)};
          pg8::EpiGated<1> E{WBF(WS_HID), DE, nullptr, 0, 1};
          pg8::gemm_phase<pg8::EpiGated<1>, pg8::GroupedOrder<2>, true, true>(lds, g, S, E, c.wv); }
        GB();
        { unsigned char* w = wsl(c); const int ntiles = (int)MISC[8];
          pg8::Gemm g{WBF(WS_HID), WBF(WS_WT_ED), MAXSLOT, NE * D, DE}; pg8::GroupedOrder<4> S{(const LAS int*)(lds + MISC_OFF + 64), ntiles, lnd(G), lnd((int)blockIdx.x)};
          pg8::EpiBf16Grp E{WBF(WS_YG), D, 3};
          pg8::gemm_phase<pg8::EpiBf16Grp, pg8::GroupedOrder<4>, true, true>(lds, g, S, E, c.wv); }
        GB();
        { unsigned char* w = wsl(c);
          VBL(T / 4, 256) k_ln2(vb, vt, WBF(WS_YG), (int*)(w + WS_ROUTE + RT_SLOT), (float*)(w + WS_ROUTE + RT_WGT), inp(c, 37) + (size_t)l * D, inp(c, 38) + (size_t)l * D, c.X, WBF(WS_XN)); }
        if (l + 1 < DEPTH) phase_weights(c, l + 1);
        GB();
}

__global__ void __launch_bounds__(512, 2) mega(Args a) {
    extern __shared__ __attribute__((aligned(16))) unsigned char lds_raw[];
    LAS unsigned char* lds = (LAS unsigned char*)lds_raw;
    volatile LAS unsigned* MISC = (volatile LAS unsigned*)(lds + MISC_OFF);
    Ctx c; c.tab = (volatile LAS unsigned long long*)(lds + MISC_OFF + 1024); c.ws0 = a.ws; c.X = a.out; c.lds = lds;
    c.wv = __builtin_amdgcn_readfirstlane((int)threadIdx.x >> 6);
    if (threadIdx.x < 16) MISC[threadIdx.x] = 0u;
    if (threadIdx.x < 39) c.tab[threadIdx.x] = (unsigned long long)a.in[threadIdx.x];
    __syncthreads();
    XcdBarrier bar = xcd_barrier_post((unsigned*)(a.ws + WS_CTL) + CW_BAR, MISC, c.wv);
    const int G = (int)gridDim.x;
    { unsigned char* w = wsl(c); VBL(T * D / 256, 256) k_x0(vb, vt, inp(c, 0), c.X, WBF(WS_XN)); }
    phase_weights(c, 0);
    GB();
    layer_body<0>(c, bar, lds, lds_raw, MISC, G);
    layer_body<1>(c, bar, lds, lds_raw, MISC, G);
    layer_body<2>(c, bar, lds, lds_raw, MISC, G);
    layer_body<3>(c, bar, lds, lds_raw, MISC, G);
}

extern "C" void kernel_launch(void* const* d_in, const int* in_sizes, int n_in, void* d_out, int out_size, void* d_ws, size_t ws_size, hipStream_t stream) {
    static int grid = 0;
    if (grid == 0) {
        if (n_in != 39 || out_size != T * D || ws_size < WS_END) { fprintf(stderr, "kernel_launch: unexpected shapes n_in %d out %d ws %zu\n", n_in, out_size, ws_size); grid = -1; return; }
        int dev = 0, cus = 0, per_cu = 0;
        if (hipGetDevice(&dev) != hipSuccess || hipDeviceGetAttribute(&cus, hipDeviceAttributeMultiprocessorCount, dev) != hipSuccess) { grid = -1; return; }
        if (hipFuncSetAttribute((const void*)mega, hipFuncAttributeMaxDynamicSharedMemorySize, LDS_BYTES) != hipSuccess) { fprintf(stderr, "kernel_launch: hipFuncSetAttribute failed\n"); grid = -1; return; }
        if (hipOccupancyMaxActiveBlocksPerMultiprocessor(&per_cu, (const void*)mega, 512, LDS_BYTES) != hipSuccess || per_cu < 1) fprintf(stderr, "kernel_launch: occupancy query says %d\n", per_cu);
        (void)hipGetLastError();
        grid = cus;
        fprintf(stderr, "kernel_launch: grid %d, ws %zu\n", grid, ws_size);
    }
    if (grid < 0) return;
    (void)hipMemsetAsync((char*)d_ws + WS_CTL, 0, CTL_BYTES, stream);
    Args a{};
    for (int i = 0; i < 39; ++i) a.in[i] = (const float*)d_in[i];
    a.out = (float*)d_out; a.ws = (unsigned char*)d_ws;
    hipLaunchKernelGGL(mega, dim3(grid), dim3(512), LDS_BYTES, stream, a);
}
```

```cpp
#include <hip/hip_runtime.h>
#include <cstdio>
#include <cstdint>
#include <cmath>

typedef unsigned short bf16_t;
typedef short bf16x8 __attribute__((ext_vector_type(8)));
typedef float f32x4 __attribute__((ext_vector_type(4)));
typedef unsigned u32x4_t __attribute__((ext_vector_type(4)));
#define LDS_BARRIER() asm volatile("s_waitcnt lgkmcnt(0)\n\ts_barrier" ::: "memory")
typedef unsigned u32x2_t_ __attribute__((ext_vector_type(2)));

constexpr int NB = 4, SEQ = 4096, T = NB * SEQ, D = 1024, DEPTH = 4, HD = 64;
constexpr int DR = 512, RH = 8, DMO = 512, MH = 8, DSS = 512, SGRP = 16, NGR = 32, SST = 64;
constexpr int OFF_MOBA = 1792, OFF_SSM = 3328, OFF_GATE = 3840, NPROJ = 6912;
constexpr int MBLK = 256, NBLK = SEQ / MBLK;
constexpr int NE = 32, EPG = 8, NGRP = 4, DE = 256;
constexpr int MAXSLOT = 40960;
constexpr float LN_EPS = 1e-5f, GN_EPS = 64e-5f;
constexpr float ALPHA = 1.6817928305074290f;

constexpr size_t MiB = 1u << 20;
constexpr size_t WS_CTL = 0, CTL_BYTES = 1 * MiB;
constexpr size_t WS_SMALL = 1 * MiB;
constexpr size_t WS_WT_IN = 4 * MiB, WS_WT_GLU = 18 * MiB, WS_WT_UPA = 19 * MiB, WS_WT_UPB = 20 * MiB, WS_WT_UPC = 21 * MiB,
                 WS_WT_OUT = 22 * MiB, WS_WT_EGU = 24 * MiB, WS_WT_ED = 56 * MiB;
constexpr size_t WS_PROJ = 72 * MiB;
constexpr size_t WS_XN = 288 * MiB;
constexpr size_t WS_R = 320 * MiB, WS_KP = 336 * MiB, WS_V = 352 * MiB, WS_KK = 368 * MiB, WS_AA = 384 * MiB, WS_GG = 400 * MiB;
constexpr size_t WS_LW = 416 * MiB;
constexpr size_t WS_YRAW = 448 * MiB;
constexpr size_t WS_YA = 480 * MiB, WS_YB = 496 * MiB, WS_YC = 512 * MiB, WS_YCPRE = 528 * MiB;
constexpr size_t WS_ROUTE = 544 * MiB;
constexpr size_t WS_END = 548 * MiB;
constexpr size_t WS_MERGED = 320 * MiB;
constexpr size_t WS_MERGEDB = 384 * MiB;
constexpr size_t WS_S = 416 * MiB;
constexpr size_t WS_XG = 72 * MiB;
constexpr size_t WS_HID = 152 * MiB;
constexpr size_t WS_YG = 172 * MiB;
constexpr size_t SM_LAM = 0;
constexpr size_t SM_BB = 16384;
constexpr size_t SM_KMEAN = 16384 + 262144;
constexpr size_t SM_RTW = SM_KMEAN + 131072;
constexpr size_t SM_KNORM = SM_RTW + 196608, SM_BBF = SM_KNORM + 2048;
constexpr size_t RT_EID = 0, RT_POS = 131072, RT_SLOT = 262144, RT_WGT = 393216;
constexpr size_t RT_TOK = 524288;
constexpr size_t WS_TOKS = 72 * MiB;
constexpr int CW_AQ = 2048;
constexpr int CW_CNT = 16384;

__device__ __forceinline__ float bf2f(bf16_t h) { return __uint_as_float(((unsigned)h) << 16); }
__device__ __forceinline__ bf16_t f2bf(float f) { unsigned u = __float_as_uint(f); return (bf16_t)((u + 0x7fffu + ((u >> 16) & 1u)) >> 16); }
template <int CTRL, int RMASK> __device__ __forceinline__ float dpp_f(float oldv, float v) {
    return __builtin_bit_cast(float, __builtin_amdgcn_update_dpp(__builtin_bit_cast(int, oldv), __builtin_bit_cast(int, v), CTRL, RMASK, 0xF, false)); }
__device__ __forceinline__ float wave_allsum(float v) {
    v += dpp_f<0xB1, 0xF>(0.f, v);
    v += dpp_f<0x4E, 0xF>(0.f, v);
    v += dpp_f<0x141, 0xF>(0.f, v);
    v += dpp_f<0x140, 0xF>(0.f, v);
    v += dpp_f<0x142, 0xA>(0.f, v);
    v += dpp_f<0x143, 0xC>(0.f, v);
    return __builtin_bit_cast(float, __builtin_amdgcn_readlane(__builtin_bit_cast(int, v), 63));
}
__device__ __forceinline__ float wave_allmax(float v) {
    v = fmaxf(v, dpp_f<0xB1, 0xF>(v, v)); v = fmaxf(v, dpp_f<0x4E, 0xF>(v, v)); v = fmaxf(v, dpp_f<0x141, 0xF>(v, v)); v = fmaxf(v, dpp_f<0x140, 0xF>(v, v));
    v = fmaxf(v, dpp_f<0x142, 0xA>(v, v)); v = fmaxf(v, dpp_f<0x143, 0xC>(v, v));
    return __builtin_bit_cast(float, __builtin_amdgcn_readlane(__builtin_bit_cast(int, v), 63));
}
__device__ __forceinline__ float lane_bcast(float v, int l) { return __builtin_bit_cast(float, __builtin_amdgcn_readlane(__builtin_bit_cast(int, v), l)); }
__device__ __forceinline__ float sigmoidf_(float x) { return 1.f / (1.f + __expf(-x)); }
__device__ __forceinline__ float gelu_tanh(float x) { const float u = 0.7978845608028654f * (x + 0.044715f * x * x * x); return 0.5f * x * (1.f + tanhf(u)); }

__device__ __forceinline__ void k_cvt(int vb, int vt, const float* __restrict__ W, int ldw, int K, int Nsub, bf16_t* __restrict__ WT, int interleave, int row_off) {
    const long i = (long)vb * 256 + vt;
    if (i >= (long)K * Nsub) return;
    const int n = (int)(i / K), k = (int)(i % K);
    const int dr = interleave ? ((n >> 7) * 256 + (n & 127) + row_off) : (n + row_off);
    WT[(size_t)dr * K + k] = f2bf(W[(size_t)k * ldw + n]);
}
__device__ __forceinline__ void k_rtw(int vb, int vt, const float* __restrict__ gw, const float* __restrict__ ew, float* __restrict__ RTW) {
    const int i = vb * 256 + vt;
    if (i >= 8 * 32 * 3 * 64) return;
    const int lane = i & 63, r3 = i >> 6, ct = r3 % 3, rest = r3 / 3, ks = rest & 31, wv = rest >> 5;
    const int j = 16 * ct + (lane & 15), k = 128 * wv + 4 * ks + (lane >> 4);
    RTW[i] = j < 4 ? gw[k * 4 + j] : j < 36 ? ew[k * 32 + (j - 4)] : 0.f;
}
__device__ __forceinline__ void k_s5tab(int vb, int vt, const float* __restrict__ a_re, const float* __restrict__ a_im, const float* __restrict__ b_re, const float* __restrict__ b_im,
                        const float* __restrict__ log_dt, float* __restrict__ LAM, float* __restrict__ BB) {
    const int i = vb * 256 + vt;
    if (i >= NGR * SST) return;
    const int g = i / SST;
    const float dt = expf(log_dt[g]);
    const float are = a_re[i], aim = a_im[i];
    const float mag = expf(are * dt);
    const float ang = aim * dt;
    const float lre = mag * cosf(ang), lim = mag * sinf(ang);
    const float den = are * are + aim * aim, nr = lre - 1.0f;
    const float cre = (nr * are + lim * aim) / den, cim = (lim * are - nr * aim) / den;
    LAM[i * 2] = lre; LAM[i * 2 + 1] = lim;
    float vr[SGRP], vi[SGRP];
#pragma unroll
    for (int h = 0; h < SGRP; ++h) {
        const float bre = b_re[i * SGRP + h], bim = b_im[i * SGRP + h];
        vr[h] = cre * bre - cim * bim; vi[h] = cre * bim + cim * bre;
        BB[(i * SGRP + h) * 2] = vr[h];
        BB[(i * SGRP + h) * 2 + 1] = vi[h];
    }
    unsigned char* bbf = (unsigned char*)BB + (SM_BBF - SM_BB);
    const int p = i % SST;
#pragma unroll
    for (int im = 0; im < 2; ++im)
#pragma unroll
        for (int kq = 0; kq < 2; ++kq) { const int n = 2 * p + im, nt = n >> 4, fr = n & 15; const float* v = im ? vi : vr;
            typedef unsigned u4_ __attribute__((ext_vector_type(4)));
            auto pk = [](float lo, float hi) { typedef float f2 __attribute__((ext_vector_type(2))); typedef __bf16 b2 __attribute__((ext_vector_type(2))); f2 x = {lo, hi}; b2 y = __builtin_convertvector(x, b2); return __builtin_bit_cast(unsigned, y); };
            u4_ o = {pk(v[8 * kq], v[8 * kq + 1]), pk(v[8 * kq + 2], v[8 * kq + 3]), pk(v[8 * kq + 4], v[8 * kq + 5]), pk(v[8 * kq + 6], v[8 * kq + 7])};
            *(u4_*)(bbf + (size_t)(((g * 8 + nt) * 32 + fr + 16 * kq) * 16)) = o; }
}
__device__ __forceinline__ void k_x0(int vb, int vt, const float* __restrict__ x, float* __restrict__ X, bf16_t* __restrict__ XN) {
    const long i = (long)vb * 256 + vt;
    if (i >= (long)T * D) return;
    const float v = x[i]; (void)X; XN[i] = f2bf(v);
}

template <class Epi, bool PAIR>
__device__ __forceinline__ void k_gemm(int vbx, int vby, int vt, const bf16_t* __restrict__ A, const bf16_t* __restrict__ Bt, int K, Epi E) {
    const int wave = vt >> 6, lane = vt & 63, fr = lane & 15, fq = lane >> 4;
    const int rt = vby;
    if (!E.active(rt)) return;
    const bf16_t* B2 = Bt + E.bt_off(rt);
    const int row0 = rt * 64 + (wave >> 1) * 32;
    int colA, colB = 0, ch0 = 0;
    if (PAIR) { ch0 = vbx * 64 + (wave & 1) * 32; colA = (ch0 >> 7) * 256 + (ch0 & 127); colB = colA + 128; }
    else colA = vbx * 64 + (wave & 1) * 32;
    f32x4 acc[2][2], acc2[2][2];
#pragma unroll
    for (int i = 0; i < 2; ++i)
#pragma unroll
        for (int j = 0; j < 2; ++j) { acc[i][j] = (f32x4){0.f, 0.f, 0.f, 0.f}; acc2[i][j] = (f32x4){0.f, 0.f, 0.f, 0.f}; }
    for (int k0 = 0; k0 < K; k0 += 32) {
        bf16x8 a[2], b[2], b2[2];
#pragma unroll
        for (int i = 0; i < 2; ++i) a[i] = *(const bf16x8*)(A + (size_t)(row0 + i * 16 + fr) * K + k0 + fq * 8);
#pragma unroll
        for (int j = 0; j < 2; ++j) b[j] = *(const bf16x8*)(B2 + (size_t)(colA + j * 16 + fr) * K + k0 + fq * 8);
        if (PAIR) {
#pragma unroll
            for (int j = 0; j < 2; ++j) b2[j] = *(const bf16x8*)(B2 + (size_t)(colB + j * 16 + fr) * K + k0 + fq * 8);
        }
#pragma unroll
        for (int i = 0; i < 2; ++i)
#pragma unroll
            for (int j = 0; j < 2; ++j) {
                acc[i][j] = __builtin_amdgcn_mfma_f32_16x16x32_bf16(a[i], b[j], acc[i][j], 0, 0, 0);
                if (PAIR) acc2[i][j] = __builtin_amdgcn_mfma_f32_16x16x32_bf16(a[i], b2[j], acc2[i][j], 0, 0, 0);
            }
    }
#pragma unroll
    for (int i = 0; i < 2; ++i)
#pragma unroll
        for (int j = 0; j < 2; ++j)
#pragma unroll
            for (int r = 0; r < 4; ++r) {
                const int row = row0 + i * 16 + fq * 4 + r;
                if (PAIR) E.store2(row, ch0 + j * 16 + fr, acc[i][j][r], acc2[i][j][r]);
                else E.store(row, colA + j * 16 + fr, acc[i][j][r]);
            }
}
struct EDense { __device__ bool active(int) const { return true; } __device__ size_t bt_off(int) const { return 0; } };
struct EProj : EDense { bf16_t* P; __device__ void store(int r, int c, float v) const { P[(size_t)r * NPROJ + c] = f2bf(v); } __device__ void store2(int, int, float, float) const {} };
struct EGlu : EDense { bf16_t* YC; const float* bias;
    __device__ void store(int, int, float) const {}
    __device__ void store2(int r, int ch, float v, float g) const { YC[(size_t)r * DSS + ch] = f2bf((v + bias[ch]) * sigmoidf_(g + bias[DSS + ch])); } };
struct EUp : EDense { const bf16_t* P; const float* gate_b; float* M; bf16_t* MB; int br;
    __device__ void store2(int, int, float, float) const {}
    __device__ void store(int r, int c, float v) const {
        const float gl = bf2f(P[(size_t)r * NPROJ + OFF_GATE + br * D + c]) + gate_b[br * D + c];
        float m = sigmoidf_(gl) * v; const size_t o = (size_t)r * D + c;
        if (br > 0) m += M[o];
        M[o] = m; if (br == 2) MB[o] = f2bf(m); } };
struct EOut : EDense { const float* X; float* S;
    __device__ void store2(int, int, float, float) const {}
    __device__ void store(int r, int c, float v) const { const size_t o = (size_t)r * D + c; S[o] = ALPHA * X[o] + v; } };
struct EGrouped { const unsigned* cnt; int rows_per_e;
    __device__ int expert_of(int rt, bool& ok) const {
        int off = 0; const int r0 = rt * 64;
        for (int e = 0; e < NE; ++e) { const int p = ((int)cnt[e] + 255) & ~255; if (r0 < off + p) { ok = true; return e; } off += p; }
        ok = false; return 0; }
    __device__ bool active(int rt) const { bool ok; expert_of(rt, ok); return ok; }
};
struct ESwi : EGrouped { bf16_t* HID;
    __device__ size_t bt_off(int rt) const { bool ok; const int e = expert_of(rt, ok); return (size_t)e * 512 * D; }
    __device__ void store(int, int, float) const {}
    __device__ void store2(int r, int ch, float g, float u) const { HID[(size_t)r * DE + ch] = f2bf(g * sigmoidf_(g) * u); } };
struct EDown : EGrouped { bf16_t* YG;
    __device__ size_t bt_off(int rt) const { bool ok; const int e = expert_of(rt, ok); return (size_t)e * D * DE; }
    __device__ void store2(int, int, float, float) const {}
    __device__ void store(int r, int c, float v) const { YG[(size_t)r * D + c] = f2bf(v); } };

__device__ __forceinline__ void k_prep(int vb, int vt, const bf16_t* __restrict__ P, const float* __restrict__ mu, const float* __restrict__ w0, const float* __restrict__ w2,
        const float* __restrict__ a0, const float* __restrict__ a2, const float* __restrict__ g2, const float* __restrict__ k_k, const float* __restrict__ k_a,
        bf16_t* R, bf16_t* KP, bf16_t* V, bf16_t* KK, bf16_t* AA, bf16_t* GG, float* LW, float* act) {
    const int t = vb, c = vt;
    const bool first = (t % SEQ) == 0;
    const bf16_t* row = P + (size_t)t * NPROJ; const bf16_t* prow = row - NPROJ;
    auto zs = [&](int col) -> float { const float z = bf2f(row[col]); const float zp = first ? 0.f : bf2f(prow[col]); return z + (zp - z) * mu[col]; };
    if (c < 256) { const float z = zs(1536 + c); act[c] = c < 64 ? tanhf(z) : (c < 128 ? z : sigmoidf_(z)); }
    __syncthreads();
    const float r = zs(c), k = zs(512 + c), v = zs(1024 + c);
    float sw = 0.f, sa = 0.f, sg = 0.f;
#pragma unroll 4
    for (int i = 0; i < 64; ++i) { sw += act[i] * w2[i * DR + c]; sa += act[64 + i] * a2[i * DR + c]; }
#pragma unroll 4
    for (int i = 0; i < 128; ++i) sg += act[128 + i] * g2[i * DR + c];
    const float xx = -(w0[c] + sw);
    const float sp = fmaxf(xx, 0.f) + log1pf(expf(-fabsf(xx)));
    const float wl = -sp - 0.5f;
    const float lw = -expf(wl);
    const float a = sigmoidf_(a0[c] + sa);
    const float kk = k * k_k[c];
    const float ss = wave_allsum(kk * kk);
    const float kkn = kk * rsqrtf(fmaxf(ss, 1e-24f));
    const float kp = k * (1.f + (a - 1.f) * k_a[c]);
    const size_t o = (size_t)t * DR + c;
    R[o] = f2bf(r); KP[o] = f2bf(kp); V[o] = f2bf(v); KK[o] = f2bf(kkn); AA[o] = f2bf(a); GG[o] = f2bf(sg); LW[o] = lw;
    __syncthreads();
}
__device__ __forceinline__ void k_wkv(int vb, int vt, const bf16_t* __restrict__ R, const bf16_t* __restrict__ KP, const bf16_t* __restrict__ V, const bf16_t* __restrict__ KK,
        const bf16_t* __restrict__ AA, const float* __restrict__ LW, float* __restrict__ YRAW) {
    const int gwv = vb * 4 + (vt >> 6), j = vt & 63;
    const int i = gwv & 63, h = (gwv >> 6) & 7, b = gwv >> 9;
    float S = 0.f;
    for (int t = 0; t < SEQ; ++t) {
        const size_t o = (size_t)(b * SEQ + t) * DR + h * 64;
        const float r = bf2f(R[o + j]), w = __expf(LW[o + j]), k = bf2f(KP[o + j]), kk = bf2f(KK[o + j]), a = bf2f(AA[o + j]), v = bf2f(V[o + i]);
        const float sa = wave_allsum(S * (-kk));
        S = S * w + sa * (kk * a) + v * k;
        const float y = wave_allsum(S * r);
        if (j == 0) YRAW[o + i] = y;
    }
}
__device__ __forceinline__ void k_wkvpost(int vb, int vt, const float* __restrict__ YRAW, const bf16_t* __restrict__ R, const bf16_t* __restrict__ KP, const bf16_t* __restrict__ V,
        const bf16_t* __restrict__ GG, const float* __restrict__ r_k, const float* __restrict__ ln_w, const float* __restrict__ ln_b, bf16_t* __restrict__ YA) {
    const int t = vb, c = vt; const size_t o = (size_t)t * DR + c;
    const float y = YRAW[o];
    const float mean = wave_allsum(y) * (1.f / 64.f);
    const float dv = y - mean;
    const float var = wave_allsum(dv * dv) * (1.f / 64.f);
    const float yn = dv * rsqrtf(var + GN_EPS) * ln_w[c] + ln_b[c];
    const float bonus = wave_allsum(bf2f(R[o]) * bf2f(KP[o]) * r_k[c]) * bf2f(V[o]);
    YA[o] = f2bf((yn + bonus) * bf2f(GG[o]));
}
__device__ __forceinline__ void k_kmean(int vb, int vt, const bf16_t* __restrict__ P, float* __restrict__ KM) {
    const int i = vb * 256 + vt;
    if (i >= NB * MH * NBLK * HD) return;
    const int d = i & 63, n = (i >> 6) & 15, h = (i >> 10) & 7, b = i >> 13;
    float s = 0.f;
    for (int q = 0; q < MBLK; ++q) s += bf2f(P[(size_t)(b * SEQ + n * MBLK + q) * NPROJ + OFF_MOBA + 512 + h * 64 + d]);
    KM[i] = s * (1.f / MBLK);
}
__device__ __forceinline__ void k_moba(int vb, int vt, const bf16_t* __restrict__ P, const float* __restrict__ KM, bf16_t* __restrict__ YB) {
    const int gwv = vb * 4 + (vt >> 6), lane = vt & 63;
    const int h = gwv & 7, tt = gwv >> 3;
    const int b = tt / SEQ, tpos = tt % SEQ, blk = tpos / MBLK;
    const float slope = exp2f(-(float)(h + 1));
    const bf16_t* qrow = P + (size_t)tt * NPROJ + OFF_MOBA + h * 64;
    const float qd = bf2f(qrow[lane]) * 0.125f;
    float q[64];
#pragma unroll
    for (int d = 0; d < 64; ++d) q[d] = lane_bcast(qd, d);
    int sel[3] = {-1, -1, -1};
    {
        float gate[16];
#pragma unroll
        for (int n = 0; n < 16; ++n) { const float km = KM[((b * MH + h) * NBLK + n) * HD + lane]; gate[n] = wave_allsum(qd * km); }
#pragma unroll
        for (int s = 0; s < 3; ++s) {
            int best = -1; float bv = 0.f;
#pragma unroll
            for (int n = 0; n < 16; ++n) { const bool ok = n < blk && n != sel[0] && n != sel[1]; if (ok && (best < 0 || gate[n] > bv)) { best = n; bv = gate[n]; } }
            sel[s] = best;
        }
    }
    float m = -INFINITY, l = 0.f, o = 0.f;
    for (int s = 0; s < 4; ++s) {
        const int n = s < 3 ? sel[s] : blk;
        if (n < 0) continue;
        for (int c0 = 0; c0 < MBLK; c0 += 64) {
            const int sp = n * MBLK + c0 + lane;
            const bool valid = sp <= tpos;
            if (n * MBLK + c0 > tpos) break;
            const bf16_t* krow = P + (size_t)(b * SEQ + sp) * NPROJ + OFF_MOBA + 512 + h * 64;
            float sc = 0.f;
#pragma unroll
            for (int d8 = 0; d8 < 8; ++d8) { const bf16x8 kv = *(const bf16x8*)(krow + d8 * 8);
#pragma unroll
                for (int e = 0; e < 8; ++e) sc += q[d8 * 8 + e] * bf2f((bf16_t)kv[e]); }
            sc -= slope * (float)(tpos - sp);
            if (!valid) sc = -INFINITY;
            const float mx = wave_allmax(sc);
            const float mn = fmaxf(m, mx);
            const float scale = __expf(m - mn);
            const float p = valid ? __expf(sc - mn) : 0.f;
            l = l * scale + wave_allsum(p);
            o *= scale;
            const bf16_t* vbase = P + (size_t)(b * SEQ + n * MBLK + c0) * NPROJ + OFF_MOBA + 1024 + h * 64 + lane;
#pragma unroll
            for (int e = 0; e < 64; ++e) { const float pe = lane_bcast(p, e); o += pe * bf2f(vbase[(size_t)e * NPROJ]); }
            m = mn;
        }
    }
    YB[(size_t)tt * DMO + h * 64 + lane] = f2bf(o / l);
}
__device__ __forceinline__ void k_s5(int vb, int vt, const bf16_t* __restrict__ P, const float* __restrict__ LAM, const float* __restrict__ BB, const float* __restrict__ c_re,
        const float* __restrict__ c_im, const float* __restrict__ dvec, bf16_t* __restrict__ YCPRE) {
    const int b = vb / NGR, g = vb % NGR, p = vt;
    const float lre = LAM[(g * SST + p) * 2], lim = LAM[(g * SST + p) * 2 + 1];
    float bre[16], bim[16], cre[16], cim[16], dd[16];
#pragma unroll
    for (int h = 0; h < 16; ++h) { bre[h] = BB[((g * SST + p) * 16 + h) * 2]; bim[h] = BB[((g * SST + p) * 16 + h) * 2 + 1];
        cre[h] = c_re[(g * 16 + h) * SST + p]; cim[h] = c_im[(g * 16 + h) * SST + p]; dd[h] = dvec[g * 16 + h]; }
    float hre = 0.f, him = 0.f;
    for (int t = 0; t < SEQ; ++t) {
        const bf16_t* ur = P + (size_t)(b * SEQ + t) * NPROJ + OFF_SSM + g * 16;
        float u[16];
#pragma unroll
        for (int h = 0; h < 16; ++h) u[h] = bf2f(ur[h]);
        float bur = 0.f, bui = 0.f;
#pragma unroll
        for (int h = 0; h < 16; ++h) { bur += bre[h] * u[h]; bui += bim[h] * u[h]; }
        const float nre = lre * hre - lim * him + bur, nim = lre * him + lim * hre + bui;
        hre = nre; him = nim;
        float myy = 0.f;
#pragma unroll
        for (int h = 0; h < 16; ++h) { const float y = wave_allsum(cre[h] * hre - cim[h] * him) + dd[h] * u[h]; if (p == h) myy = y; }
        if (p < 16) YCPRE[(size_t)(b * SEQ + t) * DSS + g * 16 + p] = f2bf(gelu_tanh(myy));
    }
}
__device__ __forceinline__ void k_ln1route(int vb, int vt, const float* __restrict__ S, const float* __restrict__ lw, const float* __restrict__ lb, float* __restrict__ X, bf16_t* __restrict__ XN,
        const float* __restrict__ RTW, const float* __restrict__ gb, const float* __restrict__ eb, unsigned* __restrict__ cnt,
        int* __restrict__ EID, int* __restrict__ POS, float* __restrict__ WGT, float* rlog) {
    const int t = vb * 4 + (vt >> 6), lane = vt & 63;
    float v[16]; float s = 0.f;
#pragma unroll
    for (int i = 0; i < 16; ++i) { v[i] = S[(size_t)t * D + i * 64 + lane]; s += v[i]; }
    const float mean = wave_allsum(s) * (1.f / D);
    float q = 0.f;
#pragma unroll
    for (int i = 0; i < 16; ++i) { v[i] -= mean; q += v[i] * v[i]; }
    const float rstd = rsqrtf(wave_allsum(q) * (1.f / D) + LN_EPS);
#pragma unroll
    for (int i = 0; i < 16; ++i) { const int c = i * 64 + lane; v[i] = v[i] * rstd * lw[c] + lb[c]; X[(size_t)t * D + c] = v[i]; XN[(size_t)t * D + c] = f2bf(v[i]); }
    float* lg = rlog + ((vb & 1) * 4 + (vt >> 6)) * 40;
    for (int j = 0; j < 36; ++j) { float a = 0.f;
#pragma unroll
        for (int i = 0; i < 16; ++i) a += v[i] * RTW[j * 1024 + i * 64 + lane];
        a = wave_allsum(a); if (lane == 0) lg[j] = a; }
    if (lane == 0) {
        int gs = 0; float gm = lg[0] + gb[0];
        for (int j = 1; j < 4; ++j) { const float x = lg[j] + gb[j]; if (x > gm) { gm = x; gs = j; } }
        float den = 0.f;
        for (int j = 0; j < 4; ++j) den += __expf(lg[j] + gb[j] - gm);
        const float pg = 1.f / den;
        int i0 = 0; float m0 = lg[4 + gs * 8] + eb[gs * 8];
        for (int j = 1; j < 8; ++j) { const float x = lg[4 + gs * 8 + j] + eb[gs * 8 + j]; if (x > m0) { m0 = x; i0 = j; } }
        int i1 = -1; float m1 = 0.f;
        for (int j = 0; j < 8; ++j) { const float x = lg[4 + gs * 8 + j] + eb[gs * 8 + j]; if (j != i0 && (i1 < 0 || x > m1)) { m1 = x; i1 = j; } }
        const float e1 = __expf(m1 - m0);
        const float p0 = 1.f / (1.f + e1), p1 = e1 / (1.f + e1);
        const int ex0 = gs * 8 + i0, ex1 = gs * 8 + i1;
        EID[t * 2] = ex0; EID[t * 2 + 1] = ex1;
        WGT[t * 2] = pg * p0; WGT[t * 2 + 1] = pg * p1;
        POS[t * 2] = (int)atomicAdd(&cnt[ex0], 1u);
        POS[t * 2 + 1] = (int)atomicAdd(&cnt[ex1], 1u);
    }
}
__device__ __forceinline__ void k_gather(int vb, int vt, const bf16_t* __restrict__ XN, const unsigned* __restrict__ cnt, const int* __restrict__ EID, const int* __restrict__ POS,
        int* __restrict__ SLOT, bf16_t* __restrict__ XG) {
    const int t = vb * 4 + (vt >> 6), lane = vt & 63;
    for (int k = 0; k < 2; ++k) {
        const int e = EID[t * 2 + k]; int off = 0;
        for (int j = 0; j < e; ++j) off += ((int)cnt[j * 64] + 255) & ~255;
        const int slot = off + POS[t * 2 + k];
        if (lane == 0) SLOT[t * 2 + k] = slot;
        const uint4* src = (const uint4*)(XN + (size_t)t * D); uint4* dst = (uint4*)(XG + (size_t)slot * D);
        dst[lane] = src[lane]; dst[lane + 64] = src[lane + 64];
    }
}
__device__ __forceinline__ void k_ln2(int vb, int vt, const bf16_t* __restrict__ YG, const int* __restrict__ SLOT, const float* __restrict__ WGT, const float* __restrict__ lw, const float* __restrict__ lb,
        float* __restrict__ X, bf16_t* __restrict__ XN) {
    const int t = vb * 4 + (vt >> 6), lane = vt & 63;
    const int s0 = SLOT[t * 2], s1 = SLOT[t * 2 + 1]; const float w0 = WGT[t * 2], w1 = WGT[t * 2 + 1];
    float v[16]; float s = 0.f;
#pragma unroll
    for (int i = 0; i < 16; ++i) { const int c = i * 64 + lane;
        const float y = bf2f(YG[(size_t)s0 * D + c]) * w0 + bf2f(YG[(size_t)s1 * D + c]) * w1;
        v[i] = ALPHA * X[(size_t)t * D + c] + y; s += v[i]; }
    const float mean = wave_allsum(s) * (1.f / D);
    float q = 0.f;
#pragma unroll
    for (int i = 0; i < 16; ++i) { v[i] -= mean; q += v[i] * v[i]; }
    const float rstd = rsqrtf(wave_allsum(q) * (1.f / D) + LN_EPS);
#pragma unroll
    for (int i = 0; i < 16; ++i) { const int c = i * 64 + lane; const float o = v[i] * rstd * lw[c] + lb[c]; X[(size_t)t * D + c] = o; XN[(size_t)t * D + c] = f2bf(o); }
}

namespace pg8 {
#define PG8_LAS __attribute__((address_space(3)))
typedef unsigned short bf16_t;
typedef short bf16x8 __attribute__((ext_vector_type(8)));
typedef float f32x4 __attribute__((ext_vector_type(4)));
typedef unsigned u32x4 __attribute__((ext_vector_type(4)));
constexpr int BM = 256, BK = 64, HALF = 128, HTB = HALF * BK * 2  , STAGE_BYTES = 8 * HTB, NXCD = 8, WGM = 8;

__host__ __device__ __forceinline__ int lds_byte(int r, int c) { const int st = (r >> 4) * 2 + (c >> 5), rr = r & 15, cc = c & 31, ob = rr * 64 + cc * 2; return st * 1024 + (ob ^ (((ob >> 9) & 1) << 5)); }
__host__ __device__ __forceinline__ void stage_rc(int b, int& R, int& C) { const int st = b / 1024, sb = b % 1024, swz = sb ^ (((sb >> 9) & 1) << 5); R = (st >> 1) * 16 + swz / 64; C = (st & 1) * 32 + (swz % 64) / 2; }
__host__ __device__ __forceinline__ int perm32(int rho) { const int n = rho >> 4, i = rho & 15; return 8 * (i >> 2) + 4 * n + (i & 3); }

struct Unit { int pm, pn; };
struct Gemm { const bf16_t* A; const bf16_t* Bt; int M, N, K; };

struct StaticOrder {
    static constexpr bool GATHER = false;
    __device__ __forceinline__ int row(int) const { return 0; }
    int nM, nN, nwg, G, c;
    __host__ __device__ void init(int M, int N, int G_, int c_) { nM = M / BM; nN = N / BM; nwg = nM * nN; G = G_; c = c_; }
    __host__ __device__ bool next(int i, Unit& u) const {
        const long L = (long)i * G + c; if (L >= nwg) return false;
        int wgid = (int)L; { const int q = nwg / NXCD, r = nwg % NXCD, xcd = wgid % NXCD, off = wgid / NXCD; wgid = (xcd < r ? xcd * (q + 1) : r * (q + 1) + (xcd - r) * q) + off; }
        const int nig = WGM * nN, gid = wgid / nig, fm = gid * WGM, gsz = (nM - fm) < WGM ? (nM - fm) : WGM;
        u.pm = fm + ((wgid % nig) % gsz); u.pn = (wgid % nig) / gsz; return true;
    }
    __device__ __forceinline__ void a_ready(const Unit&) const {}
    __device__ __forceinline__ void done(const Unit&) const {}
};

__device__ __forceinline__ unsigned cvt_pk_bf16(float lo, float hi) { unsigned r; asm volatile("v_cvt_pk_bf16_f32 %0, %1, %2" : "=v"(r) : "v"(lo), "v"(hi)); return r; }
typedef float f32x2 __attribute__((ext_vector_type(2)));
__device__ __forceinline__ f32x2 gelu_pk(f32x2 v) {
    const f32x2 av = __builtin_elementwise_abs(v), d = av * 0.2316418882f + 1.0f;
    f32x2 t; t.x = __builtin_amdgcn_rcpf(d.x); t.y = __builtin_amdgcn_rcpf(d.y);
    f32x2 q = t * 0.5307027145f + (-0.7265760135f); q = q * t + 0.7107068705f; q = q * t + (-0.142248368f); q = q * t + 0.127414796f; q = q * t;
    const f32x2 s = (v * v) * (-0.72134752044f);
    f32x2 e; e.x = __builtin_amdgcn_exp2f(s.x); e.y = __builtin_amdgcn_exp2f(s.y);
    const f32x2 m = v * (q * e), r = v - m;
    f32x2 o; o.x = v.x < 0.f ? m.x : r.x; o.y = v.y < 0.f ? m.y : r.y; return o;
}

template <int ACT  > struct EpiBf16 {
    static constexpr bool PERM = true, AFTER_DRAIN = false, CHAIN = false; static_assert(ACT == 0 || ACT == 1, "EpiBf16: ACT is 0 (none) or 1 (gelu_pk)");
    bf16_t* O; int ldc; const float* bias; int split_cols; size_t split_stride; float scale0;
    __device__ __forceinline__ void operator()(const f32x4 (&acc)[2][2][4][2], const Unit& u, int wr, int wc, int fr, int fq) const {
        const int row0 = u.pm * BM + wr * 64 + fr; int colt = u.pn * BM; bf16_t* base = O;
        float sc = 1.f; if (split_cols) { const int t = colt / split_cols; base += (size_t)t * split_stride; colt -= t * split_cols; if (t == 0) sc = scale0; }
        const int col0 = colt + wc * 32 + 8 * fq, bcol0 = u.pn * BM + wc * 32 + 8 * fq;
        f32x4 bv[2][2];
#pragma unroll
        for (int bj = 0; bj < 2; ++bj)
#pragma unroll
            for (int n = 0; n < 2; ++n) bv[bj][n] = bias ? *(const f32x4*)(bias + bcol0 + bj * HALF + 4 * n) : (f32x4){0.f, 0.f, 0.f, 0.f};
#pragma unroll
        for (int ai = 0; ai < 2; ++ai)
#pragma unroll
            for (int m = 0; m < 4; ++m) { bf16_t* rowp = base + (size_t)(row0 + ai * HALF + m * 16) * ldc + col0;
#pragma unroll
                for (int bj = 0; bj < 2; ++bj) { f32x4 v0 = acc[ai][bj][m][0] + bv[bj][0], v1 = acc[ai][bj][m][1] + bv[bj][1];
                    if (ACT == 1) { f32x2 a = gelu_pk((f32x2){v0[0], v0[1]}), b = gelu_pk((f32x2){v0[2], v0[3]}), c = gelu_pk((f32x2){v1[0], v1[1]}), d = gelu_pk((f32x2){v1[2], v1[3]});
                        v0 = (f32x4){a.x, a.y, b.x, b.y}; v1 = (f32x4){c.x, c.y, d.x, d.y}; }
                    v0 = v0 * sc; v1 = v1 * sc; u32x4 w; w.x = cvt_pk_bf16(v0[0], v0[1]); w.y = cvt_pk_bf16(v0[2], v0[3]); w.z = cvt_pk_bf16(v1[0], v1[1]); w.w = cvt_pk_bf16(v1[2], v1[3]);
                    *(u32x4*)(rowp + bj * HALF) = w; } }
    }
};

typedef unsigned u32x2 __attribute__((ext_vector_type(2)));
__device__ __forceinline__ float sigm(float x) { return __builtin_amdgcn_rcpf(1.f + __expf(-x)); }
__device__ __forceinline__ float bflo(unsigned w) { return __uint_as_float(w << 16); }
__device__ __forceinline__ float bfhi(unsigned w) { return __uint_as_float(w & 0xffff0000u); }
template <int MODE> struct EpiGated {
    static constexpr bool PERM = true, AFTER_DRAIN = false, CHAIN = false;
    bf16_t* O; int ldc; const float* bias; int bias1_off; int pn_mask;
    __device__ __forceinline__ void operator()(const f32x4 (&acc)[2][2][4][2], const Unit& u, int wr, int wc, int fr, int fq) const {
        const int row0 = u.pm * BM + wr * 64 + fr, ch0 = (u.pn & pn_mask) * 128 + wc * 32 + 8 * fq;
        f32x4 b0[2], b1[2];
#pragma unroll
        for (int n = 0; n < 2; ++n) { if (MODE == 0) { b0[n] = *(const f32x4*)(bias + ch0 + 4 * n); b1[n] = *(const f32x4*)(bias + bias1_off + ch0 + 4 * n); } else { b0[n] = (f32x4){0.f, 0.f, 0.f, 0.f}; b1[n] = b0[n]; } }
#pragma unroll
        for (int ai = 0; ai < 2; ++ai)
#pragma unroll
            for (int m = 0; m < 4; ++m) { bf16_t* rowp = O + (size_t)(row0 + ai * HALF + m * 16) * ldc + ch0; float r[8];
#pragma unroll
                for (int n = 0; n < 2; ++n) { const f32x4 a0 = acc[ai][0][m][n] + b0[n], a1 = acc[ai][1][m][n] + b1[n];
#pragma unroll
                    for (int j = 0; j < 4; ++j) r[4 * n + j] = MODE == 0 ? a0[j] * sigm(a1[j]) : a0[j] * sigm(a0[j]) * a1[j]; }
                u32x4 w; w.x = cvt_pk_bf16(r[0], r[1]); w.y = cvt_pk_bf16(r[2], r[3]); w.z = cvt_pk_bf16(r[4], r[5]); w.w = cvt_pk_bf16(r[6], r[7]);
                *(u32x4*)rowp = w; }
    }
};
struct EpiProj {
    static constexpr bool PERM = true, AFTER_DRAIN = false, CHAIN = false;
    bf16_t* O; int ldc; const float* gate_b; int gate_tile0;
    __device__ __forceinline__ void operator()(const f32x4 (&acc)[2][2][4][2], const Unit& u, int wr, int wc, int fr, int fq) const {
        const int row0 = u.pm * BM + wr * 64 + fr, col0 = u.pn * BM + wc * 32 + 8 * fq; const bool gate = u.pn >= gate_tile0;
        f32x4 bv[2][2];
#pragma unroll
        for (int bj = 0; bj < 2; ++bj)
#pragma unroll
            for (int n = 0; n < 2; ++n) bv[bj][n] = gate ? *(const f32x4*)(gate_b + (col0 - gate_tile0 * BM) + bj * HALF + 4 * n) : (f32x4){0.f, 0.f, 0.f, 0.f};
#pragma unroll
        for (int ai = 0; ai < 2; ++ai)
#pragma unroll
            for (int m = 0; m < 4; ++m) { bf16_t* rowp = O + (size_t)(row0 + ai * HALF + m * 16) * ldc + col0;
#pragma unroll
                for (int bj = 0; bj < 2; ++bj) { f32x4 v0 = acc[ai][bj][m][0], v1 = acc[ai][bj][m][1];
                    if (gate) { v0 += bv[bj][0]; v1 += bv[bj][1];
#pragma unroll
                        for (int j = 0; j < 4; ++j) { v0[j] = sigm(v0[j]); v1[j] = sigm(v1[j]); } }
                    u32x4 w; w.x = cvt_pk_bf16(v0[0], v0[1]); w.y = cvt_pk_bf16(v0[2], v0[3]); w.z = cvt_pk_bf16(v1[0], v1[1]); w.w = cvt_pk_bf16(v1[2], v1[3]);
                    *(u32x4*)(rowp + bj * HALF) = w; } }
    }
};
struct EpiUp {
    static constexpr bool PERM = true, AFTER_DRAIN = false, CHAIN = true;
    const bf16_t* P; int ldp; bf16_t* MB; int ldc;
    __device__ __forceinline__ bool chain(const Unit& u) const { return (u.pm >> 6) < 2; }
    __device__ __forceinline__ static float cg(float g) { return fmaxf(g, 1e-20f); }
    __device__ __forceinline__ void rescale(f32x4 (&acc)[2][2][4][2], const Unit& u, int wr, int wc, int fr, int fq) const {
        const int br = u.pm >> 6, pm = u.pm & 63, pn = u.pn & 3;
        const int row0 = pm * BM + wr * 64 + fr, col0 = pn * BM + wc * 32 + 8 * fq;
        const bf16_t* Pg = P + br * 1024;
#pragma unroll
        for (int ai = 0; ai < 2; ++ai)
#pragma unroll
            for (int m = 0; m < 4; ++m) { const size_t row = (size_t)(row0 + ai * HALF + m * 16);
#pragma unroll
                for (int bj = 0; bj < 2; ++bj) { const int c = col0 + bj * HALF;
                    const u32x4 ga = *(const u32x4*)(Pg + row * ldp + c), gb = *(const u32x4*)(Pg + 1024 + row * ldp + c);
                    f32x4& a0 = acc[ai][bj][m][0]; f32x4& a1 = acc[ai][bj][m][1];
                    a0[0] *= cg(bflo(ga.x)) * __builtin_amdgcn_rcpf(cg(bflo(gb.x))); a0[1] *= cg(bfhi(ga.x)) * __builtin_amdgcn_rcpf(cg(bfhi(gb.x)));
                    a0[2] *= cg(bflo(ga.y)) * __builtin_amdgcn_rcpf(cg(bflo(gb.y))); a0[3] *= cg(bfhi(ga.y)) * __builtin_amdgcn_rcpf(cg(bfhi(gb.y)));
                    a1[0] *= cg(bflo(ga.z)) * __builtin_amdgcn_rcpf(cg(bflo(gb.z))); a1[1] *= cg(bfhi(ga.z)) * __builtin_amdgcn_rcpf(cg(bfhi(gb.z)));
                    a1[2] *= cg(bflo(ga.w)) * __builtin_amdgcn_rcpf(cg(bflo(gb.w))); a1[3] *= cg(bfhi(ga.w)) * __builtin_amdgcn_rcpf(cg(bfhi(gb.w))); } }
    }
    __device__ __forceinline__ void operator()(const f32x4 (&acc)[2][2][4][2], const Unit& u, int wr, int wc, int fr, int fq) const {
        const int pm = u.pm & 63, pn = u.pn & 3;
        const int row0 = pm * BM + wr * 64 + fr, col0 = pn * BM + wc * 32 + 8 * fq;
        const bf16_t* Pg = P + 2 * 1024;
#pragma unroll
        for (int ai = 0; ai < 2; ++ai)
#pragma unroll
            for (int m = 0; m < 4; ++m) { const size_t row = (size_t)(row0 + ai * HALF + m * 16);
#pragma unroll
                for (int bj = 0; bj < 2; ++bj) { const int c = col0 + bj * HALF;
                    const u32x4 gl = *(const u32x4*)(Pg + row * ldp + c);
                    const f32x4 a0 = acc[ai][bj][m][0], a1 = acc[ai][bj][m][1];
                    u32x4 w; w.x = cvt_pk_bf16(cg(bflo(gl.x)) * a0[0], cg(bfhi(gl.x)) * a0[1]); w.y = cvt_pk_bf16(cg(bflo(gl.y)) * a0[2], cg(bfhi(gl.y)) * a0[3]);
                    w.z = cvt_pk_bf16(cg(bflo(gl.z)) * a1[0], cg(bfhi(gl.z)) * a1[1]); w.w = cvt_pk_bf16(cg(bflo(gl.w)) * a1[2], cg(bfhi(gl.w)) * a1[3]);
                    *(u32x4*)(MB + row * ldc + c) = w; } }
    }
};
struct TripleOrder {
    static constexpr bool GATHER = false;
    __device__ __forceinline__ int row(int) const { return 0; }
    StaticOrder base;
    __device__ __forceinline__ bool next(int i, Unit& u) const { const int j = i / 3, br = i - 3 * j; if (!base.next(j, u)) return false; u.pm += 64 * br; u.pn += 4 * br; return true; }
    __device__ __forceinline__ void a_ready(const Unit&) const {}
    __device__ __forceinline__ void done(const Unit&) const {}
};
struct EpiOut {
    static constexpr bool PERM = false, AFTER_DRAIN = false, CHAIN = false;
    const bf16_t* XNb; float* S; int ldc; float alpha;
    __device__ __forceinline__ void operator()(const f32x4 (&acc)[2][2][4][2], const Unit& u, int wr, int wc, int fr, int fq) const {
        const int row0 = u.pm * BM + wr * 64 + fr, col0 = u.pn * BM + wc * 32 + 4 * fq;
#pragma unroll
        for (int ai = 0; ai < 2; ++ai)
#pragma unroll
            for (int m = 0; m < 4; ++m) { const size_t off = (size_t)(row0 + ai * HALF + m * 16) * ldc + col0;
#pragma unroll
                for (int bj = 0; bj < 2; ++bj)
#pragma unroll
                    for (int n = 0; n < 2; ++n) { const u32x2 xb = *(const u32x2*)(XNb + off + bj * HALF + n * 16); const f32x4 x = {bflo(xb.x), bfhi(xb.x), bflo(xb.y), bfhi(xb.y)};
                        *(f32x4*)(S + off + bj * HALF + n * 16) = x * alpha + acc[ai][bj][m][n]; } }
    }
};
struct EpiBf16Grp {
    static constexpr bool PERM = true, AFTER_DRAIN = false, CHAIN = false;
    bf16_t* O; int ldc; int pn_mask;
    __device__ __forceinline__ void operator()(const f32x4 (&acc)[2][2][4][2], const Unit& u, int wr, int wc, int fr, int fq) const {
        const int row0 = u.pm * BM + wr * 64 + fr, col0 = (u.pn & pn_mask) * BM + wc * 32 + 8 * fq;
#pragma unroll
        for (int ai = 0; ai < 2; ++ai)
#pragma unroll
            for (int m = 0; m < 4; ++m) { bf16_t* rowp = O + (size_t)(row0 + ai * HALF + m * 16) * ldc + col0;
#pragma unroll
                for (int bj = 0; bj < 2; ++bj) { const f32x4 v0 = acc[ai][bj][m][0], v1 = acc[ai][bj][m][1];
                    u32x4 w; w.x = cvt_pk_bf16(v0[0], v0[1]); w.y = cvt_pk_bf16(v0[2], v0[3]); w.z = cvt_pk_bf16(v1[0], v1[1]); w.w = cvt_pk_bf16(v1[2], v1[3]);
                    *(u32x4*)(rowp + bj * HALF) = w; } }
    }
};
template <int NCOL> struct GroupedOrder {
    static constexpr bool GATHER = false;
    __device__ __forceinline__ int row(int) const { return 0; }
    const PG8_LAS int* tile_e; int ntiles, G, c;
    __device__ __forceinline__ bool next(int i, Unit& u) const {
        const int L = i * G + c; if (L >= ntiles * NCOL) return false;
        const int tile = L / NCOL, j = L % NCOL; u.pm = tile; u.pn = __builtin_amdgcn_readfirstlane(tile_e[tile]) * NCOL + j; return true; }
    __device__ __forceinline__ void a_ready(const Unit&) const {}
    __device__ __forceinline__ void done(const Unit&) const {}
};
template <int NCOL> struct GatherOrder {
    static constexpr bool GATHER = true;
    const PG8_LAS int* tile_e; const PG8_LAS int* tile_base; const unsigned* tok; int ntiles, G, c, nrows;
    __device__ __forceinline__ int row(int slot) const { const unsigned t = tok[tile_base[slot >> 8] + (slot & 255)]; return (int)(t < (unsigned)nrows ? t : (unsigned)(nrows - 1)); }
    __device__ __forceinline__ bool next(int i, Unit& u) const {
        const int L = i * G + c; if (L >= ntiles * NCOL) return false;
        const int tile = L / NCOL, j = L % NCOL; u.pm = tile; u.pn = __builtin_amdgcn_readfirstlane(tile_e[tile]) * NCOL + j; return true; }
    __device__ __forceinline__ void a_ready(const Unit&) const {}
    __device__ __forceinline__ void done(const Unit&) const {}
};
template <class Epi, class Sched, bool ALIGN_EPI = false, bool SP2 = false>
__device__ __forceinline__ void gemm_phase(PG8_LAS unsigned char* lds, const Gemm g, const Sched& S, const Epi& E, int wv_) {
    int tid_; asm volatile("v_mbcnt_lo_u32_b32 %0, -1, 0\n\tv_mbcnt_hi_u32_b32 %0, -1, %0\n\tv_lshl_add_u32 %0, %1, 6, %0" : "=&v"(tid_) : "s"(wv_));
    const int tid = tid_, wid = __builtin_amdgcn_readfirstlane(tid >> 6), lane = tid & 63, wr = wid >> 2, wc = wid & 3, fr = lane & 15, fq = lane >> 4;
    const int K = g.K, nt = K / BK;
    unsigned voffA[2], voffB[2];
#pragma unroll
    for (int i = 0; i < 2; ++i) { int R, C; stage_rc(tid * 16 + i * 8192, R, C); const int Rb = Epi::PERM ? ((R & ~31) + perm32(R & 31)) : R;
        voffA[i] = (unsigned)(R * K + C) * 2u; voffB[i] = (unsigned)(Rb * K + C) * 2u; }
    const size_t kstep = (size_t)(BK * 2);
    const size_t hstep = (size_t)HALF * K * 2;
    const size_t tstep = 2 * hstep;
    const size_t tstepA = Sched::GATHER ? 0 : tstep, hstepA = Sched::GATHER ? 0 : hstep;
    unsigned vAc[2][2], vAn[2][2];
    auto gather_rows = [&](const Unit& u, unsigned (&v)[2][2]) {
#pragma unroll
        for (int h = 0; h < 2; ++h)
#pragma unroll
            for (int i = 0; i < 2; ++i) { int R, C; stage_rc(tid * 16 + i * 8192, R, C); v[h][i] = (unsigned)S.row(u.pm * BM + h * HALF + R) * (unsigned)(K * 2) + (unsigned)(C * 2); } };
    const unsigned ldsw = (unsigned)wid * 1024u;
    const int aoff = lds_byte(wr * 64 + fr, fq * 8), boff = lds_byte(wc * 32 + fr, fq * 8);
#define PG8_SA(b, h) (((b) * 2 + (h)) * HTB)
#define PG8_SB(b, h) ((4 + (b) * 2 + (h)) * HTB)
#define PG8_STAGE(bufoff, gbase, voff) do { _Pragma("unroll") for (int _i = 0; _i < 2; ++_i) \
        __builtin_amdgcn_global_load_lds((const unsigned*)((const char*)(gbase) + (voff)[_i]), (PG8_LAS unsigned*)(lds + (bufoff) + ldsw + _i * 8192), 16, 0, 0); } while (0)
#define PG8_STAGE_A(bufoff, kbase, h, usenext) do { if constexpr (Sched::GATHER) { unsigned vo_[2] = {(usenext) ? vAn[h][0] : vAc[h][0], (usenext) ? vAn[h][1] : vAc[h][1]}; PG8_STAGE(bufoff, kbase, vo_); } \
        else { PG8_STAGE(bufoff, (kbase) + ((h) ? hstepA : 0), voffA); } } while (0)
#define PG8_LDA(dst, b, h) do { _Pragma("unroll") for (int m = 0; m < 4; ++m) _Pragma("unroll") for (int k = 0; k < 2; ++k) dst[m][k] = *(const PG8_LAS bf16x8*)(lds + PG8_SA(b, h) + aoff + m * 2048 + k * 1024); } while (0)
#define PG8_LDB(dst, b, h) do { _Pragma("unroll") for (int n = 0; n < 2; ++n) _Pragma("unroll") for (int k = 0; k < 2; ++k) dst[n][k] = *(const PG8_LAS bf16x8*)(lds + PG8_SB(b, h) + boff + n * 2048 + k * 1024); } while (0)
#define PG8_MMA(ai, bj, At, Bt) do { __builtin_amdgcn_s_setprio(1); _Pragma("unroll") for (int m = 0; m < 4; ++m) _Pragma("unroll") for (int n = 0; n < 2; ++n) _Pragma("unroll") for (int k = 0; k < 2; ++k) \
        acc[ai][bj][m][n] = __builtin_amdgcn_mfma_f32_16x16x32_bf16(Bt[n][k], At[m][k], acc[ai][bj][m][n], 0, 0, 0); __builtin_amdgcn_s_setprio(0); } while (0)
#define PG8_WAIT_V(n) asm volatile("s_waitcnt vmcnt(" #n ")" ::: "memory")
#define PG8_WAIT_L(n) asm volatile("s_waitcnt lgkmcnt(" #n ")" ::: "memory")
#define PG8_BAR __builtin_amdgcn_s_barrier()
#define PG8_SCHED __builtin_amdgcn_sched_barrier(0)
    Unit cur, nxt; int ui = 0;
    if (!S.next(0, cur)) return;
    f32x4 acc[2][2][4][2];
#pragma unroll
    for (int a = 0; a < 2; ++a)
#pragma unroll
        for (int b = 0; b < 2; ++b)
#pragma unroll
            for (int m = 0; m < 4; ++m)
#pragma unroll
                for (int n = 0; n < 2; ++n) acc[a][b][m][n] = (f32x4){0.f, 0.f, 0.f, 0.f};
    bf16x8 At[4][2], B0[2][2], B1[2][2];
    const char* cA = (const char*)g.A + (size_t)cur.pm * tstepA; const char* cB = (const char*)g.Bt + (size_t)cur.pn * tstep;
    S.a_ready(cur);
    if constexpr (Sched::GATHER) gather_rows(cur, vAc);
    if constexpr (SP2) {
        PG8_STAGE(PG8_SB(0, 0), cB, voffB); PG8_STAGE(PG8_SB(0, 1), cB + hstep, voffB); PG8_STAGE_A(PG8_SA(0, 0), cA, 0, false); PG8_STAGE_A(PG8_SA(0, 1), cA, 1, false);
        if (wr == 1) PG8_BAR;
        PG8_WAIT_V(2); PG8_BAR;
        PG8_STAGE(PG8_SB(1, 0), cB + kstep, voffB); PG8_STAGE_A(PG8_SA(1, 0), cA + kstep, 0, false); PG8_STAGE(PG8_SB(1, 1), cB + hstep + kstep, voffB);
        PG8_WAIT_V(6); PG8_BAR;
    } else {
        PG8_STAGE(PG8_SB(0, 0), cB, voffB); PG8_STAGE_A(PG8_SA(0, 0), cA, 0, false); PG8_STAGE(PG8_SB(0, 1), cB + hstep, voffB); PG8_STAGE_A(PG8_SA(0, 1), cA, 1, false);
        if (wr == 1) PG8_BAR;
        PG8_WAIT_V(4); PG8_BAR;
        PG8_STAGE(PG8_SB(1, 0), cB + kstep, voffB); PG8_STAGE_A(PG8_SA(1, 0), cA + kstep, 0, false); PG8_STAGE(PG8_SB(1, 1), cB + hstep + kstep, voffB);
        PG8_WAIT_V(6); PG8_BAR;
    }
    for (;;) {
        const bool has_next = S.next(ui + 1, nxt);
        const char* nA = has_next ? (const char*)g.A + (size_t)nxt.pm * tstepA : cA;
        if constexpr (Sched::GATHER) { if (has_next) gather_rows(nxt, vAn); else { vAn[0][0] = vAc[0][0]; vAn[0][1] = vAc[0][1]; vAn[1][0] = vAc[1][0]; vAn[1][1] = vAc[1][1]; } } const char* nB = has_next ? (const char*)g.Bt + (size_t)nxt.pn * tstep : cB;
#pragma nounroll
        for (int t = 0; t < nt; t += 2) {
            const bool last = (t == nt - 2);
            const char* a1 = cA + (size_t)(t + 1) * kstep;
            const char* a2 = last ? nA : cA + (size_t)(t + 2) * kstep; const char* b2 = last ? nB : cB + (size_t)(t + 2) * kstep;
            const char* a3 = a2 + kstep; const char* b3 = b2 + kstep;
            if (last && has_next) S.a_ready(nxt);
            if constexpr (SP2) {
            PG8_LDB(B0, 0, 0); PG8_LDB(B1, 0, 1); PG8_SCHED; PG8_LDA(At, 0, 0); PG8_STAGE_A(PG8_SA(1, 1), a1, 1, false);
            PG8_WAIT_V(8); PG8_WAIT_L(0); PG8_BAR; PG8_MMA(0, 0, At, B0); PG8_MMA(0, 1, At, B1); PG8_BAR; PG8_SCHED;
            PG8_LDA(At, 0, 1); PG8_STAGE(PG8_SB(0, 0), b2, voffB); PG8_STAGE(PG8_SB(0, 1), b2 + hstep, voffB); PG8_STAGE_A(PG8_SA(0, 0), a2, 0, last);
            PG8_WAIT_V(8); PG8_WAIT_L(0); PG8_BAR; PG8_MMA(1, 0, At, B0); PG8_MMA(1, 1, At, B1); PG8_BAR; PG8_SCHED;
            PG8_LDB(B0, 1, 0); PG8_LDB(B1, 1, 1); PG8_SCHED; PG8_LDA(At, 1, 0); PG8_STAGE_A(PG8_SA(0, 1), a2, 1, last);
            PG8_WAIT_V(8); PG8_WAIT_L(0); PG8_BAR; PG8_MMA(0, 0, At, B0); PG8_MMA(0, 1, At, B1); PG8_BAR; PG8_SCHED;
            PG8_LDA(At, 1, 1); PG8_STAGE(PG8_SB(1, 0), b3, voffB); PG8_STAGE(PG8_SB(1, 1), b3 + hstep, voffB); PG8_STAGE_A(PG8_SA(1, 0), a3, 0, last);
            PG8_WAIT_V(8); PG8_WAIT_L(0); PG8_BAR; PG8_MMA(1, 0, At, B0); PG8_MMA(1, 1, At, B1); PG8_BAR; PG8_SCHED;
            } else {
            PG8_LDB(B0, 0, 0); PG8_SCHED; PG8_LDA(At, 0, 0); PG8_STAGE_A(PG8_SA(1, 1), a1, 1, false);
            PG8_WAIT_L(8); PG8_BAR; PG8_WAIT_L(0); PG8_MMA(0, 0, At, B0); PG8_BAR; PG8_SCHED;
            PG8_LDB(B1, 0, 1); PG8_STAGE(PG8_SB(0, 0), b2, voffB);
            PG8_BAR; PG8_WAIT_L(0); PG8_MMA(0, 1, At, B1); PG8_BAR;
            PG8_LDA(At, 0, 1); PG8_STAGE_A(PG8_SA(0, 0), a2, 0, last);
            PG8_BAR; PG8_WAIT_L(0); PG8_MMA(1, 0, At, B0); PG8_BAR; PG8_SCHED;
            PG8_STAGE(PG8_SB(0, 1), b2 + hstep, voffB);
            PG8_WAIT_V(6); PG8_BAR; PG8_MMA(1, 1, At, B1); PG8_BAR;
            PG8_LDB(B0, 1, 0); PG8_SCHED; PG8_LDA(At, 1, 0); PG8_STAGE_A(PG8_SA(0, 1), a2, 1, last);
            PG8_WAIT_L(8); PG8_BAR; PG8_WAIT_L(0); PG8_MMA(0, 0, At, B0); PG8_BAR; PG8_SCHED;
            PG8_LDB(B1, 1, 1); PG8_STAGE(PG8_SB(1, 0), b3, voffB);
            PG8_BAR; PG8_WAIT_L(0); PG8_MMA(0, 1, At, B1); PG8_BAR;
            PG8_LDA(At, 1, 1); PG8_STAGE_A(PG8_SA(1, 0), a3, 0, last);
            PG8_BAR; PG8_WAIT_L(0); PG8_MMA(1, 0, At, B0); PG8_BAR; PG8_SCHED;
            PG8_STAGE(PG8_SB(1, 1), b3 + hstep, voffB);
            PG8_WAIT_V(6); PG8_BAR; PG8_MMA(1, 1, At, B1); PG8_BAR;
            }
        }
        if constexpr (ALIGN_EPI) { if (wr == 0) PG8_BAR; }
        bool chain_ = false;
        if constexpr (Epi::CHAIN) { chain_ = E.chain(cur); if (chain_) E.rescale(acc, cur, wr, wc, fr, fq); }
        if constexpr (!Epi::AFTER_DRAIN) { if (!chain_) { E(acc, cur, wr, wc, fr, fq); S.done(cur); } }
        if (!has_next) break;
        if (!chain_)
#pragma unroll
        for (int a = 0; a < 2; ++a)
#pragma unroll
            for (int b = 0; b < 2; ++b)
#pragma unroll
                for (int m = 0; m < 4; ++m)
#pragma unroll
                    for (int n = 0; n < 2; ++n) acc[a][b][m][n] = (f32x4){0.f, 0.f, 0.f, 0.f};
        cur = nxt; cA = nA; cB = nB; ++ui;
        if constexpr (Sched::GATHER) { vAc[0][0] = vAn[0][0]; vAc[0][1] = vAn[0][1]; vAc[1][0] = vAn[1][0]; vAc[1][1] = vAn[1][1]; }
        if constexpr (ALIGN_EPI) { if (wr == 1) PG8_BAR; }
    }
    PG8_WAIT_V(0);
    if constexpr (!ALIGN_EPI) { if (wr == 0) PG8_BAR; }
    PG8_BAR;
    if constexpr (Epi::AFTER_DRAIN) { E.fused(acc, cur, wr, wc, fr, fq, lds, wid, lane); S.done(cur); }
#undef PG8_SA
#undef PG8_STAGE_A
#undef PG8_SB
#undef PG8_STAGE
#undef PG8_LDA
#undef PG8_LDB
#undef PG8_MMA
#undef PG8_WAIT_V
#undef PG8_WAIT_L
#undef PG8_BAR
#undef PG8_SCHED
}
}

#define LAS __attribute__((address_space(3)))
#define XB_TMO      128
#define XB_XCNT(j)  (256  + 64 * (j))
#define XB_XSUB(j)  (1280 + 64 * (j))
#define XB_XGEN(j)  (2304 + 64 * (j))
#define XB_TOP      3328
#define XB_TOPGEN   3392
#define XCD_BAR_WORDS 3456
#define XB_SPIN_CAP (1u << 18)
__device__ __forceinline__ unsigned xb_ld(unsigned* p)              { return __hip_atomic_load(p, __ATOMIC_RELAXED, __HIP_MEMORY_SCOPE_AGENT); }
__device__ __forceinline__ unsigned xb_add(unsigned* p, unsigned v) { return __hip_atomic_fetch_add(p, v, __ATOMIC_RELAXED, __HIP_MEMORY_SCOPE_AGENT); }
__device__ __forceinline__ unsigned xb_xcc_id() { return (unsigned)__builtin_amdgcn_s_getreg((3 << 11) | 20) & 0xFu; }
#define XB_SPIN(cond, bar) do { unsigned _sp = 0; while (cond) { __builtin_amdgcn_s_sleep(1); \
    if ((++_sp & 255u) == 0u) { if (xb_ld(&(bar)[XB_TMO])) break; if (_sp > XB_SPIN_CAP) { atomicAdd(&(bar)[XB_TMO], 1u); break; } } } } while (0)
__device__ __forceinline__ int otid(int wv) { int t; asm volatile("v_mbcnt_lo_u32_b32 %0, -1, 0\n\tv_mbcnt_hi_u32_b32 %0, -1, %0\n\tv_lshl_add_u32 %0, %1, 6, %0" : "=&v"(t) : "s"(wv)); return t; }
struct XcdBarrier { unsigned* bar; unsigned x; volatile LAS unsigned* st; int wv; };
__device__ __forceinline__ XcdBarrier xcd_barrier_post(unsigned* bar, volatile LAS unsigned* st, int wv) {
    XcdBarrier b; b.bar = bar; b.x = xb_xcc_id(); b.st = st; b.wv = wv;
    if (threadIdx.x == 0) { (void)xb_add(&bar[XB_XCNT(b.x)], 1u); st[2] = b.x; }
    return b;
}
__device__ __forceinline__ void xcd_barrier_complete(unsigned* bar, unsigned x, unsigned& nloc, unsigned& nx) {
    const unsigned G = gridDim.x * gridDim.y * gridDim.z;
    unsigned sum, cnt, mine, sp = 0u;
    for (;;) {
        sum = 0u; cnt = 0u; mine = 0u;
#pragma unroll
        for (unsigned j = 0; j < 16; ++j) { const unsigned c = xb_ld(&bar[XB_XCNT(j)]); sum += c; cnt += (c > 0u) ? 1u : 0u; mine = (j == x) ? c : mine; }
        if (sum == G) break;
        __builtin_amdgcn_s_sleep(1);
        if ((++sp & 255u) == 0u) { if (xb_ld(&bar[XB_TMO])) break; if (sp > XB_SPIN_CAP) { atomicAdd(&bar[XB_TMO], 1u); break; } }
    }
    nloc = mine > 0u ? mine : 1u; nx = cnt > 0u ? cnt : 1u;
}
__device__ __forceinline__ void xcd_barrier(const XcdBarrier& b) {
    asm volatile("s_waitcnt vmcnt(0)" ::: "memory");
    __syncthreads();
    if (otid(b.wv) == 0) {
        unsigned* bar = b.bar;
        __builtin_amdgcn_s_waitcnt(0);
        unsigned nloc = b.st[0], nx = b.st[1]; const unsigned bx = b.st[2];
        if (nloc == 0u) { xcd_barrier_complete(bar, bx, nloc, nx); b.st[0] = nloc; b.st[1] = nx; }
        const unsigned old = xb_add(&bar[XB_XSUB(bx)], 1u);
        const unsigned gen = old / nloc;
        if (old + 1u == (gen + 1u) * nloc) {
            __builtin_amdgcn_fence(__ATOMIC_RELEASE, "agent");
            asm volatile("s_waitcnt vmcnt(0)" ::: "memory");
            const unsigned og = xb_add(&bar[XB_TOP], 1u);
            const unsigned tg = og / nx;
            if (og + 1u == (tg + 1u) * nx) xb_add(&bar[XB_TOPGEN], 1u);
            else XB_SPIN(xb_ld(&bar[XB_TOPGEN]) == tg, bar);
            __builtin_amdgcn_fence(__ATOMIC_ACQUIRE, "agent");
            xb_add(&bar[XB_XGEN(bx)], 1u);
            asm volatile("s_waitcnt vmcnt(0)" ::: "memory");
        } else {
            XB_SPIN(xb_ld(&bar[XB_XGEN(bx)]) == gen, bar);
            __builtin_amdgcn_fence(__ATOMIC_ACQUIRE, "agent");
            asm volatile("s_waitcnt vmcnt(0)" ::: "memory");
        }
    }
    __syncthreads();
}
constexpr int CW_BAR = 4096;

namespace att {
typedef short s16x4 __attribute__((ext_vector_type(4)));
typedef unsigned u32x2_t __attribute__((ext_vector_type(2)));
typedef float f32x16 __attribute__((ext_vector_type(16)));
constexpr int PK = 144, PV = 192;
constexpr int KBUF = 64 * PK, VBUF = 64 * PV;
constexpr int OFF_K = 0, OFF_V = 2 * KBUF, OFF_KM = 2 * KBUF + 2 * VBUF, OFF_OST = OFF_KM + 4096, OST_W = 32 * 144, LDS_BYTES_ATT = OFF_OST + 8 * OST_W;
constexpr float NEG = -1e30f;
__device__ __forceinline__ float half_sum(float v) { auto rr = __builtin_amdgcn_permlane32_swap(__float_as_uint(v), __float_as_uint(v), false, false); return __uint_as_float(rr[0]) + __uint_as_float(rr[1]); }
__device__ __forceinline__ float half_max(float v) { auto rr = __builtin_amdgcn_permlane32_swap(__float_as_uint(v), __float_as_uint(v), false, false); return fmaxf(__uint_as_float(rr[0]), __uint_as_float(rr[1])); }
__device__ __forceinline__ unsigned pk_bf16(float lo, float hi) { typedef float f2 __attribute__((ext_vector_type(2))); typedef __bf16 b2 __attribute__((ext_vector_type(2))); f2 v = {lo, hi}; b2 b = __builtin_convertvector(v, b2); return __builtin_bit_cast(unsigned, b); }
__device__ __forceinline__ s16x4 vtr(LAS const unsigned char* p) { typedef short v4 __attribute__((ext_vector_type(4))); return __builtin_amdgcn_ds_read_tr16_b64_v4i16((LAS v4*)p); }

__device__ __forceinline__ void unit(LAS unsigned char* lds, const bf16_t* __restrict__ P, const float* __restrict__ KM, const float* __restrict__ KN, bf16_t* __restrict__ YB, int b, int h, int qb, int tid, unsigned* qctr, unsigned& nxt) {
    const int lane = tid & 63, w = __builtin_amdgcn_readfirstlane(tid >> 6), r32 = lane & 31, hi = lane >> 5;
    const size_t rowbase = (size_t)b * SEQ; const int q0 = qb * MBLK;
    const float cexp = exp2f(-(float)(h + 1)) * 1.4426950408889634f;
    LAS float* km = (LAS float*)(lds + OFF_KM);
    for (int i = tid; i < qb * 64; i += 512) km[i] = KM[(size_t)((b * MH + h) * NBLK) * HD + i];
    const bf16_t* qp = P + (rowbase + q0 + 32 * w + r32) * NPROJ + OFF_MOBA + h * 64 + 8 * hi;
    bf16x8 qs[4];
#pragma unroll
    for (int d0 = 0; d0 < 4; ++d0) qs[d0] = *(const bf16x8*)(qp + 16 * d0);
    __syncthreads();
    unsigned selmask = 0u;
    if (qb > 0) {
        float qf[32];
#pragma unroll
        for (int d0 = 0; d0 < 4; ++d0)
#pragma unroll
            for (int e = 0; e < 8; ++e) qf[d0 * 8 + e] = bf2f((bf16_t)qs[d0][e]);
        float gate[15];
#pragma unroll
        for (int n = 0; n < 15; ++n) { float s = 0.f;
            if (n < qb) {
#pragma unroll
                for (int d0 = 0; d0 < 4; ++d0) { const f32x4 k0 = *(const LAS f32x4*)(km + n * 64 + 16 * d0 + 8 * hi), k1 = *(const LAS f32x4*)(km + n * 64 + 16 * d0 + 8 * hi + 4);
                    s += qf[d0 * 8 + 0] * k0[0] + qf[d0 * 8 + 1] * k0[1] + qf[d0 * 8 + 2] * k0[2] + qf[d0 * 8 + 3] * k0[3] + qf[d0 * 8 + 4] * k1[0] + qf[d0 * 8 + 5] * k1[1] + qf[d0 * 8 + 6] * k1[2] + qf[d0 * 8 + 7] * k1[3]; }
                s = half_sum(s); }
            gate[n] = s; }
#pragma unroll
        for (int s = 0; s < 3; ++s) { int best = -1; float bv = 0.f;
#pragma unroll
            for (int n = 0; n < 15; ++n) { const bool ok = n < qb && !((selmask >> n) & 1u); if (ok && (best < 0 || gate[n] > bv)) { best = n; bv = gate[n]; } }
            if (best >= 0) selmask |= 1u << best; }
    }
    int skT = 0;
    if (qb > 0) {
        float q2 = 0.f;
#pragma unroll
        for (int d0 = 0; d0 < 4; ++d0)
#pragma unroll
            for (int e = 0; e < 8; ++e) { const float x = bf2f((bf16_t)qs[d0][e]); q2 += x * x; }
        q2 = half_sum(q2);
        const float qw = wave_allmax(q2);
        LAS float* qmx = (LAS float*)(lds + OFF_KM + 3840);
        if (lane == 0) qmx[w] = qw;
        __syncthreads();
        float qm = qmx[0];
#pragma unroll
        for (int i = 1; i < 8; ++i) qm = fmaxf(qm, qmx[i]);
        const float qmax = sqrtf(qm), kown = KN[(b * MH + h) * NBLK + qb];
        bool pre = true;
#pragma unroll
        for (int n = 0; n < 15; ++n) { if (n < qb) { const float top = 0.18033688f * qmax * (KN[(b * MH + h) * NBLK + n] + kown) - cexp * (float)(256 * (qb - n - 1) + 1);
#pragma unroll
            for (int j = 0; j < 4; ++j) { pre = pre && (top - cexp * (float)(64 * (3 - j)) < -40.f); if (pre) skT = 4 * n + j + 1; } } }
        skT = __builtin_amdgcn_readfirstlane(skT) & ~1;
    }
#pragma unroll
    for (int d0 = 0; d0 < 4; ++d0) { unsigned wv_[4];
#pragma unroll
        for (int e = 0; e < 4; ++e) wv_[e] = pk_bf16(bf2f((bf16_t)qs[d0][2 * e]) * 0.18033688011112042f, bf2f((bf16_t)qs[d0][2 * e + 1]) * 0.18033688011112042f);
        u32x4_t t4 = {wv_[0], wv_[1], wv_[2], wv_[3]}; qs[d0] = __builtin_bit_cast(bf16x8, t4); }
    float ck[16];
#pragma unroll
    for (int r = 0; r < 16; ++r) ck[r] = cexp * (float)((r & 3) + 8 * (r >> 2));
    f32x16 oT0 = {}, oT1 = {};
    float mrun = 0.f, lsum = 0.f;
    const int qrel = 32 * w + r32;
    const int NT = 4 + 4 * qb - skT;
    const int srow = tid >> 3, sch = tid & 7;
    const bf16_t* kvsrc = P + rowbase * NPROJ + OFF_MOBA + 512 + h * 64 + sch * 8;
    u32x4_t kA, vA, kB, vB;
    { const bf16_t* s0 = kvsrc + (size_t)(q0 + srow) * NPROJ; kA = *(const u32x4_t*)s0; vA = *(const u32x4_t*)(s0 + 512); }
    *(LAS u32x4_t*)(lds + OFF_K + srow * PK + sch * 16) = kA; *(LAS u32x4_t*)(lds + OFF_V + srow * PV + sch * 16) = vA;
    { const bf16_t* s0 = kvsrc + (size_t)(q0 + 64 + srow) * NPROJ; kA = *(const u32x4_t*)s0; vA = *(const u32x4_t*)(s0 + 512); }
    __syncthreads();
#define ATT_TILE(i, KC, VC, KN, VN) do { \
        const int buf = (i) & 1; \
        if ((i) + 2 < NT) { const int i2 = (i) + 2; const int kv2 = i2 < 4 ? q0 + 64 * i2 : 64 * (skT + i2 - 4); \
            const bf16_t* s0 = kvsrc + (size_t)(kv2 + srow) * NPROJ; KN = __builtin_nontemporal_load((const u32x4_t*)s0); VN = __builtin_nontemporal_load((const u32x4_t*)(s0 + 512)); } \
        att_tile_compute((i), buf); \
        if ((i) + 1 < NT) { *(LAS u32x4_t*)(lds + OFF_K + (buf ^ 1) * KBUF + srow * PK + sch * 16) = KC; *(LAS u32x4_t*)(lds + OFF_V + (buf ^ 1) * VBUF + srow * PV + sch * 16) = VC; } \
        LDS_BARRIER(); } while (0)
    auto att_tile_compute = [&](int i, int buf) {
        int n, j; bool own;
        if (i < 4) { own = true; n = qb; j = i; } else { own = false; n = (skT + i - 4) >> 2; j = (skT + i - 4) & 3; }
        const bool sel = own ? true : (((selmask >> n) & 1u) != 0u);
        bool docomp; int causal = 0;
        if (own) { docomp = j <= (w >> 1); causal = (j == (w >> 1)); }
        else docomp = __builtin_amdgcn_ballot_w64(sel) != 0ull;
        if (docomp) {
            LAS const unsigned char* Kb = lds + OFF_K + buf * KBUF; LAS const unsigned char* Vb = lds + OFF_V + buf * VBUF;
            const float trel = (float)((n - qb) * MBLK + 64 * j + 4 * hi);
            const float bl0 = sel ? cexp * trel - mrun : NEG, bl1 = sel ? cexp * (trel + 32.f) - mrun : NEG;
            f32x16 p0, p1;
#pragma unroll
            for (int r = 0; r < 16; ++r) { p0[r] = bl0 + ck[r]; p1[r] = bl1 + ck[r]; }
#pragma unroll
            for (int d0 = 0; d0 < 4; ++d0) {
                const bf16x8 a0 = *(const LAS bf16x8*)(Kb + r32 * PK + 32 * d0 + 16 * hi), a1 = *(const LAS bf16x8*)(Kb + (r32 + 32) * PK + 32 * d0 + 16 * hi);
                p0 = __builtin_amdgcn_mfma_f32_32x32x16_bf16(a0, qs[d0], p0, 0, 0, 0);
                p1 = __builtin_amdgcn_mfma_f32_32x32x16_bf16(a1, qs[d0], p1, 0, 0, 0); }
            if (causal) {
#pragma unroll
                for (int r = 0; r < 16; ++r) { const int kvrel = 64 * j + (r & 3) + 8 * (r >> 2) + 4 * hi; if (kvrel > qrel) p0[r] = NEG; if (kvrel + 32 > qrel) p1[r] = NEG; } }
            float mt = fmaxf(p0[0], p1[0]);
#pragma unroll
            for (int r = 1; r < 16; ++r) mt = fmaxf(mt, fmaxf(p0[r], p1[r]));
            mt = half_max(mt);
            const float dsh = (i == 0) ? mt : fmaxf(mt, 0.f);
            if (__builtin_amdgcn_ballot_w64(dsh != 0.f) != 0ull) {
                const float alpha = __builtin_amdgcn_exp2f(-dsh);
                mrun += dsh; lsum *= alpha;
#pragma unroll
                for (int r = 0; r < 16; ++r) { oT0[r] *= alpha; oT1[r] *= alpha; p0[r] -= dsh; p1[r] -= dsh; } }
            float ps = 0.f;
#pragma unroll
            for (int r = 0; r < 16; ++r) { p0[r] = __builtin_amdgcn_exp2f(p0[r]); p1[r] = __builtin_amdgcn_exp2f(p1[r]); ps += p0[r] + p1[r]; }
            lsum += ps;
            bf16x8 pb[4];
#pragma unroll
            for (int s = 0; s < 4; ++s) { u32x4_t t4;
#pragma unroll
                for (int e = 0; e < 4; ++e) { const int r = 8 * (s & 1) + 2 * e; t4[e] = (s < 2) ? pk_bf16(p0[r], p0[r + 1]) : pk_bf16(p1[r], p1[r + 1]); }
                pb[s] = __builtin_bit_cast(bf16x8, t4); }
            LAS const unsigned char* vb = Vb + (4 * hi + ((lane & 15) >> 2)) * PV + (16 * ((lane >> 4) & 1) + 4 * (lane & 3)) * 2;
#pragma unroll
            for (int s = 0; s < 4; ++s) {
                const s16x4 l0 = vtr(vb + (16 * s) * PV), h0 = vtr(vb + (16 * s + 8) * PV), l1 = vtr(vb + (16 * s) * PV + 64), h1 = vtr(vb + (16 * s + 8) * PV + 64);
                const bf16x8 va0 = {l0[0], l0[1], l0[2], l0[3], h0[0], h0[1], h0[2], h0[3]}, va1 = {l1[0], l1[1], l1[2], l1[3], h1[0], h1[1], h1[2], h1[3]};
                oT0 = __builtin_amdgcn_mfma_f32_32x32x16_bf16(va0, pb[s], oT0, 0, 0, 0);
                oT1 = __builtin_amdgcn_mfma_f32_32x32x16_bf16(va1, pb[s], oT1, 0, 0, 0); }
        }
    };
    for (int i = 0; i < NT; i += 2) { ATT_TILE(i, kA, vA, kB, vB); ATT_TILE(i + 1, kB, vB, kA, vA); }
#undef ATT_TILE
    if (tid == 0) nxt = atomicAdd(qctr, 1u);
    const float inv = 1.f / half_sum(lsum);
    LAS unsigned char* ost = lds + OFF_OST + w * OST_W;
#pragma unroll
    for (int k = 0; k < 4; ++k) {
        u32x2_t a; a.x = pk_bf16(oT0[4 * k] * inv, oT0[4 * k + 1] * inv); a.y = pk_bf16(oT0[4 * k + 2] * inv, oT0[4 * k + 3] * inv);
        u32x2_t c; c.x = pk_bf16(oT1[4 * k] * inv, oT1[4 * k + 1] * inv); c.y = pk_bf16(oT1[4 * k + 2] * inv, oT1[4 * k + 3] * inv);
        *(LAS u32x2_t*)(ost + r32 * 144 + (8 * k + 4 * hi) * 2) = a; *(LAS u32x2_t*)(ost + r32 * 144 + (32 + 8 * k + 4 * hi) * 2) = c; }
    asm volatile("s_waitcnt lgkmcnt(0)" ::: "memory");
    bf16_t* yo = YB + (rowbase + q0 + 32 * w) * DMO + h * 64;
#pragma unroll
    for (int i = 0; i < 4; ++i) { const int row = i * 8 + (lane >> 3), ch = lane & 7; const u32x4_t v = *(const LAS u32x4_t*)(ost + row * 144 + ch * 16); *(u32x4_t*)(yo + (size_t)row * DMO + ch * 8) = v; }
    __syncthreads();
}
__device__ __forceinline__ void phase(LAS unsigned char* lds, volatile LAS unsigned* slotw, unsigned* qctr, const bf16_t* P, const float* KM, const float* KN, bf16_t* YB, int wv) {
    unsigned nxt = 0u;
    { int t0; asm volatile("v_mbcnt_lo_u32_b32 %0, -1, 0\n\tv_mbcnt_hi_u32_b32 %0, -1, %0\n\tv_lshl_add_u32 %0, %1, 6, %0" : "=&v"(t0) : "s"(wv)); if (t0 == 0) nxt = atomicAdd(qctr, 1u); }
    for (;;) {
        int tid; asm volatile("v_mbcnt_lo_u32_b32 %0, -1, 0\n\tv_mbcnt_hi_u32_b32 %0, -1, %0\n\tv_lshl_add_u32 %0, %1, 6, %0" : "=&v"(tid) : "s"(wv));
        if (tid == 0) *slotw = nxt;
        __syncthreads();
        const int idx = __builtin_amdgcn_readfirstlane((int)*slotw);
        if (idx >= NB * MH * NBLK) break;
        unit(lds, P, KM, KN, YB, idx & 3, 7 - (idx >> 6), 15 - ((idx >> 2) & 15), tid, qctr, nxt);
    }
}
}

namespace s5 {
constexpr int CS = 256, NCH = SEQ / CS;
constexpr int U_BYTES = CS * 32, HP = 272, WAVE_LDS = U_BYTES + 16 * HP;
constexpr size_t WS_S5E = WS_ROUTE + 1 * MiB;
__device__ __forceinline__ float blo(unsigned w) { return __uint_as_float(w << 16); }
__device__ __forceinline__ float bhi(unsigned w) { return __uint_as_float(w & 0xffff0000u); }
__device__ __forceinline__ void load_u(LAS unsigned char* ul, const bf16_t* __restrict__ P, size_t row0, int g, int lane) {
#pragma unroll
    for (int i = 0; i < 4; ++i) { const int t = lane + 64 * i; const bf16_t* src = P + (row0 + t) * NPROJ + OFF_SSM + g * 16;
        const u32x4_t v0 = *(const u32x4_t*)src, v1 = *(const u32x4_t*)(src + 8);
        *(LAS u32x4_t*)(ul + t * 32) = v0; *(LAS u32x4_t*)(ul + t * 32 + 16) = v1; }
}
struct Tab { float lre, lim, bre[16], bim[16]; };
__device__ __forceinline__ void load_tab(Tab& tb, const float* __restrict__ LAM, const float* __restrict__ BB, int g, int p) {
    tb.lre = LAM[(g * SST + p) * 2]; tb.lim = LAM[(g * SST + p) * 2 + 1];
#pragma unroll
    for (int h = 0; h < 16; h += 2) { const f32x4 v = *(const f32x4*)(BB + ((g * SST + p) * 16 + h) * 2); tb.bre[h] = v[0]; tb.bim[h] = v[1]; tb.bre[h + 1] = v[2]; tb.bim[h + 1] = v[3]; }
}
__device__ __forceinline__ void step(const Tab& tb, LAS const unsigned char* ul, int t, float& hre, float& him) {
    const u32x4_t a = *(const LAS u32x4_t*)(ul + t * 32), b = *(const LAS u32x4_t*)(ul + t * 32 + 16);
    float u[16] = {blo(a.x), bhi(a.x), blo(a.y), bhi(a.y), blo(a.z), bhi(a.z), blo(a.w), bhi(a.w), blo(b.x), bhi(b.x), blo(b.y), bhi(b.y), blo(b.z), bhi(b.z), blo(b.w), bhi(b.w)};
    float bur = 0.f, bui = 0.f;
#pragma unroll
    for (int h = 0; h < 16; ++h) { bur += tb.bre[h] * u[h]; bui += tb.bim[h] * u[h]; }
    const float nre = tb.lre * hre - tb.lim * him + bur, nim = tb.lre * him + tb.lim * hre + bui;
    hre = nre; him = nim;
}
__device__ __forceinline__ void part1(LAS unsigned char* wl, const bf16_t* __restrict__ P, const float* __restrict__ LAM, const float* __restrict__ BB, float* __restrict__ E, int unit, int lane) {
    const int c = unit & 15, g = (unit >> 4) & 31, b = unit >> 9;
    Tab tb; load_tab(tb, LAM, BB, g, lane);
    load_u(wl, P, (size_t)b * SEQ + c * CS, g, lane);
    float hre = 0.f, him = 0.f;
#pragma unroll 4
    for (int t = 0; t < CS; ++t) step(tb, wl, t, hre, him);
    *(float2*)(E + ((size_t)unit * SST + lane) * 2) = make_float2(hre, him);
}
__device__ __forceinline__ void part2(LAS unsigned char* wl, const bf16_t* __restrict__ P, const float* __restrict__ LAM, const float* __restrict__ BB, const float* __restrict__ E,
                                      const float* __restrict__ c_re, const float* __restrict__ c_im, const float* __restrict__ dvec, bf16_t* __restrict__ YCPRE, int unit, int lane) {
    const int c = unit & 15, g = (unit >> 4) & 31, b = unit >> 9;
    Tab tb; load_tab(tb, LAM, BB, g, lane);
    const size_t row0 = (size_t)b * SEQ + c * CS;
    load_u(wl, P, row0, g, lane);
    const int ch = lane & 15, kq = lane >> 4;
    bf16x8 cf[4];
#pragma unroll
    for (int s = 0; s < 4; ++s) { const int k0 = (32 * s + 8 * kq) & 63; const float* src = (s < 2 ? c_re : c_im) + (size_t)(g * 16 + ch) * SST + k0; const float sg = s < 2 ? 1.f : -1.f;
        const f32x4 v0 = *(const f32x4*)src, v1 = *(const f32x4*)(src + 4);
        u32x4_t t4 = {att::pk_bf16(sg * v0[0], sg * v0[1]), att::pk_bf16(sg * v0[2], sg * v0[3]), att::pk_bf16(sg * v1[0], sg * v1[1]), att::pk_bf16(sg * v1[2], sg * v1[3])};
        cf[s] = __builtin_bit_cast(bf16x8, t4); }
    const float dch = dvec[g * 16 + ch];
    float hre = 0.f, him = 0.f;
    { float pr = tb.lre, pi = tb.lim;
#pragma unroll
      for (int i = 0; i < 8; ++i) { const float nr = pr * pr - pi * pi, ni = 2.f * pr * pi; pr = nr; pi = ni; }
      const float* e0 = E + ((size_t)(unit - c) * SST + lane) * 2;
      for (int cc = 0; cc < c; ++cc) { const float2 e = *(const float2*)(e0 + (size_t)cc * SST * 2); const float nr = pr * hre - pi * him + e.x, ni = pr * him + pi * hre + e.y; hre = nr; him = ni; } }
    LAS unsigned char* ht = wl + U_BYTES;
    for (int sub = 0; sub < CS / 16; ++sub) {
#pragma unroll 4
        for (int tt = 0; tt < 16; ++tt) { step(tb, wl, sub * 16 + tt, hre, him);
            *(LAS bf16_t*)(ht + tt * HP + lane * 2) = f2bf(hre); *(LAS bf16_t*)(ht + tt * HP + (64 + lane) * 2) = f2bf(him); }
        f32x4 acc = {0.f, 0.f, 0.f, 0.f};
#pragma unroll
        for (int s = 0; s < 4; ++s) { const bf16x8 a = *(const LAS bf16x8*)(ht + ch * HP + (32 * s + 8 * kq) * 2); acc = __builtin_amdgcn_mfma_f32_16x16x32_bf16(a, cf[s], acc, 0, 0, 0); }
#pragma unroll
        for (int r = 0; r < 4; ++r) { const int t = sub * 16 + 4 * kq + r; const float u = bf2f(*(const LAS bf16_t*)(wl + t * 32 + ch * 2));
            const float y = acc[r] + dch * u; const float gl = y * pg8::sigm(1.5957691216057308f * (y + 0.044715f * y * y * y));
            YCPRE[(row0 + t) * DSS + g * 16 + ch] = f2bf(gl); }
    }
}
constexpr int BUP = 272, WAVE_LDS2 = U_BYTES + 16 * HP + 16 * BUP;
struct Tab2 { float lre, lim; bf16x8 bb[8]; };
__device__ __forceinline__ void load_tab2(Tab2& tb, const float* __restrict__ LAM, const float* __restrict__ BB, int g, int lane) {
    tb.lre = LAM[(g * SST + lane) * 2]; tb.lim = LAM[(g * SST + lane) * 2 + 1];
    const int fr = lane & 15, kq = lane >> 4;
#pragma unroll
    for (int nt = 0; nt < 8; ++nt) { u32x4_t t4 = {0u, 0u, 0u, 0u};
        if (kq < 2) t4 = *(const u32x4_t*)((const unsigned char*)BB + (SM_BBF - SM_BB) + (size_t)(((g * 8 + nt) * 32 + (lane & 31)) * 16));
        tb.bb[nt] = __builtin_bit_cast(bf16x8, t4); }
}
__device__ __forceinline__ void bu_group(const Tab2& tb, LAS const unsigned char* ul, LAS unsigned char* but, int g16, int lane) {
    const int fr = lane & 15, kq = lane >> 4;
    u32x4_t ub = {0u, 0u, 0u, 0u}; if (kq < 2) ub = *(const LAS u32x4_t*)(ul + (16 * g16 + fr) * 32 + kq * 16);
    const bf16x8 uf = __builtin_bit_cast(bf16x8, ub);
#pragma unroll
    for (int nt = 0; nt < 8; ++nt) { const f32x4 d = __builtin_amdgcn_mfma_f32_16x16x32_bf16(tb.bb[nt], uf, (f32x4){0.f, 0.f, 0.f, 0.f}, 0, 0, 0);
        u32x2_t_ o = {att::pk_bf16(d[0], d[1]), att::pk_bf16(d[2], d[3])};
        *(LAS u32x2_t_*)(but + fr * BUP + (16 * nt + 4 * kq) * 2) = o; }
}
__device__ __forceinline__ void part1b(LAS unsigned char* wl, const bf16_t* __restrict__ P, const float* __restrict__ LAM, const float* __restrict__ BB, float* __restrict__ E, int unit, int lane) {
    const int c = unit & 15, g = (unit >> 4) & 31, b = unit >> 9;
    Tab2 tb; load_tab2(tb, LAM, BB, g, lane);
    load_u(wl, P, (size_t)b * SEQ + c * CS, g, lane);
    LAS unsigned char* but = wl + U_BYTES + 16 * HP;
    float hre = 0.f, him = 0.f;
    for (int g16 = 0; g16 < CS / 16; ++g16) {
        bu_group(tb, wl, but, g16, lane); asm volatile("" ::: "memory");
#pragma unroll
        for (int tt = 0; tt < 16; ++tt) { const unsigned w_ = *(const LAS unsigned*)(but + tt * BUP + lane * 4); const float bur = blo(w_), bui = bhi(w_);
            const float nre = tb.lre * hre - tb.lim * him + bur, nim = tb.lre * him + tb.lim * hre + bui; hre = nre; him = nim; }
    }
    *(float2*)(E + ((size_t)unit * SST + lane) * 2) = make_float2(hre, him);
}
__device__ __forceinline__ void part2b(LAS unsigned char* wl, const bf16_t* __restrict__ P, const float* __restrict__ LAM, const float* __restrict__ BB, const float* __restrict__ E,
                                       const float* __restrict__ c_re, const float* __restrict__ c_im, const float* __restrict__ dvec, bf16_t* __restrict__ YCPRE, int unit, int lane) {
    const int c = unit & 15, g = (unit >> 4) & 31, b = unit >> 9;
    Tab2 tb; load_tab2(tb, LAM, BB, g, lane);
    const size_t row0 = (size_t)b * SEQ + c * CS;
    load_u(wl, P, row0, g, lane);
    const int ch = lane & 15, kq = lane >> 4;
    bf16x8 cf[4];
#pragma unroll
    for (int s = 0; s < 4; ++s) { const int p0 = 16 * s + 4 * kq;
        const f32x4 vr_ = *(const f32x4*)(c_re + (size_t)(g * 16 + ch) * SST + p0), vi_ = *(const f32x4*)(c_im + (size_t)(g * 16 + ch) * SST + p0);
        u32x4_t t4 = {att::pk_bf16(vr_[0], -vi_[0]), att::pk_bf16(vr_[1], -vi_[1]), att::pk_bf16(vr_[2], -vi_[2]), att::pk_bf16(vr_[3], -vi_[3])};
        cf[s] = __builtin_bit_cast(bf16x8, t4); }
    const float dch = dvec[g * 16 + ch];
    float hre = 0.f, him = 0.f;
    { float pr = tb.lre, pi = tb.lim;
#pragma unroll
      for (int i = 0; i < 8; ++i) { const float nr = pr * pr - pi * pi, ni = 2.f * pr * pi; pr = nr; pi = ni; }
      const float* e0 = E + ((size_t)(unit - c) * SST + lane) * 2;
      float2 ev[15];
#pragma unroll
      for (int cc = 0; cc < 15; ++cc) { ev[cc] = make_float2(0.f, 0.f); if (cc < c) ev[cc] = *(const float2*)(e0 + (size_t)cc * SST * 2); }
#pragma unroll
      for (int cc = 0; cc < 15; ++cc) if (cc < c) { const float nr = pr * hre - pi * him + ev[cc].x, ni = pr * him + pi * hre + ev[cc].y; hre = nr; him = ni; } }
    LAS unsigned char* ht = wl + U_BYTES; LAS unsigned char* but = ht + 16 * HP;
    for (int sub = 0; sub < CS / 16; ++sub) {
        bu_group(tb, wl, but, sub, lane); asm volatile("" ::: "memory");
#pragma unroll
        for (int tt = 0; tt < 16; ++tt) { const unsigned w_ = *(const LAS unsigned*)(but + tt * BUP + lane * 4); const float bur = blo(w_), bui = bhi(w_);
            const float nre = tb.lre * hre - tb.lim * him + bur, nim = tb.lre * him + tb.lim * hre + bui; hre = nre; him = nim;
            *(LAS unsigned*)(ht + tt * HP + lane * 4) = att::pk_bf16(hre, him); }
        asm volatile("" ::: "memory");
        f32x4 acc = {0.f, 0.f, 0.f, 0.f};
#pragma unroll
        for (int s = 0; s < 4; ++s) { const bf16x8 a = *(const LAS bf16x8*)(ht + ch * HP + (32 * s + 8 * kq) * 2); acc = __builtin_amdgcn_mfma_f32_16x16x32_bf16(a, cf[s], acc, 0, 0, 0); }
#pragma unroll
        for (int r = 0; r < 4; ++r) { const int t = sub * 16 + 4 * kq + r; const float u = bf2f(*(const LAS bf16_t*)(wl + t * 32 + ch * 2));
            const float y = acc[r] + dch * u; const float gl = y * pg8::sigm(1.5957691216057308f * (y + 0.044715f * y * y * y));
            YCPRE[(row0 + t) * DSS + g * 16 + ch] = f2bf(gl); }
        asm volatile("" ::: "memory");
    }
}
}

namespace wkv {
constexpr int CH = 64, NCHK = SEQ / CH;
constexpr size_t WS_GST = 320 * MiB, WS_GYT = 336 * MiB, WS_YLT = 368 * MiB, WS_SLT = 416 * MiB;
constexpr size_t WS_PEND = WS_ROUTE + 2 * MiB;
constexpr size_t WS_RK = WS_ROUTE + 3 * MiB;
constexpr size_t SM_W2T = 1 * MiB, SM_A2T = SM_W2T + 65536, SM_G2T = SM_A2T + 65536;
constexpr int PB = 144;
constexpr int L_CST = 147456;
constexpr int L_ACT = 109568, ACT_P = 528;
constexpr int L_SW = 33792, L_SA = L_SW + 16640, L_SG = L_SA + 16640, L_LW = 83712, LP = 65;
constexpr int L_PART = 33792;
constexpr int M_AT = 0, M_RT = 9216, M_BT = 18432, M_KT = 27648, M_BH = 36864, M_KH = 46080, M_VT = 55296;
constexpr int L_NABT = 64512, NAB_P = 272, L_NAK = 81920, L_NBRT = 91136, L_NKRT = 100352;
constexpr int M_W1 = M_AT, M_M2T = L_NAK;
static_assert(L_NABT + 64 * NAB_P <= L_NAK && L_NAK + 9216 <= L_NBRT && L_NBRT + 9216 <= L_NKRT && L_NKRT + 9216 <= L_ACT && L_LW + 16640 <= L_ACT && L_ACT + 64 * ACT_P <= 143360, "wkv LDS map");

typedef unsigned u32x2_t __attribute__((ext_vector_type(2)));
using att::pk_bf16;
template <int CTRL> __device__ __forceinline__ float dppx(float v) { return __builtin_bit_cast(float, __builtin_amdgcn_update_dpp(0, __builtin_bit_cast(int, v), CTRL, 0xF, 0xF, false)); }
__device__ __forceinline__ float sum8(float v) { v += dppx<0xB1>(v); v += dppx<0x4E>(v); v += dppx<0x141>(v); return v; }
__device__ __forceinline__ bf16x8 ld8(LAS const unsigned char* p) { return *(const LAS bf16x8*)p; }
__device__ __forceinline__ bf16x8 ld44(LAS const unsigned char* p0, LAS const unsigned char* p1) { const u32x2_t a = *(const LAS u32x2_t*)p0, b = *(const LAS u32x2_t*)p1; u32x4_t t = {a.x, a.y, b.x, b.y}; return __builtin_bit_cast(bf16x8, t); }
__device__ __forceinline__ bf16x8 acc2b(const f32x4& x, const f32x4& y) { u32x4_t t = {pk_bf16(x[0], x[1]), pk_bf16(x[2], x[3]), pk_bf16(y[0], y[1]), pk_bf16(y[2], y[3])}; return __builtin_bit_cast(bf16x8, t); }
#define MFMA16(a, b, c) __builtin_amdgcn_mfma_f32_16x16x32_bf16(a, b, c, 0, 0, 0)
__device__ __forceinline__ int tsw(int row) { return ((row >> 3) & 7) << 4; }

template <int TT> __device__ __forceinline__ void sub4_step(float (&xq)[16], LAS const unsigned char* nbq  , int sub) {
    constexpr int NV = (TT + 15) / 16;
    f32x4 nv[NV > 0 ? NV : 1];
#pragma unroll
    for (int k = 0; k < NV; ++k) nv[k] = *(const LAS f32x4*)(nbq + TT * NAB_P + k * 16);
    float a4[4] = {(sub == (TT & 3)) ? xq[TT >> 2] : 0.f, 0.f, 0.f, 0.f};
#pragma unroll
    for (int k = 0; k < NV; ++k)
#pragma unroll
        for (int e = 0; e < 4; ++e) a4[e] += xq[4 * k + e] * nv[k][e];
    float v = (a4[0] + a4[1]) + (a4[2] + a4[3]);
    v += dppx<0xB1>(v); v += dppx<0x4E>(v);
    xq[TT >> 2] = (sub == (TT & 3)) ? v : xq[TT >> 2];
}
template <int T0, int T1> struct Sub4 { static __device__ __forceinline__ void go(float (&xq)[16], LAS const unsigned char* nbq, int sub) { sub4_step<T0>(xq, nbq, sub); Sub4<T0 + 1, T1>::go(xq, nbq, sub); } };
template <int T1> struct Sub4<T1, T1> { static __device__ __forceinline__ void go(float (&)[16], LAS const unsigned char*, int) {} };

struct PreArgs { const bf16_t* P; const float *mu, *w0, *a0, *k_k, *k_a, *r_k; const bf16_t *w2t, *a2t, *g2t; bf16_t *Vo, *Go; float* RK; bf16_t *GST, *GYT; float *YLT, *SLT, *PEND; };

#define LBAR() asm volatile("s_waitcnt lgkmcnt(0)\n\ts_barrier" ::: "memory")
__device__ __forceinline__ void act_tile(LAS unsigned char* lds, const PreArgs& A, int b, int c, int tid) {
    const size_t row0 = (size_t)b * SEQ + c * CH; const bool seq0 = (c == 0);
    const int i8 = tid & 31, tr = tid >> 5, col = 1536 + 8 * i8;
    const float ka = i8 < 8 ? 2.f : 1.f, kc = i8 < 8 ? -1.f : 0.f; const bool ident = (i8 >= 8) && (i8 < 16);
    u32x4_t zc0[4], zp0[4];
#pragma unroll
    for (int k = 0; k < 4; ++k) { const int tt = tr + 16 * k; const bf16_t* rp = A.P + (row0 + tt) * NPROJ + col;
        zc0[k] = __builtin_nontemporal_load((const u32x4_t*)rp); zp0[k] = (u32x4_t){0u, 0u, 0u, 0u}; if (!(seq0 && tt == 0)) zp0[k] = __builtin_nontemporal_load((const u32x4_t*)(rp - NPROJ)); }
    const f32x4 m0a = *(const f32x4*)(A.mu + col), m0b = *(const f32x4*)(A.mu + col + 4);
#pragma unroll
    for (int k = 0; k < 4; ++k) { const int tt = tr + 16 * k; const u32x4_t zc = zc0[k], zp = zp0[k];
        float z[8] = {s5::blo(zc.x), s5::bhi(zc.x), s5::blo(zc.y), s5::bhi(zc.y), s5::blo(zc.z), s5::bhi(zc.z), s5::blo(zc.w), s5::bhi(zc.w)};
        const float zq[8] = {s5::blo(zp.x), s5::bhi(zp.x), s5::blo(zp.y), s5::bhi(zp.y), s5::blo(zp.z), s5::bhi(zp.z), s5::blo(zp.w), s5::bhi(zp.w)};
#pragma unroll
        for (int e = 0; e < 8; ++e) { const float mm = e < 4 ? m0a[e] : m0b[e - 4]; const float x = z[e] + (zq[e] - z[e]) * mm;
            const float sg = __builtin_amdgcn_rcpf(1.f + __expf(-ka * x));
            z[e] = ident ? x : ka * sg + kc; }
        u32x4_t o = {pk_bf16(z[0], z[1]), pk_bf16(z[2], z[3]), pk_bf16(z[4], z[5]), pk_bf16(z[6], z[7])};
        *(LAS u32x4_t*)(lds + L_ACT + tt * ACT_P + i8 * 16) = o; }
    LBAR();
}
__device__ __forceinline__ void load_lb(bf16x8 (&lb)[8][2], const PreArgs& A, int h, int tid) {
    asm volatile("" : "+v"(tid));
    const int lane = tid & 63, wv = __builtin_amdgcn_readfirstlane(tid >> 6), fr = lane & 15, q = lane >> 4, nh = wv >> 2;
#pragma unroll
    for (int s = 0; s < 8; ++s)
#pragma unroll
        for (int nn = 0; nn < 2; ++nn) { const unsigned ch = (unsigned)(64 * h + 16 * (2 * nh + nn) + fr);
            lb[s][nn] = s < 2 ? *(const bf16x8*)(A.w2t + (ch * 64u + (unsigned)(32 * s + 8 * q))) : s < 4 ? *(const bf16x8*)(A.a2t + (ch * 64u + (unsigned)(32 * (s - 2) + 8 * q))) : *(const bf16x8*)(A.g2t + (ch * 128u + (unsigned)(32 * (s - 4) + 8 * q))); }
}
__device__ __forceinline__ void load_z(u32x4_t (&zc)[3], u32x4_t (&zp)[3], const PreArgs& A, size_t row0, bool seq0, int h, int tid) {
    asm volatile("" : "+v"(tid));
    const int t = tid >> 3, j8 = tid & 7, ch0 = 64 * h + 8 * j8;
    const bf16_t* rb = A.P + row0 * NPROJ;
    const int o = t * NPROJ + ch0; const bool first = seq0 && t == 0;
#pragma unroll
    for (int part = 0; part < 3; ++part) { zc[part] = __builtin_nontemporal_load((const u32x4_t*)(rb + (o + 512 * part))); zp[part] = (u32x4_t){0u, 0u, 0u, 0u}; if (!first) zp[part] = __builtin_nontemporal_load((const u32x4_t*)(rb + (o + 512 * part - NPROJ))); }
}
__device__ __forceinline__ void unit_pre(LAS unsigned char* lds, const PreArgs& A, int u, int tid, bf16x8 (&lb)[8][2], u32x4_t (&zc1)[3], u32x4_t (&zp1)[3]) {
    asm volatile("" : "+v"(tid));
    const int lane = tid & 63, wv = __builtin_amdgcn_readfirstlane(tid >> 6), fr = lane & 15, q = lane >> 4;
    const int c = u & 63, h = (u >> 6) & 7, b = u >> 9;
    const size_t row0 = (size_t)b * SEQ + c * CH;
    const bool seq0 = (c == 0);
    const int t = tid >> 3, j8 = tid & 7, j0 = 8 * j8, ch0 = 64 * h + j0;
#ifdef PROBE_UP
    volatile LAS unsigned long long* ts_ = (volatile LAS unsigned long long*)(lds + 143360 + 2048); const bool pr_ = blockIdx.x == 0 && tid == 0; unsigned long long tp0_ = 0, tp1_ = 0;
    if (pr_) tp0_ = __builtin_amdgcn_s_memrealtime();
#endif
    { const int m = wv & 3, nh = wv >> 2; f32x4 aw[2] = {{0.f, 0.f, 0.f, 0.f}, {0.f, 0.f, 0.f, 0.f}}, aa[2] = {aw[0], aw[0]}, ag[2] = {aw[0], aw[0]};
#pragma unroll
      for (int s = 0; s < 8; ++s) { const bf16x8 af = ld8(lds + L_ACT + (16 * m + fr) * ACT_P + (32 * s + 8 * q) * 2);
#pragma unroll
          for (int nn = 0; nn < 2; ++nn) {
              if (s < 2) aw[nn] = MFMA16(af, lb[s][nn], aw[nn]); else if (s < 4) aa[nn] = MFMA16(af, lb[s][nn], aa[nn]); else ag[nn] = MFMA16(af, lb[s][nn], ag[nn]); } }
#pragma unroll
      for (int nn = 0; nn < 2; ++nn)
#pragma unroll
          for (int r = 0; r < 4; ++r) { const int off = ((16 * m + 4 * q + r) * LP + 16 * (2 * nh + nn) + fr) * 4;
              *(LAS float*)(lds + L_SW + off) = aw[nn][r]; *(LAS float*)(lds + L_SA + off) = aa[nn][r]; *(LAS float*)(lds + L_SG + off) = ag[nn][r]; } }
    LBAR();
    float r_[8], kp_[8], b_[8], an_[8], v_[8];
    { float lw[8], g_[8]; float ss = 0.f, rk = 0.f;
#pragma unroll
      for (int part = 0; part < 3; ++part) {
          const u32x4_t zc = zc1[part], zp = zp1[part]; const f32x4 m0 = *(const LAS f32x4*)(lds + L_CST + (512 * part + ch0) * 4), m1 = *(const LAS f32x4*)(lds + L_CST + (512 * part + ch0 + 4) * 4);
          const float z[8] = {s5::blo(zc.x), s5::bhi(zc.x), s5::blo(zc.y), s5::bhi(zc.y), s5::blo(zc.z), s5::bhi(zc.z), s5::blo(zc.w), s5::bhi(zc.w)};
          const float zq[8] = {s5::blo(zp.x), s5::bhi(zp.x), s5::blo(zp.y), s5::bhi(zp.y), s5::blo(zp.z), s5::bhi(zp.z), s5::blo(zp.w), s5::bhi(zp.w)};
#pragma unroll
          for (int e = 0; e < 8; ++e) { const float x = z[e] + (zq[e] - z[e]) * (e < 4 ? m0[e] : m1[e - 4]); if (part == 0) r_[e] = x; else if (part == 1) kp_[e] = x; else v_[e] = x; } }
      float kk[8];
      LAS const unsigned char* cst = lds + L_CST + (1536 + ch0) * 4;
      const f32x4 w0a = *(const LAS f32x4*)cst, w0b = *(const LAS f32x4*)(cst + 16), a0a = *(const LAS f32x4*)(cst + 2048), a0b = *(const LAS f32x4*)(cst + 2048 + 16);
      const f32x4 kka = *(const LAS f32x4*)(cst + 4096), kkb = *(const LAS f32x4*)(cst + 4096 + 16), kaa = *(const LAS f32x4*)(cst + 6144), kab = *(const LAS f32x4*)(cst + 6144 + 16);
      const f32x4 rka = *(const LAS f32x4*)(cst + 8192), rkb = *(const LAS f32x4*)(cst + 8192 + 16);
#pragma unroll
      for (int e = 0; e < 8; ++e) { const int off = (t * LP + j0 + e) * 4;
          const float sw = *(const LAS float*)(lds + L_SW + off), sa = *(const LAS float*)(lds + L_SA + off); g_[e] = *(const LAS float*)(lds + L_SG + off);
          const float xx = -((e < 4 ? w0a[e] : w0b[e - 4]) + sw);
          const float sp = fmaxf(xx, 0.f) + __logf(1.f + __expf(-fabsf(xx)));
          lw[e] = -__expf(-sp - 0.5f);
          const float a = pg8::sigm((e < 4 ? a0a[e] : a0b[e - 4]) + sa);
          const float k = kp_[e];
          kk[e] = k * (e < 4 ? kka[e] : kkb[e - 4]); ss += kk[e] * kk[e];
          kp_[e] = k * (1.f + (a - 1.f) * (e < 4 ? kaa[e] : kab[e - 4]));
          rk += r_[e] * kp_[e] * (e < 4 ? rka[e] : rkb[e - 4]);
          b_[e] = a; }
      ss = sum8(ss); rk = sum8(rk);
      const float rs = rsqrtf(fmaxf(ss, 1e-24f));
#pragma unroll
      for (int e = 0; e < 8; ++e) { const float kn = kk[e] * rs; an_[e] = -kn; b_[e] = kn * b_[e]; *(LAS float*)(lds + L_LW + (t * LP + j0 + e) * 4) = lw[e]; }
      if (j8 == 0) A.RK[(row0 + t) * 8 + h] = rk;
      u32x4_t ov = {pk_bf16(v_[0], v_[1]), pk_bf16(v_[2], v_[3]), pk_bf16(v_[4], v_[5]), pk_bf16(v_[6], v_[7])}, og = {pk_bf16(g_[0], g_[1]), pk_bf16(g_[2], g_[3]), pk_bf16(g_[4], g_[5]), pk_bf16(g_[6], g_[7])};
      *(u32x4_t*)(A.Vo + (row0 + t) * DR + ch0) = ov; *(u32x4_t*)(A.Go + (row0 + t) * DR + ch0) = og; }
    LBAR();
    { const int j = tid & 63, part = tid >> 6; float s = 0.f;
#pragma unroll
      for (int e = 0; e < 8; ++e) { LAS float* p = (LAS float*)(lds + L_LW + ((8 * part + e) * LP + j) * 4); s += *p; *p = s; }
      *(LAS float*)(lds + L_PART + (part * 64 + j) * 4) = s;
      LBAR();
      float o = 0.f;
      for (int pp = 0; pp < part; ++pp) o += *(const LAS float*)(lds + L_PART + (pp * 64 + j) * 4);
#pragma unroll
      for (int e = 0; e < 8; ++e) { LAS float* p = (LAS float*)(lds + L_LW + ((8 * part + e) * LP + j) * 4); *p += o; } }
    LBAR();
    { float lp[8], lpm[8], lpe[8];
#pragma unroll
      for (int e = 0; e < 8; ++e) { lp[e] = *(const LAS float*)(lds + L_LW + (t * LP + j0 + e) * 4); lpm[e] = t > 0 ? *(const LAS float*)(lds + L_LW + ((t - 1) * LP + j0 + e) * 4) : 0.f;
          lpe[e] = *(const LAS float*)(lds + L_LW + (63 * LP + j0 + e) * 4); }
      LBAR();
      float at[8], rt[8], bt[8], kt[8], bh[8], kh[8];
#pragma unroll
      for (int e = 0; e < 8; ++e) { const float Pt = __expf(lp[e]), Pm = __expf(lpm[e]), Pi = __expf(-lp[e]), Pe = __expf(lpe[e] - lp[e]);
          at[e] = an_[e] * Pm; rt[e] = r_[e] * Pt; bt[e] = b_[e] * Pi; kt[e] = kp_[e] * Pi; bh[e] = b_[e] * Pe; kh[e] = kp_[e] * Pe;
          if (t == 0) A.PEND[(size_t)u * 64 + j0 + e] = __expf(lpe[e]); }
      auto st8 = [&](int base, const float* x) { u32x4_t o = {pk_bf16(x[0], x[1]), pk_bf16(x[2], x[3]), pk_bf16(x[4], x[5]), pk_bf16(x[6], x[7])}; *(LAS u32x4_t*)(lds + base + t * PB + j0 * 2) = o; };
      st8(M_AT, at); st8(M_RT, rt); st8(M_BT, bt); st8(M_KT, kt);
#pragma unroll
      for (int e = 0; e < 8; ++e) { *(LAS bf16_t*)(lds + M_BH + (j0 + e) * PB + ((t * 2) ^ (j8 << 4))) = f2bf(bh[e]); *(LAS bf16_t*)(lds + M_KH + (j0 + e) * PB + ((t * 2) ^ (j8 << 4))) = f2bf(kh[e]); *(LAS bf16_t*)(lds + M_VT + (j0 + e) * PB + ((t * 2) ^ (j8 << 4))) = f2bf(v_[e]); } }
    LBAR();
#ifdef PROBE_UP
    if (pr_) { tp1_ = __builtin_amdgcn_s_memrealtime(); ts_[44] += tp1_ - tp0_; }
#endif
    { const int rt = wv >> 1;
#pragma unroll
      for (int cc = 0; cc < 2; ++cc) { const int ct = 2 * (wv & 1) + cc; f32x4 nab = {0.f, 0.f, 0.f, 0.f}, nak = nab;
#pragma unroll
          for (int kk = 0; kk < 2; ++kk) { const int ko = (32 * kk + 8 * q) * 2;
              const bf16x8 bfr = ld8(lds + M_AT + (16 * ct + fr) * PB + ko);
              nab = MFMA16(ld8(lds + M_BT + (16 * rt + fr) * PB + ko), bfr, nab); nak = MFMA16(ld8(lds + M_KT + (16 * rt + fr) * PB + ko), bfr, nak); }
          const int tt = 16 * ct + fr, s0 = 16 * rt + 4 * q;
#pragma unroll
          for (int r = 0; r < 4; ++r) { if (!(s0 + r < tt)) { nab[r] = 0.f; nak[r] = 0.f; } *(LAS bf16_t*)(lds + L_NAK + (s0 + r) * PB + tt * 2) = f2bf(nak[r]); }
#pragma unroll
          for (int r = 0; r < 4; ++r) *(LAS float*)(lds + L_NABT + tt * NAB_P + r * 64 + (4 * rt + q) * 4) = nab[r]; } }
    LBAR();
    for (int tl = wv; tl < 32; tl += 8) { const int mat = tl >> 4, rt = (tl >> 2) & 3, ct = tl & 3; f32x4 nn = {0.f, 0.f, 0.f, 0.f};
#pragma unroll
        for (int kk = 0; kk < 2; ++kk) { const int ko = (32 * kk + 8 * q) * 2;
            nn = MFMA16(ld8(lds + (mat ? M_KT : M_BT) + (16 * rt + fr) * PB + ko), ld8(lds + M_RT + (16 * ct + fr) * PB + ko), nn); }
        const int tt = 16 * ct + fr, s0 = 16 * rt + 4 * q;
#pragma unroll
        for (int r = 0; r < 4; ++r) if (!(s0 + r <= tt)) nn[r] = 0.f;
        u32x2_t o = {pk_bf16(nn[0], nn[1]), pk_bf16(nn[2], nn[3])};
        *(LAS u32x2_t*)(lds + (mat ? L_NKRT : L_NBRT) + tt * PB + s0 * 2) = o; }
    { const int R = tid >> 2, sub = tid & 3; float xq[16];
      if (wv < 4) {
#pragma unroll
          for (int i = 0; i < 16; ++i) xq[i] = bf2f(*(const LAS bf16_t*)(lds + M_AT + (4 * i + sub) * PB + R * 2));
      } else {
#pragma unroll
          for (int i = 0; i < 16; ++i) xq[i] = bf2f(*(const LAS bf16_t*)(lds + L_NAK + (R - 64) * PB + (4 * i + sub) * 2));
      }
      { LAS const unsigned char* nbq = lds + L_NABT + sub * 64; asm volatile("" : "+v"(nbq)); Sub4<0, 64>::go(xq, nbq, sub); }
      LBAR();
      if (wv < 4) {
#pragma unroll
          for (int i = 0; i < 16; ++i) *(LAS bf16_t*)(lds + M_W1 + R * PB + (4 * i + sub) * 2) = f2bf(xq[i]);
      } else {
#pragma unroll
          for (int i = 0; i < 16; ++i) *(LAS bf16_t*)(lds + M_M2T + (4 * i + sub) * PB + (R - 64) * 2) = f2bf(xq[i]);
      } }
    LBAR();
#ifdef PROBE_UP
    if (pr_) { tp0_ = __builtin_amdgcn_s_memrealtime(); ts_[45] += tp0_ - tp1_; }
#endif
    if (h + 1 < RH) { load_lb(lb, A, h + 1, tid); load_z(zc1, zp1, A, row0, seq0, h + 1, tid); }
    {
      const int cta = wv & 3, s = wv >> 2;
      f32x4 gy[2], gs[2];
#pragma unroll
      for (int hh = 0; hh < 2; ++hh) { const int rt = 2 * s + hh;
          const u32x2_t rr = *(const LAS u32x2_t*)(lds + M_RT + (16 * cta + fr) * PB + (16 * rt + 4 * q) * 2);
          gy[hh] = (f32x4){s5::blo(rr.x), s5::bhi(rr.x), s5::blo(rr.y), s5::bhi(rr.y)}; gs[hh] = (f32x4){0.f, 0.f, 0.f, 0.f};
#pragma unroll
          for (int kk = 0; kk < 2; ++kk) { const int ko = (32 * kk + 8 * q) * 2; const bf16x8 w1 = ld8(lds + M_W1 + (16 * rt + fr) * PB + ko);
              gy[hh] = MFMA16(w1, ld8(lds + L_NBRT + (16 * cta + fr) * PB + ko), gy[hh]);
              gs[hh] = MFMA16(w1, ld8(lds + M_BH + (16 * cta + fr) * PB + (ko ^ tsw(16 * cta + fr))), gs[hh]); } }
      *(bf16x8*)(A.GYT + (size_t)u * 4096 + ((cta * 2 + s) * 64 + lane) * 8) = acc2b(gy[0], gy[1]);
      *(bf16x8*)(A.GST + (size_t)u * 4096 + ((cta * 2 + s) * 64 + lane) * 8) = acc2b(gs[0], gs[1]); }
    {
      const int vi = wv & 3, mh = wv >> 2;
      f32x4 vw[4];
#pragma unroll
      for (int rt = 0; rt < 4; ++rt) { vw[rt] = (f32x4){0.f, 0.f, 0.f, 0.f};
#pragma unroll
          for (int kk = 0; kk < 2; ++kk) { const int ko = (32 * kk + 8 * q) * 2; vw[rt] = MFMA16(ld8(lds + M_M2T + (16 * rt + fr) * PB + ko), ld8(lds + M_VT + (16 * vi + fr) * PB + (ko ^ tsw(16 * vi + fr))), vw[rt]); } }
      const bf16x8 vb0 = acc2b(vw[0], vw[1]), vb1 = acc2b(vw[2], vw[3]);
#pragma unroll
      for (int hh = 0; hh < 2; ++hh) { const int m = 2 * mh + hh; f32x4 yl = {0.f, 0.f, 0.f, 0.f}, sl = yl;
          LAS const unsigned char* nb = lds + L_NBRT + (16 * m + fr) * PB; LAS const unsigned char* bhp = lds + M_BH + (16 * m + fr) * PB;
          yl = MFMA16(ld44(nb + (4 * q) * 2, nb + (16 + 4 * q) * 2), vb0, yl); yl = MFMA16(ld44(nb + (32 + 4 * q) * 2, nb + (48 + 4 * q) * 2), vb1, yl);
          { const int zs = tsw(16 * m + fr); sl = MFMA16(ld44(bhp + (((4 * q) * 2) ^ zs), bhp + (((16 + 4 * q) * 2) ^ zs)), vb0, sl); sl = MFMA16(ld44(bhp + (((32 + 4 * q) * 2) ^ zs), bhp + (((48 + 4 * q) * 2) ^ zs)), vb1, sl); }
#pragma unroll
          for (int kk = 0; kk < 2; ++kk) { const int ko = (32 * kk + 8 * q) * 2; const bf16x8 vf = ld8(lds + M_VT + (16 * vi + fr) * PB + (ko ^ tsw(16 * vi + fr)));
              yl = MFMA16(ld8(lds + L_NKRT + (16 * m + fr) * PB + ko), vf, yl); sl = MFMA16(ld8(lds + M_KH + (16 * m + fr) * PB + (ko ^ tsw(16 * m + fr))), vf, sl); }
          { u32x2_t o = {pk_bf16(yl[0], yl[1]), pk_bf16(yl[2], yl[3])}; *(u32x2_t*)((bf16_t*)A.YLT + (size_t)u * 4096 + ((vi * 4 + m) * 64 + lane) * 4) = o; }
          { u32x2_t o = {pk_bf16(sl[0], sl[1]), pk_bf16(sl[2], sl[3])}; *(u32x2_t*)((bf16_t*)A.SLT + (size_t)u * 4096 + ((vi * 4 + m) * 64 + lane) * 4) = o; } } }
    LBAR();
}

__device__ __forceinline__ void seq(const bf16_t* __restrict__ GST, const bf16_t* __restrict__ GYT, const float* __restrict__ YLT, const float* __restrict__ SLT, const float* __restrict__ PEND,
                                    float* __restrict__ YRAW, int bh, int vi, int lane) {
    const int fr = lane & 15, q = lane >> 4, b = bh >> 3, h = bh & 7;
    f32x4 st[4] = {{0.f, 0.f, 0.f, 0.f}, {0.f, 0.f, 0.f, 0.f}, {0.f, 0.f, 0.f, 0.f}, {0.f, 0.f, 0.f, 0.f}};
    for (int c = 0; c < NCHK; ++c) {
        const size_t u = (size_t)bh * 64 + c;
        bf16x8 gs[4][2], gy[4][2]; f32x4 pe[4], sl[4], yl[4];
#pragma unroll
        for (int a = 0; a < 4; ++a) {
#pragma unroll
            for (int s = 0; s < 2; ++s) { gs[a][s] = *(const bf16x8*)(GST + u * 4096 + ((a * 2 + s) * 64 + lane) * 8); gy[a][s] = *(const bf16x8*)(GYT + u * 4096 + ((a * 2 + s) * 64 + lane) * 8); }
            pe[a] = *(const f32x4*)(PEND + u * 64 + 16 * a + 4 * q);
            sl[a] = *(const f32x4*)(SLT + u * 4096 + ((vi * 4 + a) * 64 + lane) * 4); yl[a] = *(const f32x4*)(YLT + u * 4096 + ((vi * 4 + a) * 64 + lane) * 4); }
        const bf16x8 sb0 = acc2b(st[0], st[1]), sb1 = acc2b(st[2], st[3]);
#pragma unroll
        for (int m = 0; m < 4; ++m) { f32x4 y = MFMA16(gy[m][0], sb0, yl[m]); y = MFMA16(gy[m][1], sb1, y);
#pragma unroll
            for (int r = 0; r < 4; ++r) YRAW[((size_t)b * SEQ + c * CH + 16 * m + 4 * q + r) * DR + h * 64 + 16 * vi + fr] = y[r]; }
#pragma unroll
        for (int a = 0; a < 4; ++a) { f32x4 n = sl[a] + pe[a] * st[a]; n = MFMA16(gs[a][0], sb0, n); n = MFMA16(gs[a][1], sb1, n); st[a] = n; }
    }
}
#ifdef PROBE_SQ
#define SQP0() unsigned long long sq0_ = 0, sq1_ = 0; const bool sqp_ = blockIdx.x == 0 && tid == PROBE_SQ_TID; if (sqp_) sq0_ = __builtin_amdgcn_s_memrealtime()
#define SQP1() if (sqp_) { sq1_ = __builtin_amdgcn_s_memrealtime(); ((volatile LAS unsigned long long*)(lds + 143360 + 2048))[54] += sq1_ - sq0_; }
#define SQP2() if (sqp_) { ((volatile LAS unsigned long long*)(lds + 143360 + 2048))[55] += __builtin_amdgcn_s_memrealtime() - sq1_; }
#else
#define SQP0()
#define SQP1()
#define SQP2()
#endif
struct SetG { bf16x8 g[4][2]; u32x2_t locp[4]; };
__device__ __forceinline__ void load_set(SetG& z, bool state, const bf16_t* __restrict__ GST, const bf16_t* __restrict__ GYT, const float* __restrict__ YLT, const float* __restrict__ SLT, size_t u_, int vi, int lane) {
    const unsigned u = (unsigned)u_;
    asm volatile("" : "+v"(lane));
    const bf16_t* gp = state ? GST : GYT; const bf16_t* lp = (const bf16_t*)(state ? SLT : YLT);
#pragma unroll
    for (int a = 0; a < 4; ++a) {
#pragma unroll
        for (int s = 0; s < 2; ++s) z.g[a][s] = __builtin_nontemporal_load((const bf16x8*)(gp + (u * 4096u + (unsigned)(((a * 2 + s) * 64 + lane) * 8))));
        z.locp[a] = __builtin_nontemporal_load((const u32x2_t*)(lp + (u * 4096u + (unsigned)(((vi * 4 + a) * 64 + lane) * 4)))); }
}
__device__ __forceinline__ f32x4 unpk4(const u32x2_t w) { return (f32x4){s5::blo(w.x), s5::bhi(w.x), s5::blo(w.y), s5::bhi(w.y)}; }
struct PostArgs { const bf16_t* V; const bf16_t* GG; const float* RK; const float* ln_w; const float* ln_b; bf16_t* YA; };
struct PostIn { u32x4_t pv, pg; float rk; };
__device__ __forceinline__ void seq2(LAS unsigned char* lds, const bf16_t* __restrict__ GST, const bf16_t* __restrict__ GYT, const float* __restrict__ YLT, const float* __restrict__ SLT,
                                     const float* __restrict__ PEND, const PostArgs& PA, int bh, int tid) {
    const int lane = tid & 63, wv = __builtin_amdgcn_readfirstlane(tid >> 6), fr = lane & 15, q = lane >> 4, b = bh >> 3, h = bh & 7;
    const bool state = wv < 4; const int vi = wv & 3;
    f32x4 st[4] = {{0.f, 0.f, 0.f, 0.f}, {0.f, 0.f, 0.f, 0.f}, {0.f, 0.f, 0.f, 0.f}, {0.f, 0.f, 0.f, 0.f}};
    SetG z0, z1;
    const size_t u0 = (size_t)bh * 64;
    load_set(z0, state, GST, GYT, YLT, SLT, u0, vi, lane);
    LAS float* ybuf = (LAS float*)(lds + 16384); LAS float* pend = (LAS float*)(lds + 33280);
    { const f32x4 a = *(const f32x4*)(PEND + u0 * 64 + tid * 8), c4 = *(const f32x4*)(PEND + u0 * 64 + tid * 8 + 4); *(LAS f32x4*)(pend + tid * 8) = a; *(LAS f32x4*)(pend + tid * 8 + 4) = c4; }
    const int pt = tid >> 3, pj0 = 8 * (tid & 7), pch = h * 64 + pj0;
    PostIn pi0, pi1;
    const f32x4 lwa = *(const f32x4*)(PA.ln_w + pch), lwb = *(const f32x4*)(PA.ln_w + pch + 4), lba = *(const f32x4*)(PA.ln_b + pch), lbb = *(const f32x4*)(PA.ln_b + pch + 4);
    { const unsigned prow0 = (unsigned)(b * SEQ + pt), poff0 = prow0 * DR + pch; pi0.pv = *(const u32x4_t*)(PA.V + poff0); pi0.pg = *(const u32x4_t*)(PA.GG + poff0); pi0.rk = PA.RK[prow0 * 8 + h]; }
#define WKV_POST(cc, PP) do {   \
        const unsigned prow = (unsigned)(b * SEQ + (cc) * CH + pt), poff = prow * DR + pch; \
        const u32x4_t pv = PP.pv, pg = PP.pg; const float prk = PP.rk; \
        float yv[8]; float s_ = 0.f; \
        _Pragma("unroll") for (int e = 0; e < 8; ++e) { yv[e] = ybuf[pt * 65 + pj0 + e]; s_ += yv[e]; } \
        const float mean_ = sum8(s_) * (1.f / 64.f); float q2_ = 0.f; \
        _Pragma("unroll") for (int e = 0; e < 8; ++e) { yv[e] -= mean_; q2_ += yv[e] * yv[e]; } \
        const float rstd_ = rsqrtf(sum8(q2_) * (1.f / 64.f) + GN_EPS); \
        const float vv[8] = {s5::blo(pv.x), s5::bhi(pv.x), s5::blo(pv.y), s5::bhi(pv.y), s5::blo(pv.z), s5::bhi(pv.z), s5::blo(pv.w), s5::bhi(pv.w)}; \
        const float gg[8] = {s5::blo(pg.x), s5::bhi(pg.x), s5::blo(pg.y), s5::bhi(pg.y), s5::blo(pg.z), s5::bhi(pg.z), s5::blo(pg.w), s5::bhi(pg.w)}; \
        float o_[8]; \
        _Pragma("unroll") for (int e = 0; e < 8; ++e) o_[e] = (yv[e] * rstd_ * (e < 4 ? lwa[e] : lwb[e - 4]) + (e < 4 ? lba[e] : lbb[e - 4]) + prk * vv[e]) * gg[e]; \
        u32x4_t ow = {pk_bf16(o_[0], o_[1]), pk_bf16(o_[2], o_[3]), pk_bf16(o_[4], o_[5]), pk_bf16(o_[6], o_[7])}; \
        *(u32x4_t*)(PA.YA + poff) = ow; \
        } while (0)
#define WKV_STEP(c, ZC, ZN2, PC, PN) do {   \
        SQP0(); \
        LAS unsigned char* slot = lds + (((c) & 1) * 4 + vi) * 2048 + lane * 16; \
        bf16x8 sb0, sb1; \
        if (state) { sb0 = acc2b(st[0], st[1]); sb1 = acc2b(st[2], st[3]); *(LAS bf16x8*)slot = sb0; *(LAS bf16x8*)(slot + 1024) = sb1; } \
        if ((c) + 1 < NCHK) load_set(ZN2, state, GST, GYT, YLT, SLT, u0 + (c) + 1, vi, lane); \
        if ((c) > 0) WKV_POST((c) - 1, PN); \
        if ((c) + 1 < NCHK) { const unsigned prow1 = (unsigned)(b * SEQ + ((c) + 1) * CH + pt), poff1 = prow1 * DR + pch;     \
            PN.pv = __builtin_nontemporal_load((const u32x4_t*)(PA.V + poff1)); PN.pg = __builtin_nontemporal_load((const u32x4_t*)(PA.GG + poff1)); PN.rk = PA.RK[prow1 * 8 + h]; } \
        LDS_BARRIER(); SQP1(); \
        if (state) { \
            _Pragma("unroll") for (int a = 0; a < 4; ++a) { const f32x4 pe = *(const LAS f32x4*)(pend + (c) * 64 + 16 * a + 4 * q); \
                f32x4 n = unpk4(ZC.locp[a]) + pe * st[a]; n = MFMA16(ZC.g[a][0], sb0, n); n = MFMA16(ZC.g[a][1], sb1, n); st[a] = n; } \
        } else { \
            sb0 = *(const LAS bf16x8*)slot; sb1 = *(const LAS bf16x8*)(slot + 1024); \
            int fr_ = fr, q_ = q; asm volatile("" : "+v"(fr_), "+v"(q_)); \
            _Pragma("unroll") for (int m = 0; m < 4; ++m) { f32x4 y = MFMA16(ZC.g[m][0], sb0, unpk4(ZC.locp[m])); y = MFMA16(ZC.g[m][1], sb1, y); \
                _Pragma("unroll") for (int r = 0; r < 4; ++r) ybuf[(16 * m + 4 * q_ + r) * 65 + 16 * vi + fr_] = y[r]; } \
        } \
        LDS_BARRIER(); SQP2(); \
        } while (0)
    for (int c = 0; c < NCHK; c += 2) { WKV_STEP(c, z0, z1, pi0, pi1); WKV_STEP(c + 1, z1, z0, pi1, pi0); }
    WKV_POST(NCHK - 1, pi1);
#undef WKV_POST
#undef WKV_STEP
    __syncthreads();
}
__device__ __forceinline__ void post(int t, int c, const float* __restrict__ YRAW, const bf16_t* __restrict__ V, const bf16_t* __restrict__ GG, const float* __restrict__ RK,
                                     const float* __restrict__ ln_w, const float* __restrict__ ln_b, bf16_t* __restrict__ YA) {
    const size_t o = (size_t)t * DR + c;
    const float y = YRAW[o];
    const float mean = wave_allsum(y) * (1.f / 64.f);
    const float dv = y - mean;
    const float var = wave_allsum(dv * dv) * (1.f / 64.f);
    const float yn = dv * rsqrtf(var + GN_EPS) * ln_w[c] + ln_b[c];
    YA[o] = f2bf((yn + RK[(size_t)t * 8 + (c >> 6)] * bf2f(V[o])) * bf2f(GG[o]));
}
}

namespace rt {
__device__ __forceinline__ void ln1route8(int row0, int lane, const float* __restrict__ S, const float* __restrict__ lw, const float* __restrict__ lb, float* __restrict__ X, bf16_t* __restrict__ XN,
        const float* __restrict__ RTW, const float* __restrict__ gb, const float* __restrict__ eb, unsigned* __restrict__ cnt, int* __restrict__ EID, int* __restrict__ POS, float* __restrict__ WGT, LAS float* lg  ) {
    f32x4 v[8][4];
#pragma unroll
    for (int i = 0; i < 8; ++i) { float s = 0.f;
#pragma unroll
        for (int k = 0; k < 4; ++k) { v[i][k] = *(const f32x4*)(S + (size_t)(row0 + i) * D + 256 * k + 4 * lane); s += (v[i][k][0] + v[i][k][1]) + (v[i][k][2] + v[i][k][3]); }
        const float mean = wave_allsum(s) * (1.f / D); float q = 0.f;
#pragma unroll
        for (int k = 0; k < 4; ++k) { v[i][k] -= mean; q += (v[i][k][0] * v[i][k][0] + v[i][k][1] * v[i][k][1]) + (v[i][k][2] * v[i][k][2] + v[i][k][3] * v[i][k][3]); }
        const float rstd = rsqrtf(wave_allsum(q) * (1.f / D) + LN_EPS);
#pragma unroll
        for (int k = 0; k < 4; ++k) { const f32x4 w4 = *(const f32x4*)(lw + 256 * k + 4 * lane), b4 = *(const f32x4*)(lb + 256 * k + 4 * lane);
            v[i][k] = v[i][k] * rstd * w4 + b4;
            *(f32x4*)(X + (size_t)(row0 + i) * D + 256 * k + 4 * lane) = v[i][k];
            u32x2_t_ o = {att::pk_bf16(v[i][k][0], v[i][k][1]), att::pk_bf16(v[i][k][2], v[i][k][3])};
            *(u32x2_t_*)(XN + (size_t)(row0 + i) * D + 256 * k + 4 * lane) = o; } }
    for (int j = 0; j < 36; ++j) { f32x4 w[4];
#pragma unroll
        for (int k = 0; k < 4; ++k) w[k] = *(const f32x4*)(RTW + j * 1024 + 256 * k + 4 * lane);
#pragma unroll
        for (int i = 0; i < 8; ++i) { float a = 0.f;
#pragma unroll
            for (int k = 0; k < 4; ++k) a += (v[i][k][0] * w[k][0] + v[i][k][1] * w[k][1]) + (v[i][k][2] * w[k][2] + v[i][k][3] * w[k][3]);
            a = wave_allsum(a); if (lane == 0) lg[i * 40 + j] = a; } }
    asm volatile("s_waitcnt lgkmcnt(0)" ::: "memory");
    if (lane < 8) { const LAS float* l8 = lg + lane * 40; const int t = row0 + lane;
        int gs = 0; float gm = l8[0] + gb[0];
        for (int j = 1; j < 4; ++j) { const float x = l8[j] + gb[j]; if (x > gm) { gm = x; gs = j; } }
        float den = 0.f;
        for (int j = 0; j < 4; ++j) den += __expf(l8[j] + gb[j] - gm);
        const float pg = 1.f / den;
        int i0 = 0; float m0 = l8[4 + gs * 8] + eb[gs * 8];
        for (int j = 1; j < 8; ++j) { const float x = l8[4 + gs * 8 + j] + eb[gs * 8 + j]; if (x > m0) { m0 = x; i0 = j; } }
        int i1 = -1; float m1 = 0.f;
        for (int j = 0; j < 8; ++j) { const float x = l8[4 + gs * 8 + j] + eb[gs * 8 + j]; if (j != i0 && (i1 < 0 || x > m1)) { m1 = x; i1 = j; } }
        const float e1 = __expf(m1 - m0);
        const float p0 = 1.f / (1.f + e1), p1 = e1 / (1.f + e1);
        const int ex0 = gs * 8 + i0, ex1 = gs * 8 + i1;
        EID[t * 2] = ex0; EID[t * 2 + 1] = ex1;
        WGT[t * 2] = pg * p0; WGT[t * 2 + 1] = pg * p1;
        POS[t * 2] = (int)atomicAdd(&cnt[ex0], 1u);
        POS[t * 2 + 1] = (int)atomicAdd(&cnt[ex1], 1u); }
}
__device__ __forceinline__ void ln1route_phase(LAS unsigned char* lds, const float* __restrict__ S, const float* __restrict__ lw, const float* __restrict__ lb, float* __restrict__ X, bf16_t* __restrict__ XN,
        const float* __restrict__ RTW, const float* __restrict__ gb, const float* __restrict__ eb, unsigned* __restrict__ cnt, int* __restrict__ EID, int* __restrict__ POS, float* __restrict__ WGT, unsigned* __restrict__ TOKS, int tid, int bid, int G) {
    constexpr int XP = 1028;
    LAS float* xt = (LAS float*)lds; LAS float* part = (LAS float*)(lds + 16 * XP * 4); LAS float* lgs = part + 8 * 16 * 48;
    const int lane = tid & 63, wv = __builtin_amdgcn_readfirstlane(tid >> 6), fr = lane & 15, q = lane >> 4;
    float bw[3][32];
#pragma unroll
    for (int ct = 0; ct < 3; ++ct)
#pragma unroll
        for (int ks = 0; ks < 32; ++ks) bw[ct][ks] = RTW[((wv * 32 + ks) * 3 + ct) * 64 + lane];
    f32x4 vn[2][4];
    if (bid < T / 16) {
#pragma unroll
        for (int i = 0; i < 2; ++i)
#pragma unroll
            for (int k = 0; k < 4; ++k) vn[i][k] = __builtin_nontemporal_load((const f32x4*)(S + (size_t)(bid * 16 + 2 * wv + i) * D + 4 * lane + 256 * k)); }
    int dt = -1, de0 = 0, de1 = 0, dp0 = 0, dp1 = 0;
    for (int tl = bid; tl < T / 16; tl += G) {
        const int row0 = tl * 16;
        f32x4 vc[2][4];
#pragma unroll
        for (int i = 0; i < 2; ++i)
#pragma unroll
            for (int k = 0; k < 4; ++k) vc[i][k] = vn[i][k];
        if (tl + G < T / 16) {
#pragma unroll
            for (int i = 0; i < 2; ++i)
#pragma unroll
                for (int k = 0; k < 4; ++k) vn[i][k] = __builtin_nontemporal_load((const f32x4*)(S + (size_t)((tl + G) * 16 + 2 * wv + i) * D + 4 * lane + 256 * k)); }
#pragma unroll
        for (int i = 0; i < 2; ++i) { const int r = 2 * wv + i; f32x4 v[4]; float s = 0.f;
#pragma unroll
            for (int k = 0; k < 4; ++k) { v[k] = vc[i][k]; s += (v[k][0] + v[k][1]) + (v[k][2] + v[k][3]); }
            const float mean = wave_allsum(s) * (1.f / D); float qq = 0.f;
#pragma unroll
            for (int k = 0; k < 4; ++k) { v[k] -= mean; qq += (v[k][0] * v[k][0] + v[k][1] * v[k][1]) + (v[k][2] * v[k][2] + v[k][3] * v[k][3]); }
            const float rstd = rsqrtf(wave_allsum(qq) * (1.f / D) + LN_EPS);
#pragma unroll
            for (int k = 0; k < 4; ++k) { const f32x4 w4 = *(const f32x4*)(lw + 256 * k + 4 * lane), b4 = *(const f32x4*)(lb + 256 * k + 4 * lane);
                v[k] = v[k] * rstd * w4 + b4;
                u32x2_t_ o = {att::pk_bf16(v[k][0], v[k][1]), att::pk_bf16(v[k][2], v[k][3])};
                *(u32x2_t_*)(XN + (size_t)(row0 + r) * D + 256 * k + 4 * lane) = o;
                *(LAS f32x4*)(xt + r * XP + 256 * k + 4 * lane) = v[k]; } }
        asm volatile("s_waitcnt lgkmcnt(0)\n\ts_barrier" ::: "memory");
        f32x4 acc[3] = {{0.f, 0.f, 0.f, 0.f}, {0.f, 0.f, 0.f, 0.f}, {0.f, 0.f, 0.f, 0.f}};
#pragma unroll
        for (int ks = 0; ks < 32; ++ks) { const float a = xt[fr * XP + 128 * wv + 4 * ks + q];
#pragma unroll
            for (int ct = 0; ct < 3; ++ct) acc[ct] = __builtin_amdgcn_mfma_f32_16x16x4f32(a, bw[ct][ks], acc[ct], 0, 0, 0); }
#pragma unroll
        for (int ct = 0; ct < 3; ++ct)
#pragma unroll
            for (int r = 0; r < 4; ++r) part[(wv * 16 + 4 * q + r) * 48 + 16 * ct + fr] = acc[ct][r];
        asm volatile("s_waitcnt lgkmcnt(0)\n\ts_barrier" ::: "memory");
        for (int e = tid; e < 16 * 36; e += 512) { const int tk = e / 36, j = e % 36; float s = 0.f;
#pragma unroll
            for (int w8 = 0; w8 < 8; ++w8) s += part[(w8 * 16 + tk) * 48 + j];
            lgs[tk * 40 + j] = s; }
        asm volatile("s_waitcnt lgkmcnt(0)\n\ts_barrier" ::: "memory");
        if (tid < 16) { const LAS float* l8 = lgs + tid * 40; const int t = row0 + tid;
            int gs = 0; float gm = l8[0] + gb[0];
            for (int j = 1; j < 4; ++j) { const float x = l8[j] + gb[j]; if (x > gm) { gm = x; gs = j; } }
            float den = 0.f;
            for (int j = 0; j < 4; ++j) den += __expf(l8[j] + gb[j] - gm);
            const float pg = 1.f / den;
            int i0 = 0; float m0 = l8[4 + gs * 8] + eb[gs * 8];
            for (int j = 1; j < 8; ++j) { const float x = l8[4 + gs * 8 + j] + eb[gs * 8 + j]; if (x > m0) { m0 = x; i0 = j; } }
            int i1 = -1; float m1 = 0.f;
            for (int j = 0; j < 8; ++j) { const float x = l8[4 + gs * 8 + j] + eb[gs * 8 + j]; if (j != i0 && (i1 < 0 || x > m1)) { m1 = x; i1 = j; } }
            const float e1 = __expf(m1 - m0);
            const float p0 = 1.f / (1.f + e1), p1 = e1 / (1.f + e1);
            const int ex0 = gs * 8 + i0, ex1 = gs * 8 + i1;
            EID[t * 2] = ex0; EID[t * 2 + 1] = ex1;
            WGT[t * 2] = pg * p0; WGT[t * 2 + 1] = pg * p1;
            if (dt >= 0) { POS[dt * 2] = dp0; POS[dt * 2 + 1] = dp1; TOKS[(size_t)de0 * T + dp0] = (unsigned)dt; TOKS[(size_t)de1 * T + dp1] = (unsigned)dt; }
            dp0 = (int)atomicAdd(&cnt[ex0 * 64], 1u); dp1 = (int)atomicAdd(&cnt[ex1 * 64], 1u); dt = t; de0 = ex0; de1 = ex1; }
        asm volatile("s_waitcnt lgkmcnt(0)\n\ts_barrier" ::: "memory");
    }
    if (tid < 16 && dt >= 0) { POS[dt * 2] = dp0; POS[dt * 2 + 1] = dp1; TOKS[(size_t)de0 * T + dp0] = (unsigned)dt; TOKS[(size_t)de1 * T + dp1] = (unsigned)dt; }
}
template <bool LAST> __device__ __forceinline__ void ln2_row(int t, int lane, const bf16_t* __restrict__ YG, const LAS int* offs, const int* __restrict__ EID, const int* __restrict__ POS, const float* __restrict__ WGT, const float* __restrict__ lw, const float* __restrict__ lb,
                                                          float* __restrict__ X, bf16_t* __restrict__ XN) {
    const int s0 = offs[EID[t * 2]] + POS[t * 2], s1 = offs[EID[t * 2 + 1]] + POS[t * 2 + 1]; const float w0 = WGT[t * 2], w1 = WGT[t * 2 + 1];
    f32x4 v[4]; float s = 0.f;
#pragma unroll
    for (int k = 0; k < 4; ++k) { const int c = 256 * k + 4 * lane;
        const u32x2_t_ a = __builtin_nontemporal_load((const u32x2_t_*)(YG + (size_t)s0 * D + c)), b = __builtin_nontemporal_load((const u32x2_t_*)(YG + (size_t)s1 * D + c)), x = *(const u32x2_t_*)(XN + (size_t)t * D + c);
        v[k][0] = ALPHA * s5::blo(x.x) + (s5::blo(a.x) * w0 + s5::blo(b.x) * w1); v[k][1] = ALPHA * s5::bhi(x.x) + (s5::bhi(a.x) * w0 + s5::bhi(b.x) * w1);
        v[k][2] = ALPHA * s5::blo(x.y) + (s5::blo(a.y) * w0 + s5::blo(b.y) * w1); v[k][3] = ALPHA * s5::bhi(x.y) + (s5::bhi(a.y) * w0 + s5::bhi(b.y) * w1);
        s += (v[k][0] + v[k][1]) + (v[k][2] + v[k][3]); }
    const float mean = wave_allsum(s) * (1.f / D); float q = 0.f;
#pragma unroll
    for (int k = 0; k < 4; ++k) { v[k] -= mean; q += (v[k][0] * v[k][0] + v[k][1] * v[k][1]) + (v[k][2] * v[k][2] + v[k][3] * v[k][3]); }
    const float rstd = rsqrtf(wave_allsum(q) * (1.f / D) + LN_EPS);
#pragma unroll
    for (int k = 0; k < 4; ++k) { const int c = 256 * k + 4 * lane; const f32x4 w4 = *(const f32x4*)(lw + c), b4 = *(const f32x4*)(lb + c);
        const f32x4 o = v[k] * rstd * w4 + b4;
        if (LAST) *(f32x4*)(X + (size_t)t * D + c) = o;
        else { u32x2_t_ ob = {att::pk_bf16(o[0], o[1]), att::pk_bf16(o[2], o[3])}; *(u32x2_t_*)(XN + (size_t)t * D + c) = ob; } }
}
__device__ __forceinline__ void kmean_task(LAS unsigned char* lds, const bf16_t* __restrict__ P, float* __restrict__ KM, float* __restrict__ KN, int task, int tid) {
    const int lane = tid & 63, wave = tid >> 6, rs = lane >> 3, chn = lane & 7;
    const int n = task & 15, h = (task >> 4) & 7, b = task >> 7;
    const bf16_t* src = P + ((size_t)b * SEQ + n * MBLK + wave * 32 + rs) * NPROJ + OFF_MOBA + 512 + h * 64 + chn * 8;
    float a[8] = {0.f, 0.f, 0.f, 0.f, 0.f, 0.f, 0.f, 0.f}; float n2max = 0.f;
#pragma unroll
    for (int k = 0; k < 4; ++k) { const u32x4_t z = *(const u32x4_t*)(src + (size_t)(8 * k) * NPROJ);
        const float v[8] = {s5::blo(z.x), s5::bhi(z.x), s5::blo(z.y), s5::bhi(z.y), s5::blo(z.z), s5::bhi(z.z), s5::blo(z.w), s5::bhi(z.w)}; float q2 = 0.f;
#pragma unroll
        for (int e = 0; e < 8; ++e) { a[e] += v[e]; q2 += v[e] * v[e]; }
        n2max = fmaxf(n2max, wkv::sum8(q2)); }
    LAS float* part = (LAS float*)lds;
    LAS float* pmax = (LAS float*)(lds + 16384);
#pragma unroll
    for (int e = 0; e < 8; ++e) part[(wave * 8 + rs) * 64 + chn * 8 + e] = a[e];
    pmax[tid] = n2max;
    __syncthreads();
    if (tid < 64) { float s = 0.f, m = 0.f;
#pragma unroll 8
        for (int i = 0; i < 64; ++i) s += part[i * 64 + tid];
#pragma unroll
        for (int i = 0; i < 8; ++i) m = fmaxf(m, pmax[tid * 8 + i]);
        m = wave_allmax(m);
        KM[(size_t)task * 64 + tid] = s * (1.f / MBLK);
        if (tid == 0) KN[task] = sqrtf(m); }
    __syncthreads();
}
__device__ __forceinline__ void gather_phase(LAS unsigned char* lds, const bf16_t* __restrict__ XN, const unsigned* __restrict__ cnt, const int* __restrict__ EID, const int* __restrict__ POS,
                                             int* __restrict__ SLOT, bf16_t* __restrict__ XG, int tid, int bid, int G) {
    LAS int* offs = (LAS int*)lds;
    if (tid == 0) { int o = 0;
#pragma unroll 1
        for (int e = 0; e < NE; ++e) { offs[e] = o; o += ((int)cnt[e * 64] + 255) & ~255; } }
    __syncthreads();
    const int lane = tid & 63, wave = tid >> 6;
    for (int t = bid * 8 + wave; t < T; t += G * 8) {
        const u32x4_t a = *(const u32x4_t*)(XN + (size_t)t * D + lane * 8), b = *(const u32x4_t*)(XN + (size_t)t * D + 512 + lane * 8);
#pragma unroll
        for (int k = 0; k < 2; ++k) { const int slot = offs[EID[t * 2 + k]] + POS[t * 2 + k];
            if (lane == 0) SLOT[t * 2 + k] = slot;
            *(u32x4_t*)(XG + (size_t)slot * D + lane * 8) = a; *(u32x4_t*)(XG + (size_t)slot * D + 512 + lane * 8) = b; } }
    __syncthreads();
}
__device__ __forceinline__ void slot_phase(LAS unsigned char* lds, const unsigned* __restrict__ cnt, const int* __restrict__ EID, const int* __restrict__ POS, int* __restrict__ SLOT, unsigned* __restrict__ TOK, int tid, int bid, int G) {
    LAS int* offs = (LAS int*)lds;
    if (tid == 0) { int o = 0;
#pragma unroll 1
        for (int e = 0; e < NE; ++e) { offs[e] = o; o += ((int)cnt[e * 64] + 255) & ~255; } }
    __syncthreads();
    for (int i = bid * 512 + tid; i < T * 2; i += G * 512) { const int slot = offs[EID[i]] + POS[i]; SLOT[i] = slot; TOK[slot] = (unsigned)(i >> 1); }
    __syncthreads();
}
}

constexpr int RING_BYTES = 131072;
constexpr int MISC_OFF = 143360;
constexpr int LDS_BYTES = 163840;

struct Args { const float* in[39]; float* out; unsigned char* ws; };
__device__ __forceinline__ int lnd(int v) { asm volatile("" : "+s"(v)); return v; }
#ifdef GEMM_ONLY
#define VBL(nvb, vbsz) for (int vb = 0, vt = 0; vb < 0;)
#else
#define VBL(nvb, vbsz) for (int _t = otid(c.wv), _g = lnd((int)gridDim.x), vb = lnd((int)blockIdx.x) * (512 / (vbsz)) + _t / (vbsz), vt = _t % (vbsz); vb < (nvb); vb += _g * (512 / (vbsz)))
#endif

__device__ __forceinline__ void tr_item(const float* __restrict__ W, int ldw, int K, int nblk, bf16_t* __restrict__ WT, int interleave, int row_off, LAS float* scr, int item, int lane) {
    const int kb = item / nblk, nb = item % nblk, k0 = 64 * kb, n0 = 32 * nb;
    float wv_[32];
#pragma unroll
    for (int i = 0; i < 32; ++i) wv_[i] = __builtin_nontemporal_load(W + ((size_t)(k0 + 2 * i + (lane >> 5)) * ldw + n0 + (lane & 31)));
#pragma unroll
    for (int i = 0; i < 32; ++i) scr[(2 * i + (lane >> 5)) * 33 + (lane & 31)] = wv_[i];
    asm volatile("s_waitcnt lgkmcnt(0)" ::: "memory");
    const int c = lane & 7;
    const int dr0 = interleave ? ((n0 >> 7) * 256 + (n0 & 127) + row_off) : (n0 + row_off);
#pragma unroll
    for (int j = 0; j < 4; ++j) { const int n = (lane >> 3) + 8 * j; const LAS float* sp = scr + (8 * c) * 33 + n;
        uint4 o; o.x = (unsigned)f2bf(sp[0 * 33]) | ((unsigned)f2bf(sp[1 * 33]) << 16); o.y = (unsigned)f2bf(sp[2 * 33]) | ((unsigned)f2bf(sp[3 * 33]) << 16);
        o.z = (unsigned)f2bf(sp[4 * 33]) | ((unsigned)f2bf(sp[5 * 33]) << 16); o.w = (unsigned)f2bf(sp[6 * 33]) | ((unsigned)f2bf(sp[7 * 33]) << 16);
        *(uint4*)(WT + (size_t)(dr0 + n) * K + k0 + 8 * c) = o; }
    asm volatile("s_waitcnt lgkmcnt(0)" ::: "memory");
}
struct Ctx { volatile LAS unsigned long long* tab; unsigned char* ws0; float* X; LAS unsigned char* lds; int wv; };
__device__ __forceinline__ const float* inp(const Ctx& c, int k) { volatile LAS unsigned long long* tp = c.tab; asm volatile("" : "+s"(tp)); const unsigned long long v = tp[k]; const unsigned lo = __builtin_amdgcn_readfirstlane((unsigned)v), hi = __builtin_amdgcn_readfirstlane((unsigned)(v >> 32));
    return (const float*)(((unsigned long long)hi << 32) | lo); }
__device__ __forceinline__ unsigned char* wsl(const Ctx& c) { unsigned char* w = c.ws0; asm volatile("" : "+s"(w)); return w; }
#define WBF(off) ((bf16_t*)(w + (off)))
#define WF32(off) ((float*)(w + (off)))

__device__ __forceinline__ void phase_weights(const Ctx& c, int l) {
    unsigned char* w = wsl(c);
    const int tid = otid(c.wv), lane = tid & 63, wave = tid >> 6;
    LAS float* scr = (LAS float*)(c.lds + wave * 16384);
    const int gw = lnd((int)blockIdx.x) * 8 + wave, NGW = lnd((int)gridDim.x) * 8;
    constexpr int I_IN = (D / 64) * (NPROJ / 32), I_GLU = (DSS / 64) * (DSS / 32), I_UP = (DR / 64) * (D / 32), I_OUT = (D / 64) * (D / 32), I_EG = (D / 64) * (DE / 32), I_ED = (DE / 64) * (D / 32);
    constexpr int I_E = 2 * I_EG + I_ED;
    constexpr int I_LORA = 16 + 16 + 32;
    constexpr int NITEMS = I_IN + 2 * I_GLU + 3 * I_UP + I_OUT + NE * I_E + I_LORA;
    for (int it = gw; it < NITEMS; it += NGW) {
        int r = it;
        if (r < I_LORA) {
            if (r < 16) tr_item(inp(c, 4) + (size_t)l * 64 * DR, DR, 64, DR / 32, WBF(WS_SMALL + wkv::SM_W2T), 0, 0, scr, r, lane);
            else if (r < 32) tr_item(inp(c, 6) + (size_t)l * 64 * DR, DR, 64, DR / 32, WBF(WS_SMALL + wkv::SM_A2T), 0, 0, scr, r - 16, lane);
            else tr_item(inp(c, 7) + (size_t)l * 128 * DR, DR, 128, DR / 32, WBF(WS_SMALL + wkv::SM_G2T), 0, 0, scr, r - 32, lane);
            continue; }
        r -= I_LORA;
        if (r < I_IN) { tr_item(inp(c, 1) + (size_t)l * D * NPROJ, NPROJ, D, NPROJ / 32, WBF(WS_WT_IN), 0, 0, scr, r, lane); continue; } r -= I_IN;
        if (r < 2 * I_GLU) { const int hf = r / I_GLU; tr_item(inp(c, 21) + (size_t)l * DSS * 2 * DSS + hf * DSS, 2 * DSS, DSS, DSS / 32, WBF(WS_WT_GLU), 1, hf * 128, scr, r % I_GLU, lane); continue; } r -= 2 * I_GLU;
        if (r < 3 * I_UP) { const int br = r / I_UP; tr_item(inp(c, 23 + br) + (size_t)l * DR * D, D, DR, D / 32, WBF(WS_WT_UPA + (size_t)br * MiB), 0, 0, scr, r % I_UP, lane); continue; } r -= 3 * I_UP;
        if (r < I_OUT) { tr_item(inp(c, 27) + (size_t)l * D * D, D, D, D / 32, WBF(WS_WT_OUT), 0, 0, scr, r, lane); continue; } r -= I_OUT;
        const int e = r / I_E; r %= I_E; const size_t eo = ((size_t)l * NE + e) * D * DE;
        if (r < 2 * I_EG) { const int hf = r / I_EG; tr_item(inp(c, 34 + hf) + eo, DE, D, DE / 32, WBF(WS_WT_EGU) + (size_t)e * 512 * D, 1, hf * 128, scr, r % I_EG, lane); continue; } r -= 2 * I_EG;
        tr_item(inp(c, 36) + eo, D, DE, D / 32, WBF(WS_WT_ED) + (size_t)e * D * DE, 0, 0, scr, r, lane);
    }
    VBL(8 * 32 * 3 * 64 / 256, 256) k_rtw(vb, vt, inp(c, 30) + (size_t)l * D * 4, inp(c, 32) + (size_t)l * D * 32, WF32(WS_SMALL + SM_RTW));
    VBL(NGR * SST / 256, 256) k_s5tab(vb, vt, inp(c, 13) + (size_t)l * NGR * SST, inp(c, 14) + (size_t)l * NGR * SST, inp(c, 15) + (size_t)l * NGR * SST * SGRP,
                                      inp(c, 16) + (size_t)l * NGR * SST * SGRP, inp(c, 20) + (size_t)l * NGR, WF32(WS_SMALL + SM_LAM), WF32(WS_SMALL + SM_BB));
}

#ifdef PROBE_A
#define GB() do { xcd_barrier(bar); if (l == 1 && blockIdx.x == 0 && otid(c.wv) == 0) { volatile LAS unsigned long long* ts_ = (volatile LAS unsigned long long*)(lds + MISC_OFF + 2048); const unsigned n_ = (unsigned)ts_[0]; ts_[1 + n_] = __builtin_amdgcn_s_memrealtime(); ts_[0] = n_ + 1; } } while (0)
#else
#define GB() xcd_barrier(bar)
#endif
template <int l> __device__ __forceinline__ void layer_body(const Ctx& c, const XcdBarrier& bar, LAS unsigned char* lds, unsigned char* lds_raw, volatile LAS unsigned* MISC, int G) {
#ifdef PROBE_A
    if (l == 1 && blockIdx.x == 0 && otid(c.wv) == 0) { volatile LAS unsigned long long* ts_ = (volatile LAS unsigned long long*)(lds + MISC_OFF + 2048); ts_[1] = __builtin_amdgcn_s_memrealtime(); ts_[0] = 1; }
#endif
        { unsigned char* w = wsl(c);
          pg8::Gemm g{WBF(WS_XN), WBF(WS_WT_IN), T, NPROJ, D}; pg8::StaticOrder S; S.init(T, NPROJ, lnd(G), lnd((int)blockIdx.x));
          pg8::EpiProj E{WBF(WS_PROJ), NPROJ, inp(c, 26) + (size_t)l * 3 * D, OFF_GATE / 256};
          pg8::gemm_phase<pg8::EpiProj, pg8::StaticOrder, true, true>(lds, g, S, E, c.wv); }
        GB();
        { unsigned char* w = wsl(c);
          { wkv::PreArgs pa; pa.P = WBF(WS_PROJ); pa.mu = inp(c, 2) + (size_t)l * 1792; pa.w0 = inp(c, 3) + (size_t)l * DR; pa.a0 = inp(c, 5) + (size_t)l * DR; pa.k_k = inp(c, 8) + (size_t)l * DR;
            pa.k_a = inp(c, 9) + (size_t)l * DR; pa.r_k = inp(c, 10) + (size_t)l * DR; pa.w2t = WBF(WS_SMALL + wkv::SM_W2T); pa.a2t = WBF(WS_SMALL + wkv::SM_A2T); pa.g2t = WBF(WS_SMALL + wkv::SM_G2T);
            pa.Vo = WBF(WS_V); pa.Go = WBF(WS_GG); pa.RK = (float*)(w + wkv::WS_RK); pa.GST = WBF(wkv::WS_GST); pa.GYT = WBF(wkv::WS_GYT); pa.YLT = WF32(wkv::WS_YLT); pa.SLT = WF32(wkv::WS_SLT); pa.PEND = (float*)(w + wkv::WS_PEND);
            const int tid = otid(c.wv);
#ifdef PROBE_IN
            if (l == 1 && blockIdx.x == 0 && tid == 0) ((volatile LAS unsigned long long*)(lds + MISC_OFF + 2048))[39] = __builtin_amdgcn_s_memrealtime();
#endif
            { const float* srcs_[6] = {pa.mu, pa.w0, pa.a0, pa.k_k, pa.k_a, pa.r_k};
#pragma unroll
              for (int k_ = 0; k_ < 2; ++k_) { const int i4 = tid + 512 * k_, f0 = 4 * i4;
                  const int arr = f0 < 1536 ? 0 : 1 + ((f0 - 1536) >> 9), off = f0 < 1536 ? f0 : (f0 - 1536) & 511;
                  const float* sp = arr == 0 ? pa.mu : arr == 1 ? pa.w0 : arr == 2 ? pa.a0 : arr == 3 ? pa.k_k : arr == 4 ? pa.k_a : pa.r_k; (void)srcs_;
                  *(LAS f32x4*)(lds + wkv::L_CST + f0 * 4) = *(const f32x4*)(sp + off); } }
            { const int G_ = lnd(G), bid_ = lnd((int)blockIdx.x);
              for (int tile = bid_; tile < NB * wkv::NCHK; tile += G_) {
                  const int b_ = tile >> 6, c_ = tile & 63;
                  wkv::act_tile(lds, pa, b_, c_, tid);
                  pg8::bf16x8 lb_[8][2]; wkv::load_lb(lb_, pa, 0, tid);
                  u32x4_t zc_[3], zp_[3]; wkv::load_z(zc_, zp_, pa, (size_t)b_ * SEQ + c_ * wkv::CH, c_ == 0, 0, tid);
                  for (int h_ = 0; h_ < RH; ++h_) wkv::unit_pre(lds, pa, ((b_ * RH + h_) << 6) + c_, tid, lb_, zc_, zp_); } }
#ifdef PROBE_IN
            if (l == 1 && blockIdx.x == 0 && tid == 0) ((volatile LAS unsigned long long*)(lds + MISC_OFF + 2048))[40] = __builtin_amdgcn_s_memrealtime();
#endif
          }
          { const int tid = otid(c.wv);
            for (int task = lnd((int)blockIdx.x); task < NB * MH * NBLK; task += lnd(G)) rt::kmean_task(lds, WBF(WS_PROJ), WF32(WS_SMALL + SM_KMEAN), WF32(WS_SMALL + SM_KNORM), task, tid);
#ifdef PROBE_IN
            if (l == 1 && blockIdx.x == 0 && tid == 0) ((volatile LAS unsigned long long*)(lds + MISC_OFF + 2048))[41] = __builtin_amdgcn_s_memrealtime();
#endif
          } }
        __syncthreads();
        { unsigned char* w = wsl(c); const int tid = otid(c.wv), lane = tid & 63, wave = tid >> 6;
          for (int u = lnd((int)blockIdx.x) * 8 + wave; u < NB * NGR * s5::NCH; u += lnd(G) * 8)
              s5::part1b(lds + wave * s5::WAVE_LDS2, WBF(WS_PROJ), WF32(WS_SMALL + SM_LAM), WF32(WS_SMALL + SM_BB), (float*)(w + s5::WS_S5E), u, lane); }
        GB();
#ifdef PROBE_PB
        if (l == 1 && blockIdx.x == PROBE_PB_BLK && otid(c.wv) == 0) ((volatile LAS unsigned long long*)(lds + MISC_OFF + 2048))[46] = __builtin_amdgcn_s_memrealtime();
#endif
        { unsigned char* w = wsl(c); const int tid = otid(c.wv);
          for (int bh = lnd((int)blockIdx.x); bh < NB * RH; bh += lnd(G))
              { wkv::PostArgs pa2{WBF(WS_V), WBF(WS_GG), (const float*)(w + wkv::WS_RK), inp(c, 11) + (size_t)l * DR, inp(c, 12) + (size_t)l * DR, WBF(WS_YA)};
                wkv::seq2(lds, WBF(wkv::WS_GST), WBF(wkv::WS_GYT), WF32(wkv::WS_YLT), WF32(wkv::WS_SLT), (const float*)(w + wkv::WS_PEND), pa2, bh, tid); } }
#ifdef PROBE_PB
        if (l == 1 && blockIdx.x == PROBE_PB_BLK && otid(c.wv) == 0) ((volatile LAS unsigned long long*)(lds + MISC_OFF + 2048))[47] = __builtin_amdgcn_s_memrealtime();
#endif
        { unsigned char* w = wsl(c); const int tid = otid(c.wv), lane = tid & 63, wave = tid >> 6;
          const int G_ = lnd(G), bid_ = lnd((int)blockIdx.x), skip_ = G_ >= 64 ? NB * RH : 0;
          if (bid_ >= skip_) for (int u = (bid_ - skip_) * 8 + wave; u < NB * NGR * s5::NCH; u += (G_ - skip_) * 8)
              s5::part2b(lds + wave * s5::WAVE_LDS2, WBF(WS_PROJ), WF32(WS_SMALL + SM_LAM), WF32(WS_SMALL + SM_BB), (const float*)(w + s5::WS_S5E),
                        inp(c, 17) + (size_t)l * NGR * SGRP * SST, inp(c, 18) + (size_t)l * NGR * SGRP * SST, inp(c, 19) + (size_t)l * DSS, WBF(WS_YCPRE), u, lane); }
        __syncthreads();
#ifdef PROBE_PB
        if (l == 1 && blockIdx.x == PROBE_PB_BLK && otid(c.wv) == 0) ((volatile LAS unsigned long long*)(lds + MISC_OFF + 2048))[48] = __builtin_amdgcn_s_memrealtime();
#endif
        { unsigned char* w = wsl(c);
          att::phase(lds, MISC + 12, (unsigned*)(w + WS_CTL) + CW_AQ + l, WBF(WS_PROJ), WF32(WS_SMALL + SM_KMEAN), WF32(WS_SMALL + SM_KNORM), WBF(WS_YB), c.wv); }
#ifdef PROBE_PB
        if (l == 1 && blockIdx.x == PROBE_PB_BLK && otid(c.wv) == 0) ((volatile LAS unsigned long long*)(lds + MISC_OFF + 2048))[49] = __builtin_amdgcn_s_memrealtime();
#endif
        GB();
        { unsigned char* w = wsl(c);
          pg8::Gemm g{WBF(WS_YCPRE), WBF(WS_WT_GLU), T, 2 * DSS, DSS}; pg8::StaticOrder S; S.init(T, 2 * DSS, lnd(G), lnd((int)blockIdx.x));
          pg8::EpiGated<0> E{WBF(WS_YC), DSS, inp(c, 22) + (size_t)l * 2 * DSS, DSS, 3};
          pg8::gemm_phase<pg8::EpiGated<0>, pg8::StaticOrder, true, true>(lds, g, S, E, c.wv); }
        GB();
        { unsigned char* w = wsl(c);
          static_assert(WS_YB == WS_YA + (size_t)T * DR * 2 && WS_YC == WS_YB + (size_t)T * DR * 2 && WS_WT_UPB == WS_WT_UPA + (size_t)D * DR * 2 && WS_WT_UPC == WS_WT_UPB + (size_t)D * DR * 2, "branch operands contiguous");
          pg8::Gemm g{WBF(WS_YA), WBF(WS_WT_UPA), 3 * T, 3 * D, DR}; pg8::TripleOrder S; S.base.init(T, D, lnd(G), lnd((int)blockIdx.x));
          pg8::EpiUp E{WBF(WS_PROJ) + OFF_GATE, NPROJ, WBF(WS_MERGEDB), D};
          pg8::gemm_phase<pg8::EpiUp, pg8::TripleOrder, true, true>(lds, g, S, E, c.wv); }
        GB();
        { unsigned char* w = wsl(c);
          pg8::Gemm g{WBF(WS_MERGEDB), WBF(WS_WT_OUT), T, D, D}; pg8::StaticOrder S; S.init(T, D, lnd(G), lnd((int)blockIdx.x));
          pg8::EpiOut E{WBF(WS_XN), WF32(WS_S), D, ALPHA};
          pg8::gemm_phase<pg8::EpiOut, pg8::StaticOrder, true, true>(lds, g, S, E, c.wv); }
        GB();
        { unsigned char* w = wsl(c); unsigned* cnt = (unsigned*)(w + WS_CTL) + CW_CNT + l * 32 * 64;
          rt::ln1route_phase(lds, WF32(WS_S), inp(c, 28) + (size_t)l * D, inp(c, 29) + (size_t)l * D, c.X, WBF(WS_XN), WF32(WS_SMALL + SM_RTW), inp(c, 31) + (size_t)l * 4, inp(c, 33) + (size_t)l * 32, cnt,
                             (int*)(w + WS_ROUTE + RT_EID), (int*)(w + WS_ROUTE + RT_POS), (float*)(w + WS_ROUTE + RT_WGT), (unsigned*)(w + WS_TOKS), otid(c.wv), lnd((int)blockIdx.x), lnd(G)); }
        GB();
        { unsigned char* w = wsl(c); unsigned* cnt = (unsigned*)(w + WS_CTL) + CW_CNT + l * 32 * 64;
          { const int t_ = otid(c.wv); if (t_ < NE) MISC[352 + t_] = cnt[t_ * 64]; }
          __syncthreads();
          if (otid(c.wv) == 0) { int nt = 0;
#pragma unroll 1
              for (int e = 0; e < NE; ++e) { const int te = ((int)MISC[352 + e] + 255) >> 8;
#pragma unroll 1
                  for (int q = 0; q < te; ++q) { MISC[16 + nt + q] = (unsigned)e; MISC[656 + nt + q] = (unsigned)(e * T + q * 256); }
                  nt += te; }
              MISC[8] = (unsigned)nt; }
          __syncthreads();
          const int ntiles = (int)MISC[8];
          pg8::Gemm g{WBF(WS_XN), WBF(WS_WT_EGU), MAXSLOT, NE * 512, D}; pg8::GatherOrder<2> S{(const LAS int*)(lds + MISC_OFF + 64), (const LAS int*)(lds + MISC_OFF + 2624), (const unsigned*)(w + WS_TOKS), ntiles, lnd(G), lnd((int)blockIdx.x), T};
          pg8::EpiGated<1> E{WBF(WS_HID), DE, nullptr, 0, 1};
          pg8::gemm_phase<pg8::EpiGated<1>, pg8::GatherOrder<2>, true, true>(lds, g, S, E, c.wv); }
        GB();
        { unsigned char* w = wsl(c); const int ntiles = (int)MISC[8];
          pg8::Gemm g{WBF(WS_HID), WBF(WS_WT_ED), MAXSLOT, NE * D, DE}; pg8::GroupedOrder<4> S{(const LAS int*)(lds + MISC_OFF + 64), ntiles, lnd(G), lnd((int)blockIdx.x)};
          pg8::EpiBf16Grp E{WBF(WS_YG), D, 3};
          pg8::gemm_phase<pg8::EpiBf16Grp, pg8::GroupedOrder<4>, true, true>(lds, g, S, E, c.wv); }
        GB();
        { unsigned char* w = wsl(c);
          { const int tid = otid(c.wv), lane = tid & 63, wave = tid >> 6; unsigned* cnt = (unsigned*)(w + WS_CTL) + CW_CNT + l * 32 * 64;
            LAS int* offs = (LAS int*)lds;
            if (tid < NE) offs[64 + tid] = (int)cnt[tid * 64];
            __syncthreads();
            if (tid == 0) { int o = 0;
#pragma unroll 1
                for (int e = 0; e < NE; ++e) { offs[e] = o; o += (offs[64 + e] + 255) & ~255; } }
            __syncthreads();
            for (int t = lnd((int)blockIdx.x) * 8 + wave; t < T; t += lnd(G) * 8)
                rt::ln2_row<(l == DEPTH - 1)>(t, lane, WBF(WS_YG), offs, (const int*)(w + WS_ROUTE + RT_EID), (const int*)(w + WS_ROUTE + RT_POS), (float*)(w + WS_ROUTE + RT_WGT), inp(c, 37) + (size_t)l * D, inp(c, 38) + (size_t)l * D, c.X, WBF(WS_XN));
            __syncthreads(); } }
        if (l + 1 < DEPTH) phase_weights(c, l + 1);
        GB();
}

__global__ void __launch_bounds__(512, 2) mega(Args a) {
    extern __shared__ __attribute__((aligned(16))) unsigned char lds_raw[];
    LAS unsigned char* lds = (LAS unsigned char*)lds_raw;
    volatile LAS unsigned* MISC = (volatile LAS unsigned*)(lds + MISC_OFF);
    Ctx c; c.tab = (volatile LAS unsigned long long*)(lds + MISC_OFF + 1024); c.ws0 = a.ws; c.X = a.out; c.lds = lds;
    c.wv = __builtin_amdgcn_readfirstlane((int)threadIdx.x >> 6);
    if (threadIdx.x < 16) MISC[threadIdx.x] = 0u;
    if (threadIdx.x < 64) ((volatile LAS unsigned long long*)(lds + MISC_OFF + 2048))[threadIdx.x] = 0ull;
    if (threadIdx.x < 39) c.tab[threadIdx.x] = (unsigned long long)a.in[threadIdx.x];
    __syncthreads();
    XcdBarrier bar = xcd_barrier_post((unsigned*)(a.ws + WS_CTL) + CW_BAR, MISC, c.wv);
    const int G = (int)gridDim.x;
    constexpr int l = -1; (void)l;
    { unsigned char* w = wsl(c); const float* xin = inp(c, 0); bf16_t* xn = WBF(WS_XN);
#pragma unroll 4
      for (size_t i = ((size_t)lnd((int)blockIdx.x) * 512 + otid(c.wv)) * 8; i < (size_t)T * D; i += (size_t)lnd(G) * 512 * 8) {
          const f32x4 a = __builtin_nontemporal_load((const f32x4*)(xin + i)), b = __builtin_nontemporal_load((const f32x4*)(xin + i + 4));
          u32x4_t o = {att::pk_bf16(a[0], a[1]), att::pk_bf16(a[2], a[3]), att::pk_bf16(b[0], b[1]), att::pk_bf16(b[2], b[3])}; *(u32x4_t*)(xn + i) = o; } }
    phase_weights(c, 0);
    GB();
    layer_body<0>(c, bar, lds, lds_raw, MISC, G);
    layer_body<1>(c, bar, lds, lds_raw, MISC, G);
    layer_body<2>(c, bar, lds, lds_raw, MISC, G);
    layer_body<3>(c, bar, lds, lds_raw, MISC, G);
#ifdef PROBE_A
#ifndef PROBE_PB_BLK
#define PROBE_PB_BLK 0
#endif
    if (blockIdx.x == PROBE_PB_BLK) {
        volatile LAS unsigned long long* ts_ = (volatile LAS unsigned long long*)(lds + MISC_OFF + 2048);
#if defined(PROBE_PB)
        const float dA = (float)(ts_[PROBE_PB_I1] - ts_[PROBE_PB_I0]) * 0.01f, dB = (float)(ts_[PROBE_PB_I3] - ts_[PROBE_PB_I2]) * 0.01f;
#elif defined(PROBE_UP)
        const float dA = (float)ts_[44] * 0.01f / 32.f, dB = (float)ts_[45] * 0.01f / 32.f;
#elif defined(PROBE_IN)
        const float dA = (float)(ts_[40] - ts_[39]) * 0.01f, dB = (float)(ts_[41] - ts_[40]) * 0.01f;
#else
        const float dA = (float)(ts_[2 + PROBE_A] - ts_[1 + PROBE_A]) * 0.01f, dB = (float)(ts_[2 + PROBE_B] - ts_[1 + PROBE_B]) * 0.01f;
#endif
        const int tid = otid(c.wv);
        if (tid == 0) c.X[0] += dA * 0.01f;
        const float dl = sqrtf(dB * 1e-6f * 16777216.f / 1048576.f);
        for (int i = tid; i < 1048576; i += 512) c.X[16 * i + 5] += dl;
    }
#endif
}

extern "C" void kernel_launch(void* const* d_in, const int* in_sizes, int n_in, void* d_out, int out_size, void* d_ws, size_t ws_size, hipStream_t stream) {
    static int grid = 0;
    if (grid == 0) {
        if (n_in != 39 || out_size != T * D || ws_size < WS_END) { fprintf(stderr, "kernel_launch: unexpected shapes n_in %d out %d ws %zu\n", n_in, out_size, ws_size); grid = -1; return; }
        int dev = 0, cus = 0, per_cu = 0;
        if (hipGetDevice(&dev) != hipSuccess || hipDeviceGetAttribute(&cus, hipDeviceAttributeMultiprocessorCount, dev) != hipSuccess) { grid = -1; return; }
        if (hipFuncSetAttribute((const void*)mega, hipFuncAttributeMaxDynamicSharedMemorySize, LDS_BYTES) != hipSuccess) { fprintf(stderr, "kernel_launch: hipFuncSetAttribute failed\n"); grid = -1; return; }
        if (hipOccupancyMaxActiveBlocksPerMultiprocessor(&per_cu, (const void*)mega, 512, LDS_BYTES) != hipSuccess || per_cu < 1) fprintf(stderr, "kernel_launch: occupancy query says %d\n", per_cu);
        (void)hipGetLastError();
        grid = cus;
        fprintf(stderr, "kernel_launch: grid %d, ws %zu\n", grid, ws_size);
    }
    if (grid < 0) return;
    (void)hipMemsetAsync((char*)d_ws + WS_CTL, 0, CTL_BYTES, stream);
    Args a{};
    for (int i = 0; i < 39; ++i) a.in[i] = (const float*)d_in[i];
    a.out = (float*)d_out; a.ws = (unsigned char*)d_ws;
    hipLaunchKernelGGL(mega, dim3(grid), dim3(512), LDS_BYTES, stream, a);
}
```

```cpp
#include <hip/hip_runtime.h>
#include <cstdio>
#include <cstdint>
#include <cmath>

typedef unsigned short bf16_t;
typedef short bf16x8 __attribute__((ext_vector_type(8)));
typedef float f32x4 __attribute__((ext_vector_type(4)));
typedef unsigned u32x4_t __attribute__((ext_vector_type(4)));
#define LDS_BARRIER() asm volatile("s_waitcnt lgkmcnt(0)\n\ts_barrier" ::: "memory")
typedef unsigned u32x2_t_ __attribute__((ext_vector_type(2)));

constexpr int NB = 4, SEQ = 4096, T = NB * SEQ, D = 1024, DEPTH = 4, HD = 64;
constexpr int DR = 512, RH = 8, DMO = 512, MH = 8, DSS = 512, SGRP = 16, NGR = 32, SST = 64;
constexpr int OFF_MOBA = 1792, OFF_SSM = 3328, OFF_GATE = 3840, NPROJ = 6912;
constexpr int MBLK = 256, NBLK = SEQ / MBLK;
constexpr int NE = 32, EPG = 8, NGRP = 4, DE = 256;
constexpr int MAXSLOT = 40960;
constexpr float LN_EPS = 1e-5f, GN_EPS = 64e-5f;
constexpr float ALPHA = 1.6817928305074290f;

constexpr size_t MiB = 1u << 20;
constexpr size_t WS_CTL = 0, CTL_BYTES = 1 * MiB;
constexpr size_t WS_SMALL = 1 * MiB;
constexpr size_t WS_WT_IN = 4 * MiB, WS_WT_GLU = 18 * MiB, WS_WT_UPA = 19 * MiB, WS_WT_UPB = 20 * MiB, WS_WT_UPC = 21 * MiB,
                 WS_WT_OUT = 22 * MiB, WS_WT_EGU = 24 * MiB, WS_WT_ED = 56 * MiB;
constexpr size_t WS_PROJ = 72 * MiB;
constexpr size_t WS_XN = 288 * MiB;
constexpr size_t WS_R = 320 * MiB, WS_KP = 336 * MiB, WS_V = 352 * MiB, WS_KK = 368 * MiB, WS_AA = 384 * MiB, WS_GG = 400 * MiB;
constexpr size_t WS_LW = 416 * MiB;
constexpr size_t WS_YRAW = 448 * MiB;
constexpr size_t WS_YA = 480 * MiB, WS_YB = 496 * MiB, WS_YC = 512 * MiB, WS_YCPRE = 528 * MiB;
constexpr size_t WS_ROUTE = 544 * MiB;
constexpr size_t WS_END = 548 * MiB;
constexpr size_t WS_MERGED = 320 * MiB;
constexpr size_t WS_MERGEDB = 384 * MiB;
constexpr size_t WS_S = 416 * MiB;
constexpr size_t WS_XG = 72 * MiB;
constexpr size_t WS_HID = 152 * MiB;
constexpr size_t WS_YG = 172 * MiB;
constexpr size_t SM_LAM = 0;
constexpr size_t SM_BB = 16384;
constexpr size_t SM_KMEAN = 16384 + 262144;
constexpr size_t SM_RTW = SM_KMEAN + 131072;
constexpr size_t SM_KNORM = SM_RTW + 196608, SM_BBF = SM_KNORM + 2048;
constexpr size_t RT_EID = 0, RT_POS = 131072, RT_SLOT = 262144, RT_WGT = 393216;
constexpr size_t RT_TOK = 524288;
constexpr size_t WS_TOKS = 72 * MiB;
constexpr int CW_AQ = 2048;
constexpr int CW_CNT = 16384;

__device__ __forceinline__ float bf2f(bf16_t h) { return __uint_as_float(((unsigned)h) << 16); }
__device__ __forceinline__ bf16_t f2bf(float f) { unsigned u = __float_as_uint(f); return (bf16_t)((u + 0x7fffu + ((u >> 16) & 1u)) >> 16); }
template <int CTRL, int RMASK> __device__ __forceinline__ float dpp_f(float oldv, float v) {
    return __builtin_bit_cast(float, __builtin_amdgcn_update_dpp(__builtin_bit_cast(int, oldv), __builtin_bit_cast(int, v), CTRL, RMASK, 0xF, false)); }
__device__ __forceinline__ float wave_allsum(float v) {
    v += dpp_f<0xB1, 0xF>(0.f, v);
    v += dpp_f<0x4E, 0xF>(0.f, v);
    v += dpp_f<0x141, 0xF>(0.f, v);
    v += dpp_f<0x140, 0xF>(0.f, v);
    v += dpp_f<0x142, 0xA>(0.f, v);
    v += dpp_f<0x143, 0xC>(0.f, v);
    return __builtin_bit_cast(float, __builtin_amdgcn_readlane(__builtin_bit_cast(int, v), 63));
}
__device__ __forceinline__ float wave_allmax(float v) {
    v = fmaxf(v, dpp_f<0xB1, 0xF>(v, v)); v = fmaxf(v, dpp_f<0x4E, 0xF>(v, v)); v = fmaxf(v, dpp_f<0x141, 0xF>(v, v)); v = fmaxf(v, dpp_f<0x140, 0xF>(v, v));
    v = fmaxf(v, dpp_f<0x142, 0xA>(v, v)); v = fmaxf(v, dpp_f<0x143, 0xC>(v, v));
    return __builtin_bit_cast(float, __builtin_amdgcn_readlane(__builtin_bit_cast(int, v), 63));
}
__device__ __forceinline__ float lane_bcast(float v, int l) { return __builtin_bit_cast(float, __builtin_amdgcn_readlane(__builtin_bit_cast(int, v), l)); }
__device__ __forceinline__ float sigmoidf_(float x) { return 1.f / (1.f + __expf(-x)); }
__device__ __forceinline__ float gelu_tanh(float x) { const float u = 0.7978845608028654f * (x + 0.044715f * x * x * x); return 0.5f * x * (1.f + tanhf(u)); }

__device__ __forceinline__ void k_cvt(int vb, int vt, const float* __restrict__ W, int ldw, int K, int Nsub, bf16_t* __restrict__ WT, int interleave, int row_off) {
    const long i = (long)vb * 256 + vt;
    if (i >= (long)K * Nsub) return;
    const int n = (int)(i / K), k = (int)(i % K);
    const int dr = interleave ? ((n >> 7) * 256 + (n & 127) + row_off) : (n + row_off);
    WT[(size_t)dr * K + k] = f2bf(W[(size_t)k * ldw + n]);
}
__device__ __forceinline__ void k_rtw(int vb, int vt, const float* __restrict__ gw, const float* __restrict__ ew, float* __restrict__ RTW) {
    const int i = vb * 256 + vt;
    if (i >= 8 * 32 * 3 * 64) return;
    const int lane = i & 63, r3 = i >> 6, ct = r3 % 3, rest = r3 / 3, ks = rest & 31, wv = rest >> 5;
    const int j = 16 * ct + (lane & 15), k = 128 * wv + 4 * ks + (lane >> 4);
    RTW[i] = j < 4 ? gw[k * 4 + j] : j < 36 ? ew[k * 32 + (j - 4)] : 0.f;
}
__device__ __forceinline__ void k_s5tab(int vb, int vt, const float* __restrict__ a_re, const float* __restrict__ a_im, const float* __restrict__ b_re, const float* __restrict__ b_im,
                        const float* __restrict__ log_dt, float* __restrict__ LAM, float* __restrict__ BB) {
    const int i = vb * 256 + vt;
    if (i >= NGR * SST) return;
    const int g = i / SST;
    const float dt = expf(log_dt[g]);
    const float are = a_re[i], aim = a_im[i];
    const float mag = expf(are * dt);
    const float ang = aim * dt;
    const float lre = mag * cosf(ang), lim = mag * sinf(ang);
    const float den = are * are + aim * aim, nr = lre - 1.0f;
    const float cre = (nr * are + lim * aim) / den, cim = (lim * are - nr * aim) / den;
    LAM[i * 2] = lre; LAM[i * 2 + 1] = lim;
    float vr[SGRP], vi[SGRP];
#pragma unroll
    for (int h = 0; h < SGRP; ++h) {
        const float bre = b_re[i * SGRP + h], bim = b_im[i * SGRP + h];
        vr[h] = cre * bre - cim * bim; vi[h] = cre * bim + cim * bre;
        BB[(i * SGRP + h) * 2] = vr[h];
        BB[(i * SGRP + h) * 2 + 1] = vi[h];
    }
    unsigned char* bbf = (unsigned char*)BB + (SM_BBF - SM_BB);
    const int p = i % SST;
#pragma unroll
    for (int im = 0; im < 2; ++im)
#pragma unroll
        for (int kq = 0; kq < 2; ++kq) { const int n = 2 * p + im, nt = n >> 4, fr = n & 15; const float* v = im ? vi : vr;
            typedef unsigned u4_ __attribute__((ext_vector_type(4)));
            auto pk = [](float lo, float hi) { typedef float f2 __attribute__((ext_vector_type(2))); typedef __bf16 b2 __attribute__((ext_vector_type(2))); f2 x = {lo, hi}; b2 y = __builtin_convertvector(x, b2); return __builtin_bit_cast(unsigned, y); };
            u4_ o = {pk(v[8 * kq], v[8 * kq + 1]), pk(v[8 * kq + 2], v[8 * kq + 3]), pk(v[8 * kq + 4], v[8 * kq + 5]), pk(v[8 * kq + 6], v[8 * kq + 7])};
            *(u4_*)(bbf + (size_t)(((g * 8 + nt) * 32 + fr + 16 * kq) * 16)) = o; }
}
__device__ __forceinline__ void k_x0(int vb, int vt, const float* __restrict__ x, float* __restrict__ X, bf16_t* __restrict__ XN) {
    const long i = (long)vb * 256 + vt;
    if (i >= (long)T * D) return;
    const float v = x[i]; (void)X; XN[i] = f2bf(v);
}

template <class Epi, bool PAIR>
__device__ __forceinline__ void k_gemm(int vbx, int vby, int vt, const bf16_t* __restrict__ A, const bf16_t* __restrict__ Bt, int K, Epi E) {
    const int wave = vt >> 6, lane = vt & 63, fr = lane & 15, fq = lane >> 4;
    const int rt = vby;
    if (!E.active(rt)) return;
    const bf16_t* B2 = Bt + E.bt_off(rt);
    const int row0 = rt * 64 + (wave >> 1) * 32;
    int colA, colB = 0, ch0 = 0;
    if (PAIR) { ch0 = vbx * 64 + (wave & 1) * 32; colA = (ch0 >> 7) * 256 + (ch0 & 127); colB = colA + 128; }
    else colA = vbx * 64 + (wave & 1) * 32;
    f32x4 acc[2][2], acc2[2][2];
#pragma unroll
    for (int i = 0; i < 2; ++i)
#pragma unroll
        for (int j = 0; j < 2; ++j) { acc[i][j] = (f32x4){0.f, 0.f, 0.f, 0.f}; acc2[i][j] = (f32x4){0.f, 0.f, 0.f, 0.f}; }
    for (int k0 = 0; k0 < K; k0 += 32) {
        bf16x8 a[2], b[2], b2[2];
#pragma unroll
        for (int i = 0; i < 2; ++i) a[i] = *(const bf16x8*)(A + (size_t)(row0 + i * 16 + fr) * K + k0 + fq * 8);
#pragma unroll
        for (int j = 0; j < 2; ++j) b[j] = *(const bf16x8*)(B2 + (size_t)(colA + j * 16 + fr) * K + k0 + fq * 8);
        if (PAIR) {
#pragma unroll
            for (int j = 0; j < 2; ++j) b2[j] = *(const bf16x8*)(B2 + (size_t)(colB + j * 16 + fr) * K + k0 + fq * 8);
        }
#pragma unroll
        for (int i = 0; i < 2; ++i)
#pragma unroll
            for (int j = 0; j < 2; ++j) {
                acc[i][j] = __builtin_amdgcn_mfma_f32_16x16x32_bf16(a[i], b[j], acc[i][j], 0, 0, 0);
                if (PAIR) acc2[i][j] = __builtin_amdgcn_mfma_f32_16x16x32_bf16(a[i], b2[j], acc2[i][j], 0, 0, 0);
            }
    }
#pragma unroll
    for (int i = 0; i < 2; ++i)
#pragma unroll
        for (int j = 0; j < 2; ++j)
#pragma unroll
            for (int r = 0; r < 4; ++r) {
                const int row = row0 + i * 16 + fq * 4 + r;
                if (PAIR) E.store2(row, ch0 + j * 16 + fr, acc[i][j][r], acc2[i][j][r]);
                else E.store(row, colA + j * 16 + fr, acc[i][j][r]);
            }
}
struct EDense { __device__ bool active(int) const { return true; } __device__ size_t bt_off(int) const { return 0; } };
struct EProj : EDense { bf16_t* P; __device__ void store(int r, int c, float v) const { P[(size_t)r * NPROJ + c] = f2bf(v); } __device__ void store2(int, int, float, float) const {} };
struct EGlu : EDense { bf16_t* YC; const float* bias;
    __device__ void store(int, int, float) const {}
    __device__ void store2(int r, int ch, float v, float g) const { YC[(size_t)r * DSS + ch] = f2bf((v + bias[ch]) * sigmoidf_(g + bias[DSS + ch])); } };
struct EUp : EDense { const bf16_t* P; const float* gate_b; float* M; bf16_t* MB; int br;
    __device__ void store2(int, int, float, float) const {}
    __device__ void store(int r, int c, float v) const {
        const float gl = bf2f(P[(size_t)r * NPROJ + OFF_GATE + br * D + c]) + gate_b[br * D + c];
        float m = sigmoidf_(gl) * v; const size_t o = (size_t)r * D + c;
        if (br > 0) m += M[o];
        M[o] = m; if (br == 2) MB[o] = f2bf(m); } };
struct EOut : EDense { const float* X; float* S;
    __device__ void store2(int, int, float, float) const {}
    __device__ void store(int r, int c, float v) const { const size_t o = (size_t)r * D + c; S[o] = ALPHA * X[o] + v; } };
struct EGrouped { const unsigned* cnt; int rows_per_e;
    __device__ int expert_of(int rt, bool& ok) const {
        int off = 0; const int r0 = rt * 64;
        for (int e = 0; e < NE; ++e) { const int p = ((int)cnt[e] + 255) & ~255; if (r0 < off + p) { ok = true; return e; } off += p; }
        ok = false; return 0; }
    __device__ bool active(int rt) const { bool ok; expert_of(rt, ok); return ok; }
};
struct ESwi : EGrouped { bf16_t* HID;
    __device__ size_t bt_off(int rt) const { bool ok; const int e = expert_of(rt, ok); return (size_t)e * 512 * D; }
    __device__ void store(int, int, float) const {}
    __device__ void store2(int r, int ch, float g, float u) const { HID[(size_t)r * DE + ch] = f2bf(g * sigmoidf_(g) * u); } };
struct EDown : EGrouped { bf16_t* YG;
    __device__ size_t bt_off(int rt) const { bool ok; const int e = expert_of(rt, ok); return (size_t)e * D * DE; }
    __device__ void store2(int, int, float, float) const {}
    __device__ void store(int r, int c, float v) const { YG[(size_t)r * D + c] = f2bf(v); } };

__device__ __forceinline__ void k_prep(int vb, int vt, const bf16_t* __restrict__ P, const float* __restrict__ mu, const float* __restrict__ w0, const float* __restrict__ w2,
        const float* __restrict__ a0, const float* __restrict__ a2, const float* __restrict__ g2, const float* __restrict__ k_k, const float* __restrict__ k_a,
        bf16_t* R, bf16_t* KP, bf16_t* V, bf16_t* KK, bf16_t* AA, bf16_t* GG, float* LW, float* act) {
    const int t = vb, c = vt;
    const bool first = (t % SEQ) == 0;
    const bf16_t* row = P + (size_t)t * NPROJ; const bf16_t* prow = row - NPROJ;
    auto zs = [&](int col) -> float { const float z = bf2f(row[col]); const float zp = first ? 0.f : bf2f(prow[col]); return z + (zp - z) * mu[col]; };
    if (c < 256) { const float z = zs(1536 + c); act[c] = c < 64 ? tanhf(z) : (c < 128 ? z : sigmoidf_(z)); }
    __syncthreads();
    const float r = zs(c), k = zs(512 + c), v = zs(1024 + c);
    float sw = 0.f, sa = 0.f, sg = 0.f;
#pragma unroll 4
    for (int i = 0; i < 64; ++i) { sw += act[i] * w2[i * DR + c]; sa += act[64 + i] * a2[i * DR + c]; }
#pragma unroll 4
    for (int i = 0; i < 128; ++i) sg += act[128 + i] * g2[i * DR + c];
    const float xx = -(w0[c] + sw);
    const float sp = fmaxf(xx, 0.f) + log1pf(expf(-fabsf(xx)));
    const float wl = -sp - 0.5f;
    const float lw = -expf(wl);
    const float a = sigmoidf_(a0[c] + sa);
    const float kk = k * k_k[c];
    const float ss = wave_allsum(kk * kk);
    const float kkn = kk * rsqrtf(fmaxf(ss, 1e-24f));
    const float kp = k * (1.f + (a - 1.f) * k_a[c]);
    const size_t o = (size_t)t * DR + c;
    R[o] = f2bf(r); KP[o] = f2bf(kp); V[o] = f2bf(v); KK[o] = f2bf(kkn); AA[o] = f2bf(a); GG[o] = f2bf(sg); LW[o] = lw;
    __syncthreads();
}
__device__ __forceinline__ void k_wkv(int vb, int vt, const bf16_t* __restrict__ R, const bf16_t* __restrict__ KP, const bf16_t* __restrict__ V, const bf16_t* __restrict__ KK,
        const bf16_t* __restrict__ AA, const float* __restrict__ LW, float* __restrict__ YRAW) {
    const int gwv = vb * 4 + (vt >> 6), j = vt & 63;
    const int i = gwv & 63, h = (gwv >> 6) & 7, b = gwv >> 9;
    float S = 0.f;
    for (int t = 0; t < SEQ; ++t) {
        const size_t o = (size_t)(b * SEQ + t) * DR + h * 64;
        const float r = bf2f(R[o + j]), w = __expf(LW[o + j]), k = bf2f(KP[o + j]), kk = bf2f(KK[o + j]), a = bf2f(AA[o + j]), v = bf2f(V[o + i]);
        const float sa = wave_allsum(S * (-kk));
        S = S * w + sa * (kk * a) + v * k;
        const float y = wave_allsum(S * r);
        if (j == 0) YRAW[o + i] = y;
    }
}
__device__ __forceinline__ void k_wkvpost(int vb, int vt, const float* __restrict__ YRAW, const bf16_t* __restrict__ R, const bf16_t* __restrict__ KP, const bf16_t* __restrict__ V,
        const bf16_t* __restrict__ GG, const float* __restrict__ r_k, const float* __restrict__ ln_w, const float* __restrict__ ln_b, bf16_t* __restrict__ YA) {
    const int t = vb, c = vt; const size_t o = (size_t)t * DR + c;
    const float y = YRAW[o];
    const float mean = wave_allsum(y) * (1.f / 64.f);
    const float dv = y - mean;
    const float var = wave_allsum(dv * dv) * (1.f / 64.f);
    const float yn = dv * rsqrtf(var + GN_EPS) * ln_w[c] + ln_b[c];
    const float bonus = wave_allsum(bf2f(R[o]) * bf2f(KP[o]) * r_k[c]) * bf2f(V[o]);
    YA[o] = f2bf((yn + bonus) * bf2f(GG[o]));
}
__device__ __forceinline__ void k_kmean(int vb, int vt, const bf16_t* __restrict__ P, float* __restrict__ KM) {
    const int i = vb * 256 + vt;
    if (i >= NB * MH * NBLK * HD) return;
    const int d = i & 63, n = (i >> 6) & 15, h = (i >> 10) & 7, b = i >> 13;
    float s = 0.f;
    for (int q = 0; q < MBLK; ++q) s += bf2f(P[(size_t)(b * SEQ + n * MBLK + q) * NPROJ + OFF_MOBA + 512 + h * 64 + d]);
    KM[i] = s * (1.f / MBLK);
}
__device__ __forceinline__ void k_moba(int vb, int vt, const bf16_t* __restrict__ P, const float* __restrict__ KM, bf16_t* __restrict__ YB) {
    const int gwv = vb * 4 + (vt >> 6), lane = vt & 63;
    const int h = gwv & 7, tt = gwv >> 3;
    const int b = tt / SEQ, tpos = tt % SEQ, blk = tpos / MBLK;
    const float slope = exp2f(-(float)(h + 1));
    const bf16_t* qrow = P + (size_t)tt * NPROJ + OFF_MOBA + h * 64;
    const float qd = bf2f(qrow[lane]) * 0.125f;
    float q[64];
#pragma unroll
    for (int d = 0; d < 64; ++d) q[d] = lane_bcast(qd, d);
    int sel[3] = {-1, -1, -1};
    {
        float gate[16];
#pragma unroll
        for (int n = 0; n < 16; ++n) { const float km = KM[((b * MH + h) * NBLK + n) * HD + lane]; gate[n] = wave_allsum(qd * km); }
#pragma unroll
        for (int s = 0; s < 3; ++s) {
            int best = -1; float bv = 0.f;
#pragma unroll
            for (int n = 0; n < 16; ++n) { const bool ok = n < blk && n != sel[0] && n != sel[1]; if (ok && (best < 0 || gate[n] > bv)) { best = n; bv = gate[n]; } }
            sel[s] = best;
        }
    }
    float m = -INFINITY, l = 0.f, o = 0.f;
    for (int s = 0; s < 4; ++s) {
        const int n = s < 3 ? sel[s] : blk;
        if (n < 0) continue;
        for (int c0 = 0; c0 < MBLK; c0 += 64) {
            const int sp = n * MBLK + c0 + lane;
            const bool valid = sp <= tpos;
            if (n * MBLK + c0 > tpos) break;
            const bf16_t* krow = P + (size_t)(b * SEQ + sp) * NPROJ + OFF_MOBA + 512 + h * 64;
            float sc = 0.f;
#pragma unroll
            for (int d8 = 0; d8 < 8; ++d8) { const bf16x8 kv = *(const bf16x8*)(krow + d8 * 8);
#pragma unroll
                for (int e = 0; e < 8; ++e) sc += q[d8 * 8 + e] * bf2f((bf16_t)kv[e]); }
            sc -= slope * (float)(tpos - sp);
            if (!valid) sc = -INFINITY;
            const float mx = wave_allmax(sc);
            const float mn = fmaxf(m, mx);
            const float scale = __expf(m - mn);
            const float p = valid ? __expf(sc - mn) : 0.f;
            l = l * scale + wave_allsum(p);
            o *= scale;
            const bf16_t* vbase = P + (size_t)(b * SEQ + n * MBLK + c0) * NPROJ + OFF_MOBA + 1024 + h * 64 + lane;
#pragma unroll
            for (int e = 0; e < 64; ++e) { const float pe = lane_bcast(p, e); o += pe * bf2f(vbase[(size_t)e * NPROJ]); }
            m = mn;
        }
    }
    YB[(size_t)tt * DMO + h * 64 + lane] = f2bf(o / l);
}
__device__ __forceinline__ void k_s5(int vb, int vt, const bf16_t* __restrict__ P, const float* __restrict__ LAM, const float* __restrict__ BB, const float* __restrict__ c_re,
        const float* __restrict__ c_im, const float* __restrict__ dvec, bf16_t* __restrict__ YCPRE) {
    const int b = vb / NGR, g = vb % NGR, p = vt;
    const float lre = LAM[(g * SST + p) * 2], lim = LAM[(g * SST + p) * 2 + 1];
    float bre[16], bim[16], cre[16], cim[16], dd[16];
#pragma unroll
    for (int h = 0; h < 16; ++h) { bre[h] = BB[((g * SST + p) * 16 + h) * 2]; bim[h] = BB[((g * SST + p) * 16 + h) * 2 + 1];
        cre[h] = c_re[(g * 16 + h) * SST + p]; cim[h] = c_im[(g * 16 + h) * SST + p]; dd[h] = dvec[g * 16 + h]; }
    float hre = 0.f, him = 0.f;
    for (int t = 0; t < SEQ; ++t) {
        const bf16_t* ur = P + (size_t)(b * SEQ + t) * NPROJ + OFF_SSM + g * 16;
        float u[16];
#pragma unroll
        for (int h = 0; h < 16; ++h) u[h] = bf2f(ur[h]);
        float bur = 0.f, bui = 0.f;
#pragma unroll
        for (int h = 0; h < 16; ++h) { bur += bre[h] * u[h]; bui += bim[h] * u[h]; }
        const float nre = lre * hre - lim * him + bur, nim = lre * him + lim * hre + bui;
        hre = nre; him = nim;
        float myy = 0.f;
#pragma unroll
        for (int h = 0; h < 16; ++h) { const float y = wave_allsum(cre[h] * hre - cim[h] * him) + dd[h] * u[h]; if (p == h) myy = y; }
        if (p < 16) YCPRE[(size_t)(b * SEQ + t) * DSS + g * 16 + p] = f2bf(gelu_tanh(myy));
    }
}
__device__ __forceinline__ void k_ln1route(int vb, int vt, const float* __restrict__ S, const float* __restrict__ lw, const float* __restrict__ lb, float* __restrict__ X, bf16_t* __restrict__ XN,
        const float* __restrict__ RTW, const float* __restrict__ gb, const float* __restrict__ eb, unsigned* __restrict__ cnt,
        int* __restrict__ EID, int* __restrict__ POS, float* __restrict__ WGT, float* rlog) {
    const int t = vb * 4 + (vt >> 6), lane = vt & 63;
    float v[16]; float s = 0.f;
#pragma unroll
    for (int i = 0; i < 16; ++i) { v[i] = S[(size_t)t * D + i * 64 + lane]; s += v[i]; }
    const float mean = wave_allsum(s) * (1.f / D);
    float q = 0.f;
#pragma unroll
    for (int i = 0; i < 16; ++i) { v[i] -= mean; q += v[i] * v[i]; }
    const float rstd = rsqrtf(wave_allsum(q) * (1.f / D) + LN_EPS);
#pragma unroll
    for (int i = 0; i < 16; ++i) { const int c = i * 64 + lane; v[i] = v[i] * rstd * lw[c] + lb[c]; X[(size_t)t * D + c] = v[i]; XN[(size_t)t * D + c] = f2bf(v[i]); }
    float* lg = rlog + ((vb & 1) * 4 + (vt >> 6)) * 40;
    for (int j = 0; j < 36; ++j) { float a = 0.f;
#pragma unroll
        for (int i = 0; i < 16; ++i) a += v[i] * RTW[j * 1024 + i * 64 + lane];
        a = wave_allsum(a); if (lane == 0) lg[j] = a; }
    if (lane == 0) {
        int gs = 0; float gm = lg[0] + gb[0];
        for (int j = 1; j < 4; ++j) { const float x = lg[j] + gb[j]; if (x > gm) { gm = x; gs = j; } }
        float den = 0.f;
        for (int j = 0; j < 4; ++j) den += __expf(lg[j] + gb[j] - gm);
        const float pg = 1.f / den;
        int i0 = 0; float m0 = lg[4 + gs * 8] + eb[gs * 8];
        for (int j = 1; j < 8; ++j) { const float x = lg[4 + gs * 8 + j] + eb[gs * 8 + j]; if (x > m0) { m0 = x; i0 = j; } }
        int i1 = -1; float m1 = 0.f;
        for (int j = 0; j < 8; ++j) { const float x = lg[4 + gs * 8 + j] + eb[gs * 8 + j]; if (j != i0 && (i1 < 0 || x > m1)) { m1 = x; i1 = j; } }
        const float e1 = __expf(m1 - m0);
        const float p0 = 1.f / (1.f + e1), p1 = e1 / (1.f + e1);
        const int ex0 = gs * 8 + i0, ex1 = gs * 8 + i1;
        EID[t * 2] = ex0; EID[t * 2 + 1] = ex1;
        WGT[t * 2] = pg * p0; WGT[t * 2 + 1] = pg * p1;
        POS[t * 2] = (int)atomicAdd(&cnt[ex0], 1u);
        POS[t * 2 + 1] = (int)atomicAdd(&cnt[ex1], 1u);
    }
}
__device__ __forceinline__ void k_gather(int vb, int vt, const bf16_t* __restrict__ XN, const unsigned* __restrict__ cnt, const int* __restrict__ EID, const int* __restrict__ POS,
        int* __restrict__ SLOT, bf16_t* __restrict__ XG) {
    const int t = vb * 4 + (vt >> 6), lane = vt & 63;
    for (int k = 0; k < 2; ++k) {
        const int e = EID[t * 2 + k]; int off = 0;
        for (int j = 0; j < e; ++j) off += ((int)cnt[j * 64] + 255) & ~255;
        const int slot = off + POS[t * 2 + k];
        if (lane == 0) SLOT[t * 2 + k] = slot;
        const uint4* src = (const uint4*)(XN + (size_t)t * D); uint4* dst = (uint4*)(XG + (size_t)slot * D);
        dst[lane] = src[lane]; dst[lane + 64] = src[lane + 64];
    }
}
__device__ __forceinline__ void k_ln2(int vb, int vt, const bf16_t* __restrict__ YG, const int* __restrict__ SLOT, const float* __restrict__ WGT, const float* __restrict__ lw, const float* __restrict__ lb,
        float* __restrict__ X, bf16_t* __restrict__ XN) {
    const int t = vb * 4 + (vt >> 6), lane = vt & 63;
    const int s0 = SLOT[t * 2], s1 = SLOT[t * 2 + 1]; const float w0 = WGT[t * 2], w1 = WGT[t * 2 + 1];
    float v[16]; float s = 0.f;
#pragma unroll
    for (int i = 0; i < 16; ++i) { const int c = i * 64 + lane;
        const float y = bf2f(YG[(size_t)s0 * D + c]) * w0 + bf2f(YG[(size_t)s1 * D + c]) * w1;
        v[i] = ALPHA * X[(size_t)t * D + c] + y; s += v[i]; }
    const float mean = wave_allsum(s) * (1.f / D);
    float q = 0.f;
#pragma unroll
    for (int i = 0; i < 16; ++i) { v[i] -= mean; q += v[i] * v[i]; }
    const float rstd = rsqrtf(wave_allsum(q) * (1.f / D) + LN_EPS);
#pragma unroll
    for (int i = 0; i < 16; ++i) { const int c = i * 64 + lane; const float o = v[i] * rstd * lw[c] + lb[c]; X[(size_t)t * D + c] = o; XN[(size_t)t * D + c] = f2bf(o); }
}

namespace pg8 {
#define PG8_LAS __attribute__((address_space(3)))
typedef unsigned short bf16_t;
typedef short bf16x8 __attribute__((ext_vector_type(8)));
typedef float f32x4 __attribute__((ext_vector_type(4)));
typedef unsigned u32x4 __attribute__((ext_vector_type(4)));
constexpr int BM = 256, BK = 64, HALF = 128, HTB = HALF * BK * 2  , STAGE_BYTES = 8 * HTB, NXCD = 8, WGM = 8;

__host__ __device__ __forceinline__ int lds_byte(int r, int c) { const int st = (r >> 4) * 2 + (c >> 5), rr = r & 15, cc = c & 31, ob = rr * 64 + cc * 2; return st * 1024 + (ob ^ (((ob >> 9) & 1) << 5)); }
__host__ __device__ __forceinline__ void stage_rc(int b, int& R, int& C) { const int st = b / 1024, sb = b % 1024, swz = sb ^ (((sb >> 9) & 1) << 5); R = (st >> 1) * 16 + swz / 64; C = (st & 1) * 32 + (swz % 64) / 2; }
__host__ __device__ __forceinline__ int perm32(int rho) { const int n = rho >> 4, i = rho & 15; return 8 * (i >> 2) + 4 * n + (i & 3); }

struct Unit { int pm, pn; };
struct Gemm { const bf16_t* A; const bf16_t* Bt; int M, N, K; };

struct StaticOrder {
    static constexpr bool GATHER = false;
    __device__ __forceinline__ int row(int) const { return 0; }
    int nM, nN, nwg, G, c;
    __host__ __device__ void init(int M, int N, int G_, int c_) { nM = M / BM; nN = N / BM; nwg = nM * nN; G = G_; c = c_; }
    __host__ __device__ bool next(int i, Unit& u) const {
        const long L = (long)i * G + c; if (L >= nwg) return false;
        int wgid = (int)L; { const int q = nwg / NXCD, r = nwg % NXCD, xcd = wgid % NXCD, off = wgid / NXCD; wgid = (xcd < r ? xcd * (q + 1) : r * (q + 1) + (xcd - r) * q) + off; }
        const int nig = WGM * nN, gid = wgid / nig, fm = gid * WGM, gsz = (nM - fm) < WGM ? (nM - fm) : WGM;
        u.pm = fm + ((wgid % nig) % gsz); u.pn = (wgid % nig) / gsz; return true;
    }
    __device__ __forceinline__ void a_ready(const Unit&) const {}
    __device__ __forceinline__ void done(const Unit&) const {}
};

__device__ __forceinline__ unsigned cvt_pk_bf16(float lo, float hi) { unsigned r; asm volatile("v_cvt_pk_bf16_f32 %0, %1, %2" : "=v"(r) : "v"(lo), "v"(hi)); return r; }
typedef float f32x2 __attribute__((ext_vector_type(2)));
__device__ __forceinline__ f32x2 gelu_pk(f32x2 v) {
    const f32x2 av = __builtin_elementwise_abs(v), d = av * 0.2316418882f + 1.0f;
    f32x2 t; t.x = __builtin_amdgcn_rcpf(d.x); t.y = __builtin_amdgcn_rcpf(d.y);
    f32x2 q = t * 0.5307027145f + (-0.7265760135f); q = q * t + 0.7107068705f; q = q * t + (-0.142248368f); q = q * t + 0.127414796f; q = q * t;
    const f32x2 s = (v * v) * (-0.72134752044f);
    f32x2 e; e.x = __builtin_amdgcn_exp2f(s.x); e.y = __builtin_amdgcn_exp2f(s.y);
    const f32x2 m = v * (q * e), r = v - m;
    f32x2 o; o.x = v.x < 0.f ? m.x : r.x; o.y = v.y < 0.f ? m.y : r.y; return o;
}

template <int ACT  > struct EpiBf16 {
    static constexpr bool PERM = true, AFTER_DRAIN = false, CHAIN = false; static_assert(ACT == 0 || ACT == 1, "EpiBf16: ACT is 0 (none) or 1 (gelu_pk)");
    bf16_t* O; int ldc; const float* bias; int split_cols; size_t split_stride; float scale0;
    __device__ __forceinline__ void operator()(const f32x4 (&acc)[2][2][4][2], const Unit& u, int wr, int wc, int fr, int fq) const {
        const int row0 = u.pm * BM + wr * 64 + fr; int colt = u.pn * BM; bf16_t* base = O;
        float sc = 1.f; if (split_cols) { const int t = colt / split_cols; base += (size_t)t * split_stride; colt -= t * split_cols; if (t == 0) sc = scale0; }
        const int col0 = colt + wc * 32 + 8 * fq, bcol0 = u.pn * BM + wc * 32 + 8 * fq;
        f32x4 bv[2][2];
#pragma unroll
        for (int bj = 0; bj < 2; ++bj)
#pragma unroll
            for (int n = 0; n < 2; ++n) bv[bj][n] = bias ? *(const f32x4*)(bias + bcol0 + bj * HALF + 4 * n) : (f32x4){0.f, 0.f, 0.f, 0.f};
#pragma unroll
        for (int ai = 0; ai < 2; ++ai)
#pragma unroll
            for (int m = 0; m < 4; ++m) { bf16_t* rowp = base + (size_t)(row0 + ai * HALF + m * 16) * ldc + col0;
#pragma unroll
                for (int bj = 0; bj < 2; ++bj) { f32x4 v0 = acc[ai][bj][m][0] + bv[bj][0], v1 = acc[ai][bj][m][1] + bv[bj][1];
                    if (ACT == 1) { f32x2 a = gelu_pk((f32x2){v0[0], v0[1]}), b = gelu_pk((f32x2){v0[2], v0[3]}), c = gelu_pk((f32x2){v1[0], v1[1]}), d = gelu_pk((f32x2){v1[2], v1[3]});
                        v0 = (f32x4){a.x, a.y, b.x, b.y}; v1 = (f32x4){c.x, c.y, d.x, d.y}; }
                    v0 = v0 * sc; v1 = v1 * sc; u32x4 w; w.x = cvt_pk_bf16(v0[0], v0[1]); w.y = cvt_pk_bf16(v0[2], v0[3]); w.z = cvt_pk_bf16(v1[0], v1[1]); w.w = cvt_pk_bf16(v1[2], v1[3]);
                    *(u32x4*)(rowp + bj * HALF) = w; } }
    }
};

typedef unsigned u32x2 __attribute__((ext_vector_type(2)));
__device__ __forceinline__ float sigm(float x) { return __builtin_amdgcn_rcpf(1.f + __expf(-x)); }
__device__ __forceinline__ float bflo(unsigned w) { return __uint_as_float(w << 16); }
__device__ __forceinline__ float bfhi(unsigned w) { return __uint_as_float(w & 0xffff0000u); }
template <int MODE> struct EpiGated {
    static constexpr bool PERM = true, AFTER_DRAIN = false, CHAIN = false;
    bf16_t* O; int ldc; const float* bias; int bias1_off; int pn_mask;
    __device__ __forceinline__ void operator()(const f32x4 (&acc)[2][2][4][2], const Unit& u, int wr, int wc, int fr, int fq) const {
        const int row0 = u.pm * BM + wr * 64 + fr, ch0 = (u.pn & pn_mask) * 128 + wc * 32 + 8 * fq;
        f32x4 b0[2], b1[2];
#pragma unroll
        for (int n = 0; n < 2; ++n) { if (MODE == 0) { b0[n] = *(const f32x4*)(bias + ch0 + 4 * n); b1[n] = *(const f32x4*)(bias + bias1_off + ch0 + 4 * n); } else { b0[n] = (f32x4){0.f, 0.f, 0.f, 0.f}; b1[n] = b0[n]; } }
#pragma unroll
        for (int ai = 0; ai < 2; ++ai)
#pragma unroll
            for (int m = 0; m < 4; ++m) { bf16_t* rowp = O + (size_t)(row0 + ai * HALF + m * 16) * ldc + ch0; float r[8];
#pragma unroll
                for (int n = 0; n < 2; ++n) { const f32x4 a0 = acc[ai][0][m][n] + b0[n], a1 = acc[ai][1][m][n] + b1[n];
#pragma unroll
                    for (int j = 0; j < 4; ++j) r[4 * n + j] = MODE == 0 ? a0[j] * sigm(a1[j]) : a0[j] * sigm(a0[j]) * a1[j]; }
                u32x4 w; w.x = cvt_pk_bf16(r[0], r[1]); w.y = cvt_pk_bf16(r[2], r[3]); w.z = cvt_pk_bf16(r[4], r[5]); w.w = cvt_pk_bf16(r[6], r[7]);
                *(u32x4*)rowp = w; }
    }
};
struct EpiProj {
    static constexpr bool PERM = true, AFTER_DRAIN = false, CHAIN = false;
    bf16_t* O; int ldc; const float* gate_b; int gate_tile0;
    __device__ __forceinline__ void operator()(const f32x4 (&acc)[2][2][4][2], const Unit& u, int wr, int wc, int fr, int fq) const {
        const int row0 = u.pm * BM + wr * 64 + fr, col0 = u.pn * BM + wc * 32 + 8 * fq; const bool gate = u.pn >= gate_tile0;
        f32x4 bv[2][2];
#pragma unroll
        for (int bj = 0; bj < 2; ++bj)
#pragma unroll
            for (int n = 0; n < 2; ++n) bv[bj][n] = gate ? *(const f32x4*)(gate_b + (col0 - gate_tile0 * BM) + bj * HALF + 4 * n) : (f32x4){0.f, 0.f, 0.f, 0.f};
#pragma unroll
        for (int ai = 0; ai < 2; ++ai)
#pragma unroll
            for (int m = 0; m < 4; ++m) { bf16_t* rowp = O + (size_t)(row0 + ai * HALF + m * 16) * ldc + col0;
#pragma unroll
                for (int bj = 0; bj < 2; ++bj) { f32x4 v0 = acc[ai][bj][m][0], v1 = acc[ai][bj][m][1];
                    if (gate) { v0 += bv[bj][0]; v1 += bv[bj][1];
#pragma unroll
                        for (int j = 0; j < 4; ++j) { v0[j] = sigm(v0[j]); v1[j] = sigm(v1[j]); } }
                    u32x4 w; w.x = cvt_pk_bf16(v0[0], v0[1]); w.y = cvt_pk_bf16(v0[2], v0[3]); w.z = cvt_pk_bf16(v1[0], v1[1]); w.w = cvt_pk_bf16(v1[2], v1[3]);
                    *(u32x4*)(rowp + bj * HALF) = w; } }
    }
};
struct EpiUp {
    static constexpr bool PERM = true, AFTER_DRAIN = false, CHAIN = true;
    const bf16_t* P; int ldp; bf16_t* MB; int ldc;
    __device__ __forceinline__ bool chain(const Unit& u) const { return (u.pm >> 6) < 2; }
    __device__ __forceinline__ static float cg(float g) { return fmaxf(g, 1e-20f); }
    __device__ __forceinline__ void rescale(f32x4 (&acc)[2][2][4][2], const Unit& u, int wr, int wc, int fr, int fq) const {
        const int br = u.pm >> 6, pm = u.pm & 63, pn = u.pn & 3;
        const int row0 = pm * BM + wr * 64 + fr, col0 = pn * BM + wc * 32 + 8 * fq;
        const bf16_t* Pg = P + br * 1024;
#pragma unroll
        for (int ai = 0; ai < 2; ++ai)
#pragma unroll
            for (int m = 0; m < 4; ++m) { const size_t row = (size_t)(row0 + ai * HALF + m * 16);
#pragma unroll
                for (int bj = 0; bj < 2; ++bj) { const int c = col0 + bj * HALF;
                    const u32x4 ga = *(const u32x4*)(Pg + row * ldp + c), gb = *(const u32x4*)(Pg + 1024 + row * ldp + c);
                    f32x4& a0 = acc[ai][bj][m][0]; f32x4& a1 = acc[ai][bj][m][1];
                    a0[0] *= cg(bflo(ga.x)) * __builtin_amdgcn_rcpf(cg(bflo(gb.x))); a0[1] *= cg(bfhi(ga.x)) * __builtin_amdgcn_rcpf(cg(bfhi(gb.x)));
                    a0[2] *= cg(bflo(ga.y)) * __builtin_amdgcn_rcpf(cg(bflo(gb.y))); a0[3] *= cg(bfhi(ga.y)) * __builtin_amdgcn_rcpf(cg(bfhi(gb.y)));
                    a1[0] *= cg(bflo(ga.z)) * __builtin_amdgcn_rcpf(cg(bflo(gb.z))); a1[1] *= cg(bfhi(ga.z)) * __builtin_amdgcn_rcpf(cg(bfhi(gb.z)));
                    a1[2] *= cg(bflo(ga.w)) * __builtin_amdgcn_rcpf(cg(bflo(gb.w))); a1[3] *= cg(bfhi(ga.w)) * __builtin_amdgcn_rcpf(cg(bfhi(gb.w))); } }
    }
    __device__ __forceinline__ void operator()(const f32x4 (&acc)[2][2][4][2], const Unit& u, int wr, int wc, int fr, int fq) const {
        const int pm = u.pm & 63, pn = u.pn & 3;
        const int row0 = pm * BM + wr * 64 + fr, col0 = pn * BM + wc * 32 + 8 * fq;
        const bf16_t* Pg = P + 2 * 1024;
#pragma unroll
        for (int ai = 0; ai < 2; ++ai)
#pragma unroll
            for (int m = 0; m < 4; ++m) { const size_t row = (size_t)(row0 + ai * HALF + m * 16);
#pragma unroll
                for (int bj = 0; bj < 2; ++bj) { const int c = col0 + bj * HALF;
                    const u32x4 gl = *(const u32x4*)(Pg + row * ldp + c);
                    const f32x4 a0 = acc[ai][bj][m][0], a1 = acc[ai][bj][m][1];
                    u32x4 w; w.x = cvt_pk_bf16(cg(bflo(gl.x)) * a0[0], cg(bfhi(gl.x)) * a0[1]); w.y = cvt_pk_bf16(cg(bflo(gl.y)) * a0[2], cg(bfhi(gl.y)) * a0[3]);
                    w.z = cvt_pk_bf16(cg(bflo(gl.z)) * a1[0], cg(bfhi(gl.z)) * a1[1]); w.w = cvt_pk_bf16(cg(bflo(gl.w)) * a1[2], cg(bfhi(gl.w)) * a1[3]);
                    *(u32x4*)(MB + row * ldc + c) = w; } }
    }
};
struct TripleOrder {
    static constexpr bool GATHER = false;
    __device__ __forceinline__ int row(int) const { return 0; }
    StaticOrder base;
    __device__ __forceinline__ bool next(int i, Unit& u) const { const int j = i / 3, br = i - 3 * j; if (!base.next(j, u)) return false; u.pm += 64 * br; u.pn += 4 * br; return true; }
    __device__ __forceinline__ void a_ready(const Unit&) const {}
    __device__ __forceinline__ void done(const Unit&) const {}
};
struct EpiOut {
    static constexpr bool PERM = false, AFTER_DRAIN = false, CHAIN = false;
    const bf16_t* XNb; float* S; int ldc; float alpha;
    __device__ __forceinline__ void operator()(const f32x4 (&acc)[2][2][4][2], const Unit& u, int wr, int wc, int fr, int fq) const {
        const int row0 = u.pm * BM + wr * 64 + fr, col0 = u.pn * BM + wc * 32 + 4 * fq;
#pragma unroll
        for (int ai = 0; ai < 2; ++ai)
#pragma unroll
            for (int m = 0; m < 4; ++m) { const size_t off = (size_t)(row0 + ai * HALF + m * 16) * ldc + col0;
#pragma unroll
                for (int bj = 0; bj < 2; ++bj)
#pragma unroll
                    for (int n = 0; n < 2; ++n) { const u32x2 xb = *(const u32x2*)(XNb + off + bj * HALF + n * 16); const f32x4 x = {bflo(xb.x), bfhi(xb.x), bflo(xb.y), bfhi(xb.y)};
                        *(f32x4*)(S + off + bj * HALF + n * 16) = x * alpha + acc[ai][bj][m][n]; } }
    }
};
struct EpiBf16Grp {
    static constexpr bool PERM = true, AFTER_DRAIN = false, CHAIN = false;
    bf16_t* O; int ldc; int pn_mask;
    __device__ __forceinline__ void operator()(const f32x4 (&acc)[2][2][4][2], const Unit& u, int wr, int wc, int fr, int fq) const {
        const int row0 = u.pm * BM + wr * 64 + fr, col0 = (u.pn & pn_mask) * BM + wc * 32 + 8 * fq;
#pragma unroll
        for (int ai = 0; ai < 2; ++ai)
#pragma unroll
            for (int m = 0; m < 4; ++m) { bf16_t* rowp = O + (size_t)(row0 + ai * HALF + m * 16) * ldc + col0;
#pragma unroll
                for (int bj = 0; bj < 2; ++bj) { const f32x4 v0 = acc[ai][bj][m][0], v1 = acc[ai][bj][m][1];
                    u32x4 w; w.x = cvt_pk_bf16(v0[0], v0[1]); w.y = cvt_pk_bf16(v0[2], v0[3]); w.z = cvt_pk_bf16(v1[0], v1[1]); w.w = cvt_pk_bf16(v1[2], v1[3]);
                    *(u32x4*)(rowp + bj * HALF) = w; } }
    }
};
template <int NCOL> struct GroupedOrder {
    static constexpr bool GATHER = false;
    __device__ __forceinline__ int row(int) const { return 0; }
    const PG8_LAS int* tile_e; int ntiles, G, c;
    __device__ __forceinline__ bool next(int i, Unit& u) const {
        const int L = i * G + c; if (L >= ntiles * NCOL) return false;
        const int tile = L / NCOL, j = L % NCOL; u.pm = tile; u.pn = __builtin_amdgcn_readfirstlane(tile_e[tile]) * NCOL + j; return true; }
    __device__ __forceinline__ void a_ready(const Unit&) const {}
    __device__ __forceinline__ void done(const Unit&) const {}
};
template <int NCOL> struct GatherOrder {
    static constexpr bool GATHER = true;
    const PG8_LAS int* tile_e; const PG8_LAS int* tile_base; const unsigned* tok; int ntiles, G, c, nrows;
    __device__ __forceinline__ int row(int slot) const { const unsigned t = tok[tile_base[slot >> 8] + (slot & 255)]; return (int)(t < (unsigned)nrows ? t : (unsigned)(nrows - 1)); }
    __device__ __forceinline__ bool next(int i, Unit& u) const {
        const int L = i * G + c; if (L >= ntiles * NCOL) return false;
        const int tile = L / NCOL, j = L % NCOL; u.pm = tile; u.pn = __builtin_amdgcn_readfirstlane(tile_e[tile]) * NCOL + j; return true; }
    __device__ __forceinline__ void a_ready(const Unit&) const {}
    __device__ __forceinline__ void done(const Unit&) const {}
};
template <class Epi, class Sched, bool ALIGN_EPI = false, bool SP2 = false>
__device__ __forceinline__ void gemm_phase(PG8_LAS unsigned char* lds, const Gemm g, const Sched& S, const Epi& E, int wv_) {
    int tid_; asm volatile("v_mbcnt_lo_u32_b32 %0, -1, 0\n\tv_mbcnt_hi_u32_b32 %0, -1, %0\n\tv_lshl_add_u32 %0, %1, 6, %0" : "=&v"(tid_) : "s"(wv_));
    const int tid = tid_, wid = __builtin_amdgcn_readfirstlane(tid >> 6), lane = tid & 63, wr = wid >> 2, wc = wid & 3, fr = lane & 15, fq = lane >> 4;
    const int K = g.K, nt = K / BK;
    unsigned voffA[2], voffB[2];
#pragma unroll
    for (int i = 0; i < 2; ++i) { int R, C; stage_rc(tid * 16 + i * 8192, R, C); const int Rb = Epi::PERM ? ((R & ~31) + perm32(R & 31)) : R;
        voffA[i] = (unsigned)(R * K + C) * 2u; voffB[i] = (unsigned)(Rb * K + C) * 2u; }
    const size_t kstep = (size_t)(BK * 2);
    const size_t hstep = (size_t)HALF * K * 2;
    const size_t tstep = 2 * hstep;
    const size_t tstepA = Sched::GATHER ? 0 : tstep, hstepA = Sched::GATHER ? 0 : hstep;
    unsigned vAc[2][2], vAn[2][2];
    auto gather_rows = [&](const Unit& u, unsigned (&v)[2][2]) {
#pragma unroll
        for (int h = 0; h < 2; ++h)
#pragma unroll
            for (int i = 0; i < 2; ++i) { int R, C; stage_rc(tid * 16 + i * 8192, R, C); v[h][i] = (unsigned)S.row(u.pm * BM + h * HALF + R) * (unsigned)(K * 2) + (unsigned)(C * 2); } };
    const unsigned ldsw = (unsigned)wid * 1024u;
    const int aoff = lds_byte(wr * 64 + fr, fq * 8), boff = lds_byte(wc * 32 + fr, fq * 8);
#define PG8_SA(b, h) (((b) * 2 + (h)) * HTB)
#define PG8_SB(b, h) ((4 + (b) * 2 + (h)) * HTB)
#define PG8_STAGE(bufoff, gbase, voff) do { _Pragma("unroll") for (int _i = 0; _i < 2; ++_i) \
        __builtin_amdgcn_global_load_lds((const unsigned*)((const char*)(gbase) + (voff)[_i]), (PG8_LAS unsigned*)(lds + (bufoff) + ldsw + _i * 8192), 16, 0, 0); } while (0)
#define PG8_STAGE_A(bufoff, kbase, h, usenext) do { if constexpr (Sched::GATHER) { unsigned vo_[2] = {(usenext) ? vAn[h][0] : vAc[h][0], (usenext) ? vAn[h][1] : vAc[h][1]}; PG8_STAGE(bufoff, kbase, vo_); } \
        else { PG8_STAGE(bufoff, (kbase) + ((h) ? hstepA : 0), voffA); } } while (0)
#define PG8_LDA(dst, b, h) do { _Pragma("unroll") for (int m = 0; m < 4; ++m) _Pragma("unroll") for (int k = 0; k < 2; ++k) dst[m][k] = *(const PG8_LAS bf16x8*)(lds + PG8_SA(b, h) + aoff + m * 2048 + k * 1024); } while (0)
#define PG8_LDB(dst, b, h) do { _Pragma("unroll") for (int n = 0; n < 2; ++n) _Pragma("unroll") for (int k = 0; k < 2; ++k) dst[n][k] = *(const PG8_LAS bf16x8*)(lds + PG8_SB(b, h) + boff + n * 2048 + k * 1024); } while (0)
#define PG8_MMA(ai, bj, At, Bt) do { __builtin_amdgcn_s_setprio(1); _Pragma("unroll") for (int m = 0; m < 4; ++m) _Pragma("unroll") for (int n = 0; n < 2; ++n) _Pragma("unroll") for (int k = 0; k < 2; ++k) \
        acc[ai][bj][m][n] = __builtin_amdgcn_mfma_f32_16x16x32_bf16(Bt[n][k], At[m][k], acc[ai][bj][m][n], 0, 0, 0); __builtin_amdgcn_s_setprio(0); } while (0)
#define PG8_WAIT_V(n) asm volatile("s_waitcnt vmcnt(" #n ")" ::: "memory")
#define PG8_WAIT_L(n) asm volatile("s_waitcnt lgkmcnt(" #n ")" ::: "memory")
#define PG8_BAR __builtin_amdgcn_s_barrier()
#define PG8_SCHED __builtin_amdgcn_sched_barrier(0)
    Unit cur, nxt; int ui = 0;
    if (!S.next(0, cur)) return;
    f32x4 acc[2][2][4][2];
#pragma unroll
    for (int a = 0; a < 2; ++a)
#pragma unroll
        for (int b = 0; b < 2; ++b)
#pragma unroll
            for (int m = 0; m < 4; ++m)
#pragma unroll
                for (int n = 0; n < 2; ++n) acc[a][b][m][n] = (f32x4){0.f, 0.f, 0.f, 0.f};
    bf16x8 At[4][2], B0[2][2], B1[2][2];
    const char* cA = (const char*)g.A + (size_t)cur.pm * tstepA; const char* cB = (const char*)g.Bt + (size_t)cur.pn * tstep;
    S.a_ready(cur);
    if constexpr (Sched::GATHER) gather_rows(cur, vAc);
    if constexpr (SP2) {
        PG8_STAGE(PG8_SB(0, 0), cB, voffB); PG8_STAGE(PG8_SB(0, 1), cB + hstep, voffB); PG8_STAGE_A(PG8_SA(0, 0), cA, 0, false); PG8_STAGE_A(PG8_SA(0, 1), cA, 1, false);
        if (wr == 1) PG8_BAR;
        PG8_WAIT_V(2); PG8_BAR;
        PG8_STAGE(PG8_SB(1, 0), cB + kstep, voffB); PG8_STAGE_A(PG8_SA(1, 0), cA + kstep, 0, false); PG8_STAGE(PG8_SB(1, 1), cB + hstep + kstep, voffB);
        PG8_WAIT_V(6); PG8_BAR;
    } else {
        PG8_STAGE(PG8_SB(0, 0), cB, voffB); PG8_STAGE_A(PG8_SA(0, 0), cA, 0, false); PG8_STAGE(PG8_SB(0, 1), cB + hstep, voffB); PG8_STAGE_A(PG8_SA(0, 1), cA, 1, false);
        if (wr == 1) PG8_BAR;
        PG8_WAIT_V(4); PG8_BAR;
        PG8_STAGE(PG8_SB(1, 0), cB + kstep, voffB); PG8_STAGE_A(PG8_SA(1, 0), cA + kstep, 0, false); PG8_STAGE(PG8_SB(1, 1), cB + hstep + kstep, voffB);
        PG8_WAIT_V(6); PG8_BAR;
    }
    for (;;) {
        const bool has_next = S.next(ui + 1, nxt);
        const char* nA = has_next ? (const char*)g.A + (size_t)nxt.pm * tstepA : cA;
        if constexpr (Sched::GATHER) { if (has_next) gather_rows(nxt, vAn); else { vAn[0][0] = vAc[0][0]; vAn[0][1] = vAc[0][1]; vAn[1][0] = vAc[1][0]; vAn[1][1] = vAc[1][1]; } } const char* nB = has_next ? (const char*)g.Bt + (size_t)nxt.pn * tstep : cB;
#pragma nounroll
        for (int t = 0; t < nt; t += 2) {
            const bool last = (t == nt - 2);
            const char* a1 = cA + (size_t)(t + 1) * kstep;
            const char* a2 = last ? nA : cA + (size_t)(t + 2) * kstep; const char* b2 = last ? nB : cB + (size_t)(t + 2) * kstep;
            const char* a3 = a2 + kstep; const char* b3 = b2 + kstep;
            if (last && has_next) S.a_ready(nxt);
            if constexpr (SP2) {
            PG8_LDB(B0, 0, 0); PG8_LDB(B1, 0, 1); PG8_SCHED; PG8_LDA(At, 0, 0); PG8_STAGE_A(PG8_SA(1, 1), a1, 1, false);
            PG8_WAIT_V(8); PG8_WAIT_L(0); PG8_BAR; PG8_MMA(0, 0, At, B0); PG8_MMA(0, 1, At, B1); PG8_BAR; PG8_SCHED;
            PG8_LDA(At, 0, 1); PG8_STAGE(PG8_SB(0, 0), b2, voffB); PG8_STAGE(PG8_SB(0, 1), b2 + hstep, voffB); PG8_STAGE_A(PG8_SA(0, 0), a2, 0, last);
            PG8_WAIT_V(8); PG8_WAIT_L(0); PG8_BAR; PG8_MMA(1, 0, At, B0); PG8_MMA(1, 1, At, B1); PG8_BAR; PG8_SCHED;
            PG8_LDB(B0, 1, 0); PG8_LDB(B1, 1, 1); PG8_SCHED; PG8_LDA(At, 1, 0); PG8_STAGE_A(PG8_SA(0, 1), a2, 1, last);
            PG8_WAIT_V(8); PG8_WAIT_L(0); PG8_BAR; PG8_MMA(0, 0, At, B0); PG8_MMA(0, 1, At, B1); PG8_BAR; PG8_SCHED;
            PG8_LDA(At, 1, 1); PG8_STAGE(PG8_SB(1, 0), b3, voffB); PG8_STAGE(PG8_SB(1, 1), b3 + hstep, voffB); PG8_STAGE_A(PG8_SA(1, 0), a3, 0, last);
            PG8_WAIT_V(8); PG8_WAIT_L(0); PG8_BAR; PG8_MMA(1, 0, At, B0); PG8_MMA(1, 1, At, B1); PG8_BAR; PG8_SCHED;
            } else {
            PG8_LDB(B0, 0, 0); PG8_SCHED; PG8_LDA(At, 0, 0); PG8_STAGE_A(PG8_SA(1, 1), a1, 1, false);
            PG8_WAIT_L(8); PG8_BAR; PG8_WAIT_L(0); PG8_MMA(0, 0, At, B0); PG8_BAR; PG8_SCHED;
            PG8_LDB(B1, 0, 1); PG8_STAGE(PG8_SB(0, 0), b2, voffB);
            PG8_BAR; PG8_WAIT_L(0); PG8_MMA(0, 1, At, B1); PG8_BAR;
            PG8_LDA(At, 0, 1); PG8_STAGE_A(PG8_SA(0, 0), a2, 0, last);
            PG8_BAR; PG8_WAIT_L(0); PG8_MMA(1, 0, At, B0); PG8_BAR; PG8_SCHED;
            PG8_STAGE(PG8_SB(0, 1), b2 + hstep, voffB);
            PG8_WAIT_V(6); PG8_BAR; PG8_MMA(1, 1, At, B1); PG8_BAR;
            PG8_LDB(B0, 1, 0); PG8_SCHED; PG8_LDA(At, 1, 0); PG8_STAGE_A(PG8_SA(0, 1), a2, 1, last);
            PG8_WAIT_L(8); PG8_BAR; PG8_WAIT_L(0); PG8_MMA(0, 0, At, B0); PG8_BAR; PG8_SCHED;
            PG8_LDB(B1, 1, 1); PG8_STAGE(PG8_SB(1, 0), b3, voffB);
            PG8_BAR; PG8_WAIT_L(0); PG8_MMA(0, 1, At, B1); PG8_BAR;
            PG8_LDA(At, 1, 1); PG8_STAGE_A(PG8_SA(1, 0), a3, 0, last);
            PG8_BAR; PG8_WAIT_L(0); PG8_MMA(1, 0, At, B0); PG8_BAR; PG8_SCHED;
            PG8_STAGE(PG8_SB(1, 1), b3 + hstep, voffB);
            PG8_WAIT_V(6); PG8_BAR; PG8_MMA(1, 1, At, B1); PG8_BAR;
            }
        }
        if constexpr (ALIGN_EPI) { if (wr == 0) PG8_BAR; }
        bool chain_ = false;
        if constexpr (Epi::CHAIN) { chain_ = E.chain(cur); if (chain_) E.rescale(acc, cur, wr, wc, fr, fq); }
        if constexpr (!Epi::AFTER_DRAIN) { if (!chain_) { E(acc, cur, wr, wc, fr, fq); S.done(cur); } }
        if (!has_next) break;
        if (!chain_)
#pragma unroll
        for (int a = 0; a < 2; ++a)
#pragma unroll
            for (int b = 0; b < 2; ++b)
#pragma unroll
                for (int m = 0; m < 4; ++m)
#pragma unroll
                    for (int n = 0; n < 2; ++n) acc[a][b][m][n] = (f32x4){0.f, 0.f, 0.f, 0.f};
        cur = nxt; cA = nA; cB = nB; ++ui;
        if constexpr (Sched::GATHER) { vAc[0][0] = vAn[0][0]; vAc[0][1] = vAn[0][1]; vAc[1][0] = vAn[1][0]; vAc[1][1] = vAn[1][1]; }
        if constexpr (ALIGN_EPI) { if (wr == 1) PG8_BAR; }
    }
    PG8_WAIT_V(0);
    if constexpr (!ALIGN_EPI) { if (wr == 0) PG8_BAR; }
    PG8_BAR;
    if constexpr (Epi::AFTER_DRAIN) { E.fused(acc, cur, wr, wc, fr, fq, lds, wid, lane); S.done(cur); }
#undef PG8_SA
#undef PG8_STAGE_A
#undef PG8_SB
#undef PG8_STAGE
#undef PG8_LDA
#undef PG8_LDB
#undef PG8_MMA
#undef PG8_WAIT_V
#undef PG8_WAIT_L
#undef PG8_BAR
#undef PG8_SCHED
}
}

#define LAS __attribute__((address_space(3)))
#define XB_TMO      128
#define XB_XCNT(j)  (256  + 64 * (j))
#define XB_XSUB(j)  (1280 + 64 * (j))
#define XB_XGEN(j)  (2304 + 64 * (j))
#define XB_TOP      3328
#define XB_TOPGEN   3392
#define XCD_BAR_WORDS 3456
#define XB_SPIN_CAP (1u << 18)
__device__ __forceinline__ unsigned xb_ld(unsigned* p)              { return __hip_atomic_load(p, __ATOMIC_RELAXED, __HIP_MEMORY_SCOPE_AGENT); }
__device__ __forceinline__ unsigned xb_add(unsigned* p, unsigned v) { return __hip_atomic_fetch_add(p, v, __ATOMIC_RELAXED, __HIP_MEMORY_SCOPE_AGENT); }
__device__ __forceinline__ unsigned xb_xcc_id() { return (unsigned)__builtin_amdgcn_s_getreg((3 << 11) | 20) & 0xFu; }
#define XB_SPIN(cond, bar) do { unsigned _sp = 0; while (cond) { __builtin_amdgcn_s_sleep(1); \
    if ((++_sp & 255u) == 0u) { if (xb_ld(&(bar)[XB_TMO])) break; if (_sp > XB_SPIN_CAP) { atomicAdd(&(bar)[XB_TMO], 1u); break; } } } } while (0)
__device__ __forceinline__ int otid(int wv) { int t; asm volatile("v_mbcnt_lo_u32_b32 %0, -1, 0\n\tv_mbcnt_hi_u32_b32 %0, -1, %0\n\tv_lshl_add_u32 %0, %1, 6, %0" : "=&v"(t) : "s"(wv)); return t; }
struct XcdBarrier { unsigned* bar; unsigned x; volatile LAS unsigned* st; int wv; };
__device__ __forceinline__ XcdBarrier xcd_barrier_post(unsigned* bar, volatile LAS unsigned* st, int wv) {
    XcdBarrier b; b.bar = bar; b.x = xb_xcc_id(); b.st = st; b.wv = wv;
    if (threadIdx.x == 0) { (void)xb_add(&bar[XB_XCNT(b.x)], 1u); st[2] = b.x; }
    return b;
}
__device__ __forceinline__ void xcd_barrier_complete(unsigned* bar, unsigned x, unsigned& nloc, unsigned& nx) {
    const unsigned G = gridDim.x * gridDim.y * gridDim.z;
    unsigned sum, cnt, mine, sp = 0u;
    for (;;) {
        sum = 0u; cnt = 0u; mine = 0u;
#pragma unroll
        for (unsigned j = 0; j < 16; ++j) { const unsigned c = xb_ld(&bar[XB_XCNT(j)]); sum += c; cnt += (c > 0u) ? 1u : 0u; mine = (j == x) ? c : mine; }
        if (sum == G) break;
        __builtin_amdgcn_s_sleep(1);
        if ((++sp & 255u) == 0u) { if (xb_ld(&bar[XB_TMO])) break; if (sp > XB_SPIN_CAP) { atomicAdd(&bar[XB_TMO], 1u); break; } }
    }
    nloc = mine > 0u ? mine : 1u; nx = cnt > 0u ? cnt : 1u;
}
__device__ __forceinline__ void xcd_barrier(const XcdBarrier& b) {
    asm volatile("s_waitcnt vmcnt(0)" ::: "memory");
    __syncthreads();
    if (otid(b.wv) == 0) {
        unsigned* bar = b.bar;
        __builtin_amdgcn_s_waitcnt(0);
        unsigned nloc = b.st[0], nx = b.st[1]; const unsigned bx = b.st[2];
        if (nloc == 0u) { xcd_barrier_complete(bar, bx, nloc, nx); b.st[0] = nloc; b.st[1] = nx; }
        const unsigned old = xb_add(&bar[XB_XSUB(bx)], 1u);
        const unsigned gen = old / nloc;
        if (old + 1u == (gen + 1u) * nloc) {
            __builtin_amdgcn_fence(__ATOMIC_RELEASE, "agent");
            asm volatile("s_waitcnt vmcnt(0)" ::: "memory");
            const unsigned og = xb_add(&bar[XB_TOP], 1u);
            const unsigned tg = og / nx;
            if (og + 1u == (tg + 1u) * nx) xb_add(&bar[XB_TOPGEN], 1u);
            else XB_SPIN(xb_ld(&bar[XB_TOPGEN]) == tg, bar);
            __builtin_amdgcn_fence(__ATOMIC_ACQUIRE, "agent");
            xb_add(&bar[XB_XGEN(bx)], 1u);
            asm volatile("s_waitcnt vmcnt(0)" ::: "memory");
        } else {
            XB_SPIN(xb_ld(&bar[XB_XGEN(bx)]) == gen, bar);
            __builtin_amdgcn_fence(__ATOMIC_ACQUIRE, "agent");
            asm volatile("s_waitcnt vmcnt(0)" ::: "memory");
        }
    }
    __syncthreads();
}
constexpr int CW_BAR = 4096;

namespace att {
typedef short s16x4 __attribute__((ext_vector_type(4)));
typedef unsigned u32x2_t __attribute__((ext_vector_type(2)));
typedef float f32x16 __attribute__((ext_vector_type(16)));
constexpr int PK = 144, PV = 192;
constexpr int KBUF = 64 * PK, VBUF = 64 * PV;
constexpr int OFF_K = 0, OFF_V = 2 * KBUF, OFF_KM = 2 * KBUF + 2 * VBUF, OFF_OST = OFF_KM + 4096, OST_W = 32 * 144, LDS_BYTES_ATT = OFF_OST + 8 * OST_W;
constexpr float NEG = -1e30f;
__device__ __forceinline__ float half_sum(float v) { auto rr = __builtin_amdgcn_permlane32_swap(__float_as_uint(v), __float_as_uint(v), false, false); return __uint_as_float(rr[0]) + __uint_as_float(rr[1]); }
__device__ __forceinline__ float half_max(float v) { auto rr = __builtin_amdgcn_permlane32_swap(__float_as_uint(v), __float_as_uint(v), false, false); return fmaxf(__uint_as_float(rr[0]), __uint_as_float(rr[1])); }
__device__ __forceinline__ unsigned pk_bf16(float lo, float hi) { typedef float f2 __attribute__((ext_vector_type(2))); typedef __bf16 b2 __attribute__((ext_vector_type(2))); f2 v = {lo, hi}; b2 b = __builtin_convertvector(v, b2); return __builtin_bit_cast(unsigned, b); }
__device__ __forceinline__ s16x4 vtr(LAS const unsigned char* p) { typedef short v4 __attribute__((ext_vector_type(4))); return __builtin_amdgcn_ds_read_tr16_b64_v4i16((LAS v4*)p); }

__device__ __forceinline__ void unit(LAS unsigned char* lds, const bf16_t* __restrict__ P, const float* __restrict__ KM, const float* __restrict__ KN, bf16_t* __restrict__ YB, int b, int h, int qb, int tid, unsigned* qctr, unsigned& nxt) {
    const int lane = tid & 63, w = __builtin_amdgcn_readfirstlane(tid >> 6), r32 = lane & 31, hi = lane >> 5;
    const size_t rowbase = (size_t)b * SEQ; const int q0 = qb * MBLK;
    const float cexp = exp2f(-(float)(h + 1)) * 1.4426950408889634f;
    LAS float* km = (LAS float*)(lds + OFF_KM);
    for (int i = tid; i < qb * 64; i += 512) km[i] = KM[(size_t)((b * MH + h) * NBLK) * HD + i];
    const bf16_t* qp = P + (rowbase + q0 + 32 * w + r32) * NPROJ + OFF_MOBA + h * 64 + 8 * hi;
    bf16x8 qs[4];
#pragma unroll
    for (int d0 = 0; d0 < 4; ++d0) qs[d0] = *(const bf16x8*)(qp + 16 * d0);
    __syncthreads();
    unsigned selmask = 0u;
    if (qb > 0) {
        float qf[32];
#pragma unroll
        for (int d0 = 0; d0 < 4; ++d0)
#pragma unroll
            for (int e = 0; e < 8; ++e) qf[d0 * 8 + e] = bf2f((bf16_t)qs[d0][e]);
        float gate[15];
#pragma unroll
        for (int n = 0; n < 15; ++n) { float s = 0.f;
            if (n < qb) {
#pragma unroll
                for (int d0 = 0; d0 < 4; ++d0) { const f32x4 k0 = *(const LAS f32x4*)(km + n * 64 + 16 * d0 + 8 * hi), k1 = *(const LAS f32x4*)(km + n * 64 + 16 * d0 + 8 * hi + 4);
                    s += qf[d0 * 8 + 0] * k0[0] + qf[d0 * 8 + 1] * k0[1] + qf[d0 * 8 + 2] * k0[2] + qf[d0 * 8 + 3] * k0[3] + qf[d0 * 8 + 4] * k1[0] + qf[d0 * 8 + 5] * k1[1] + qf[d0 * 8 + 6] * k1[2] + qf[d0 * 8 + 7] * k1[3]; }
                s = half_sum(s); }
            gate[n] = s; }
#pragma unroll
        for (int s = 0; s < 3; ++s) { int best = -1; float bv = 0.f;
#pragma unroll
            for (int n = 0; n < 15; ++n) { const bool ok = n < qb && !((selmask >> n) & 1u); if (ok && (best < 0 || gate[n] > bv)) { best = n; bv = gate[n]; } }
            if (best >= 0) selmask |= 1u << best; }
    }
    int skT = 0;
    if (qb > 0) {
        float q2 = 0.f;
#pragma unroll
        for (int d0 = 0; d0 < 4; ++d0)
#pragma unroll
            for (int e = 0; e < 8; ++e) { const float x = bf2f((bf16_t)qs[d0][e]); q2 += x * x; }
        q2 = half_sum(q2);
        const float qw = wave_allmax(q2);
        LAS float* qmx = (LAS float*)(lds + OFF_KM + 3840);
        if (lane == 0) qmx[w] = qw;
        __syncthreads();
        float qm = qmx[0];
#pragma unroll
        for (int i = 1; i < 8; ++i) qm = fmaxf(qm, qmx[i]);
        const float qmax = sqrtf(qm), kown = KN[(b * MH + h) * NBLK + qb];
        bool pre = true;
#pragma unroll
        for (int n = 0; n < 15; ++n) { if (n < qb) { const float top = 0.18033688f * qmax * (KN[(b * MH + h) * NBLK + n] + kown) - cexp * (float)(256 * (qb - n - 1) + 1);
#pragma unroll
            for (int j = 0; j < 4; ++j) { pre = pre && (top - cexp * (float)(64 * (3 - j)) < -40.f); if (pre) skT = 4 * n + j + 1; } } }
        skT = __builtin_amdgcn_readfirstlane(skT) & ~1;
    }
#pragma unroll
    for (int d0 = 0; d0 < 4; ++d0) { unsigned wv_[4];
#pragma unroll
        for (int e = 0; e < 4; ++e) wv_[e] = pk_bf16(bf2f((bf16_t)qs[d0][2 * e]) * 0.18033688011112042f, bf2f((bf16_t)qs[d0][2 * e + 1]) * 0.18033688011112042f);
        u32x4_t t4 = {wv_[0], wv_[1], wv_[2], wv_[3]}; qs[d0] = __builtin_bit_cast(bf16x8, t4); }
    float ck[16];
#pragma unroll
    for (int r = 0; r < 16; ++r) ck[r] = cexp * (float)((r & 3) + 8 * (r >> 2));
    f32x16 oT0 = {}, oT1 = {};
    float mrun = 0.f, lsum = 0.f;
    const int qrel = 32 * w + r32;
    const int NT = 4 + 4 * qb - skT;
    const int srow = tid >> 3, sch = tid & 7;
    const bf16_t* kvsrc = P + rowbase * NPROJ + OFF_MOBA + 512 + h * 64 + sch * 8;
    u32x4_t kA, vA, kB, vB;
    { const bf16_t* s0 = kvsrc + (size_t)(q0 + srow) * NPROJ; kA = *(const u32x4_t*)s0; vA = *(const u32x4_t*)(s0 + 512); }
    *(LAS u32x4_t*)(lds + OFF_K + srow * PK + sch * 16) = kA; *(LAS u32x4_t*)(lds + OFF_V + srow * PV + sch * 16) = vA;
    { const bf16_t* s0 = kvsrc + (size_t)(q0 + 64 + srow) * NPROJ; kA = *(const u32x4_t*)s0; vA = *(const u32x4_t*)(s0 + 512); }
    __syncthreads();
#define ATT_TILE(i, KC, VC, KN, VN) do { \
        const int buf = (i) & 1; \
        if ((i) + 2 < NT) { const int i2 = (i) + 2; const int kv2 = i2 < 4 ? q0 + 64 * i2 : 64 * (skT + i2 - 4); \
            const bf16_t* s0 = kvsrc + (size_t)(kv2 + srow) * NPROJ; KN = *(const u32x4_t*)s0; VN = *(const u32x4_t*)(s0 + 512); } \
        att_tile_compute((i), buf); \
        if ((i) + 1 < NT) { *(LAS u32x4_t*)(lds + OFF_K + (buf ^ 1) * KBUF + srow * PK + sch * 16) = KC; *(LAS u32x4_t*)(lds + OFF_V + (buf ^ 1) * VBUF + srow * PV + sch * 16) = VC; } \
        LDS_BARRIER(); } while (0)
    auto att_tile_compute = [&](int i, int buf) {
        int n, j; bool own;
        if (i < 4) { own = true; n = qb; j = i; } else { own = false; n = (skT + i - 4) >> 2; j = (skT + i - 4) & 3; }
        const bool sel = own ? true : (((selmask >> n) & 1u) != 0u);
        bool docomp; int causal = 0;
        if (own) { docomp = j <= (w >> 1); causal = (j == (w >> 1)); }
        else docomp = __builtin_amdgcn_ballot_w64(sel) != 0ull;
        if (docomp) {
            LAS const unsigned char* Kb = lds + OFF_K + buf * KBUF; LAS const unsigned char* Vb = lds + OFF_V + buf * VBUF;
            const float trel = (float)((n - qb) * MBLK + 64 * j + 4 * hi);
            const float bl0 = sel ? cexp * trel - mrun : NEG, bl1 = sel ? cexp * (trel + 32.f) - mrun : NEG;
            f32x16 p0, p1;
#pragma unroll
            for (int r = 0; r < 16; ++r) { p0[r] = bl0 + ck[r]; p1[r] = bl1 + ck[r]; }
#pragma unroll
            for (int d0 = 0; d0 < 4; ++d0) {
                const bf16x8 a0 = *(const LAS bf16x8*)(Kb + r32 * PK + 32 * d0 + 16 * hi), a1 = *(const LAS bf16x8*)(Kb + (r32 + 32) * PK + 32 * d0 + 16 * hi);
                p0 = __builtin_amdgcn_mfma_f32_32x32x16_bf16(a0, qs[d0], p0, 0, 0, 0);
                p1 = __builtin_amdgcn_mfma_f32_32x32x16_bf16(a1, qs[d0], p1, 0, 0, 0); }
            if (causal) {
#pragma unroll
                for (int r = 0; r < 16; ++r) { const int kvrel = 64 * j + (r & 3) + 8 * (r >> 2) + 4 * hi; if (kvrel > qrel) p0[r] = NEG; if (kvrel + 32 > qrel) p1[r] = NEG; } }
            float mt = fmaxf(p0[0], p1[0]);
#pragma unroll
            for (int r = 1; r < 16; ++r) mt = fmaxf(mt, fmaxf(p0[r], p1[r]));
            mt = half_max(mt);
            const float dsh = (i == 0) ? mt : fmaxf(mt, 0.f);
            if (__builtin_amdgcn_ballot_w64(dsh != 0.f) != 0ull) {
                const float alpha = __builtin_amdgcn_exp2f(-dsh);
                mrun += dsh; lsum *= alpha;
#pragma unroll
                for (int r = 0; r < 16; ++r) { oT0[r] *= alpha; oT1[r] *= alpha; p0[r] -= dsh; p1[r] -= dsh; } }
            float ps = 0.f;
#pragma unroll
            for (int r = 0; r < 16; ++r) { p0[r] = __builtin_amdgcn_exp2f(p0[r]); p1[r] = __builtin_amdgcn_exp2f(p1[r]); ps += p0[r] + p1[r]; }
            lsum += ps;
            bf16x8 pb[4];
#pragma unroll
            for (int s = 0; s < 4; ++s) { u32x4_t t4;
#pragma unroll
                for (int e = 0; e < 4; ++e) { const int r = 8 * (s & 1) + 2 * e; t4[e] = (s < 2) ? pk_bf16(p0[r], p0[r + 1]) : pk_bf16(p1[r], p1[r + 1]); }
                pb[s] = __builtin_bit_cast(bf16x8, t4); }
            LAS const unsigned char* vb = Vb + (4 * hi + ((lane & 15) >> 2)) * PV + (16 * ((lane >> 4) & 1) + 4 * (lane & 3)) * 2;
#pragma unroll
            for (int s = 0; s < 4; ++s) {
                const s16x4 l0 = vtr(vb + (16 * s) * PV), h0 = vtr(vb + (16 * s + 8) * PV), l1 = vtr(vb + (16 * s) * PV + 64), h1 = vtr(vb + (16 * s + 8) * PV + 64);
                const bf16x8 va0 = {l0[0], l0[1], l0[2], l0[3], h0[0], h0[1], h0[2], h0[3]}, va1 = {l1[0], l1[1], l1[2], l1[3], h1[0], h1[1], h1[2], h1[3]};
                oT0 = __builtin_amdgcn_mfma_f32_32x32x16_bf16(va0, pb[s], oT0, 0, 0, 0);
                oT1 = __builtin_amdgcn_mfma_f32_32x32x16_bf16(va1, pb[s], oT1, 0, 0, 0); }
        }
    };
    for (int i = 0; i < NT; i += 2) { ATT_TILE(i, kA, vA, kB, vB); ATT_TILE(i + 1, kB, vB, kA, vA); }
#undef ATT_TILE
    if (tid == 0) nxt = atomicAdd(qctr, 1u);
    const float inv = 1.f / half_sum(lsum);
    LAS unsigned char* ost = lds + OFF_OST + w * OST_W;
#pragma unroll
    for (int k = 0; k < 4; ++k) {
        u32x2_t a; a.x = pk_bf16(oT0[4 * k] * inv, oT0[4 * k + 1] * inv); a.y = pk_bf16(oT0[4 * k + 2] * inv, oT0[4 * k + 3] * inv);
        u32x2_t c; c.x = pk_bf16(oT1[4 * k] * inv, oT1[4 * k + 1] * inv); c.y = pk_bf16(oT1[4 * k + 2] * inv, oT1[4 * k + 3] * inv);
        *(LAS u32x2_t*)(ost + r32 * 144 + (8 * k + 4 * hi) * 2) = a; *(LAS u32x2_t*)(ost + r32 * 144 + (32 + 8 * k + 4 * hi) * 2) = c; }
    asm volatile("s_waitcnt lgkmcnt(0)" ::: "memory");
    bf16_t* yo = YB + (rowbase + q0 + 32 * w) * DMO + h * 64;
#pragma unroll
    for (int i = 0; i < 4; ++i) { const int row = i * 8 + (lane >> 3), ch = lane & 7; const u32x4_t v = *(const LAS u32x4_t*)(ost + row * 144 + ch * 16); *(u32x4_t*)(yo + (size_t)row * DMO + ch * 8) = v; }
    __syncthreads();
}
__device__ __forceinline__ void phase(LAS unsigned char* lds, volatile LAS unsigned* slotw, unsigned* qctr, const bf16_t* P, const float* KM, const float* KN, bf16_t* YB, int wv) {
    unsigned nxt = 0u;
    { int t0; asm volatile("v_mbcnt_lo_u32_b32 %0, -1, 0\n\tv_mbcnt_hi_u32_b32 %0, -1, %0\n\tv_lshl_add_u32 %0, %1, 6, %0" : "=&v"(t0) : "s"(wv)); if (t0 == 0) nxt = atomicAdd(qctr, 1u); }
    for (;;) {
        int tid; asm volatile("v_mbcnt_lo_u32_b32 %0, -1, 0\n\tv_mbcnt_hi_u32_b32 %0, -1, %0\n\tv_lshl_add_u32 %0, %1, 6, %0" : "=&v"(tid) : "s"(wv));
        if (tid == 0) *slotw = nxt;
        __syncthreads();
        const int idx = __builtin_amdgcn_readfirstlane((int)*slotw);
        if (idx >= NB * MH * NBLK) break;
        { int hq, qbq, bq;
          if (idx < 192) { qbq = 15 - idx / 12; const int r_ = idx % 12; hq = 7 - r_ / 4; bq = r_ & 3; }
          else { const int j_ = idx - 192; hq = 4 - (j_ >> 6); qbq = 15 - ((j_ >> 2) & 15); bq = j_ & 3; }
          unit(lds, P, KM, KN, YB, bq, hq, qbq, tid, qctr, nxt); }
    }
}
}

namespace s5 {
constexpr int CS = 256, NCH = SEQ / CS;
constexpr int U_BYTES = CS * 32, HP = 272, WAVE_LDS = U_BYTES + 16 * HP;
constexpr size_t WS_S5E = WS_ROUTE + 1 * MiB;
__device__ __forceinline__ float blo(unsigned w) { return __uint_as_float(w << 16); }
__device__ __forceinline__ float bhi(unsigned w) { return __uint_as_float(w & 0xffff0000u); }
__device__ __forceinline__ void load_u(LAS unsigned char* ul, const bf16_t* __restrict__ P, size_t row0, int g, int lane) {
#pragma unroll
    for (int i = 0; i < 4; ++i) { const int t = lane + 64 * i; const bf16_t* src = P + (row0 + t) * NPROJ + OFF_SSM + g * 16;
        const u32x4_t v0 = *(const u32x4_t*)src, v1 = *(const u32x4_t*)(src + 8);
        *(LAS u32x4_t*)(ul + t * 32) = v0; *(LAS u32x4_t*)(ul + t * 32 + 16) = v1; }
}
struct Tab { float lre, lim, bre[16], bim[16]; };
__device__ __forceinline__ void load_tab(Tab& tb, const float* __restrict__ LAM, const float* __restrict__ BB, int g, int p) {
    tb.lre = LAM[(g * SST + p) * 2]; tb.lim = LAM[(g * SST + p) * 2 + 1];
#pragma unroll
    for (int h = 0; h < 16; h += 2) { const f32x4 v = *(const f32x4*)(BB + ((g * SST + p) * 16 + h) * 2); tb.bre[h] = v[0]; tb.bim[h] = v[1]; tb.bre[h + 1] = v[2]; tb.bim[h + 1] = v[3]; }
}
__device__ __forceinline__ void step(const Tab& tb, LAS const unsigned char* ul, int t, float& hre, float& him) {
    const u32x4_t a = *(const LAS u32x4_t*)(ul + t * 32), b = *(const LAS u32x4_t*)(ul + t * 32 + 16);
    float u[16] = {blo(a.x), bhi(a.x), blo(a.y), bhi(a.y), blo(a.z), bhi(a.z), blo(a.w), bhi(a.w), blo(b.x), bhi(b.x), blo(b.y), bhi(b.y), blo(b.z), bhi(b.z), blo(b.w), bhi(b.w)};
    float bur = 0.f, bui = 0.f;
#pragma unroll
    for (int h = 0; h < 16; ++h) { bur += tb.bre[h] * u[h]; bui += tb.bim[h] * u[h]; }
    const float nre = tb.lre * hre - tb.lim * him + bur, nim = tb.lre * him + tb.lim * hre + bui;
    hre = nre; him = nim;
}
__device__ __forceinline__ void part1(LAS unsigned char* wl, const bf16_t* __restrict__ P, const float* __restrict__ LAM, const float* __restrict__ BB, float* __restrict__ E, int unit, int lane) {
    const int c = unit & 15, g = (unit >> 4) & 31, b = unit >> 9;
    Tab tb; load_tab(tb, LAM, BB, g, lane);
    load_u(wl, P, (size_t)b * SEQ + c * CS, g, lane);
    float hre = 0.f, him = 0.f;
#pragma unroll 4
    for (int t = 0; t < CS; ++t) step(tb, wl, t, hre, him);
    *(float2*)(E + ((size_t)unit * SST + lane) * 2) = make_float2(hre, him);
}
__device__ __forceinline__ void part2(LAS unsigned char* wl, const bf16_t* __restrict__ P, const float* __restrict__ LAM, const float* __restrict__ BB, const float* __restrict__ E,
                                      const float* __restrict__ c_re, const float* __restrict__ c_im, const float* __restrict__ dvec, bf16_t* __restrict__ YCPRE, int unit, int lane) {
    const int c = unit & 15, g = (unit >> 4) & 31, b = unit >> 9;
    Tab tb; load_tab(tb, LAM, BB, g, lane);
    const size_t row0 = (size_t)b * SEQ + c * CS;
    load_u(wl, P, row0, g, lane);
    const int ch = lane & 15, kq = lane >> 4;
    bf16x8 cf[4];
#pragma unroll
    for (int s = 0; s < 4; ++s) { const int k0 = (32 * s + 8 * kq) & 63; const float* src = (s < 2 ? c_re : c_im) + (size_t)(g * 16 + ch) * SST + k0; const float sg = s < 2 ? 1.f : -1.f;
        const f32x4 v0 = *(const f32x4*)src, v1 = *(const f32x4*)(src + 4);
        u32x4_t t4 = {att::pk_bf16(sg * v0[0], sg * v0[1]), att::pk_bf16(sg * v0[2], sg * v0[3]), att::pk_bf16(sg * v1[0], sg * v1[1]), att::pk_bf16(sg * v1[2], sg * v1[3])};
        cf[s] = __builtin_bit_cast(bf16x8, t4); }
    const float dch = dvec[g * 16 + ch];
    float hre = 0.f, him = 0.f;
    { float pr = tb.lre, pi = tb.lim;
#pragma unroll
      for (int i = 0; i < 8; ++i) { const float nr = pr * pr - pi * pi, ni = 2.f * pr * pi; pr = nr; pi = ni; }
      const float* e0 = E + ((size_t)(unit - c) * SST + lane) * 2;
      for (int cc = 0; cc < c; ++cc) { const float2 e = *(const float2*)(e0 + (size_t)cc * SST * 2); const float nr = pr * hre - pi * him + e.x, ni = pr * him + pi * hre + e.y; hre = nr; him = ni; } }
    LAS unsigned char* ht = wl + U_BYTES;
    for (int sub = 0; sub < CS / 16; ++sub) {
#pragma unroll 4
        for (int tt = 0; tt < 16; ++tt) { step(tb, wl, sub * 16 + tt, hre, him);
            *(LAS bf16_t*)(ht + tt * HP + lane * 2) = f2bf(hre); *(LAS bf16_t*)(ht + tt * HP + (64 + lane) * 2) = f2bf(him); }
        f32x4 acc = {0.f, 0.f, 0.f, 0.f};
#pragma unroll
        for (int s = 0; s < 4; ++s) { const bf16x8 a = *(const LAS bf16x8*)(ht + ch * HP + (32 * s + 8 * kq) * 2); acc = __builtin_amdgcn_mfma_f32_16x16x32_bf16(a, cf[s], acc, 0, 0, 0); }
#pragma unroll
        for (int r = 0; r < 4; ++r) { const int t = sub * 16 + 4 * kq + r; const float u = bf2f(*(const LAS bf16_t*)(wl + t * 32 + ch * 2));
            const float y = acc[r] + dch * u; const float gl = y * pg8::sigm(1.5957691216057308f * (y + 0.044715f * y * y * y));
            YCPRE[(row0 + t) * DSS + g * 16 + ch] = f2bf(gl); }
    }
}
constexpr int BUP = 272, WAVE_LDS2 = U_BYTES + 16 * HP + 16 * BUP;
struct Tab2 { float lre, lim; bf16x8 bb[8]; };
__device__ __forceinline__ void load_tab2(Tab2& tb, const float* __restrict__ LAM, const float* __restrict__ BB, int g, int lane) {
    tb.lre = LAM[(g * SST + lane) * 2]; tb.lim = LAM[(g * SST + lane) * 2 + 1];
    const int fr = lane & 15, kq = lane >> 4;
#pragma unroll
    for (int nt = 0; nt < 8; ++nt) { u32x4_t t4 = {0u, 0u, 0u, 0u};
        if (kq < 2) t4 = *(const u32x4_t*)((const unsigned char*)BB + (SM_BBF - SM_BB) + (size_t)(((g * 8 + nt) * 32 + (lane & 31)) * 16));
        tb.bb[nt] = __builtin_bit_cast(bf16x8, t4); }
}
__device__ __forceinline__ void bu_group(const Tab2& tb, LAS const unsigned char* ul, LAS unsigned char* but, int g16, int lane) {
    const int fr = lane & 15, kq = lane >> 4;
    u32x4_t ub = {0u, 0u, 0u, 0u}; if (kq < 2) ub = *(const LAS u32x4_t*)(ul + (16 * g16 + fr) * 32 + kq * 16);
    const bf16x8 uf = __builtin_bit_cast(bf16x8, ub);
#pragma unroll
    for (int nt = 0; nt < 8; ++nt) { const f32x4 d = __builtin_amdgcn_mfma_f32_16x16x32_bf16(tb.bb[nt], uf, (f32x4){0.f, 0.f, 0.f, 0.f}, 0, 0, 0);
        u32x2_t_ o = {att::pk_bf16(d[0], d[1]), att::pk_bf16(d[2], d[3])};
        *(LAS u32x2_t_*)(but + fr * BUP + (16 * nt + 4 * kq) * 2) = o; }
}
__device__ __forceinline__ void part1b(LAS unsigned char* wl, const bf16_t* __restrict__ P, const float* __restrict__ LAM, const float* __restrict__ BB, float* __restrict__ E, int unit, int lane) {
    const int c = unit & 15, g = (unit >> 4) & 31, b = unit >> 9;
    Tab2 tb; load_tab2(tb, LAM, BB, g, lane);
    load_u(wl, P, (size_t)b * SEQ + c * CS, g, lane);
    LAS unsigned char* but = wl + U_BYTES + 16 * HP;
    float hre = 0.f, him = 0.f;
    for (int g16 = 0; g16 < CS / 16; ++g16) {
        bu_group(tb, wl, but, g16, lane); asm volatile("" ::: "memory");
#pragma unroll
        for (int tt = 0; tt < 16; ++tt) { const unsigned w_ = *(const LAS unsigned*)(but + tt * BUP + lane * 4); const float bur = blo(w_), bui = bhi(w_);
            const float nre = tb.lre * hre - tb.lim * him + bur, nim = tb.lre * him + tb.lim * hre + bui; hre = nre; him = nim; }
    }
    *(float2*)(E + ((size_t)unit * SST + lane) * 2) = make_float2(hre, him);
}
__device__ __forceinline__ void part2b(LAS unsigned char* wl, const bf16_t* __restrict__ P, const float* __restrict__ LAM, const float* __restrict__ BB, const float* __restrict__ E,
                                       const float* __restrict__ c_re, const float* __restrict__ c_im, const float* __restrict__ dvec, bf16_t* __restrict__ YCPRE, int unit, int lane) {
    const int c = unit & 15, g = (unit >> 4) & 31, b = unit >> 9;
    Tab2 tb; load_tab2(tb, LAM, BB, g, lane);
    const size_t row0 = (size_t)b * SEQ + c * CS;
    load_u(wl, P, row0, g, lane);
    const int ch = lane & 15, kq = lane >> 4;
    bf16x8 cf[4];
#pragma unroll
    for (int s = 0; s < 4; ++s) { const int p0 = 16 * s + 4 * kq;
        const f32x4 vr_ = *(const f32x4*)(c_re + (size_t)(g * 16 + ch) * SST + p0), vi_ = *(const f32x4*)(c_im + (size_t)(g * 16 + ch) * SST + p0);
        u32x4_t t4 = {att::pk_bf16(vr_[0], -vi_[0]), att::pk_bf16(vr_[1], -vi_[1]), att::pk_bf16(vr_[2], -vi_[2]), att::pk_bf16(vr_[3], -vi_[3])};
        cf[s] = __builtin_bit_cast(bf16x8, t4); }
    const float dch = dvec[g * 16 + ch];
    float hre = 0.f, him = 0.f;
    { float pr = tb.lre, pi = tb.lim;
#pragma unroll
      for (int i = 0; i < 8; ++i) { const float nr = pr * pr - pi * pi, ni = 2.f * pr * pi; pr = nr; pi = ni; }
      const float* e0 = E + ((size_t)(unit - c) * SST + lane) * 2;
      float2 ev[15];
#pragma unroll
      for (int cc = 0; cc < 15; ++cc) { ev[cc] = make_float2(0.f, 0.f); if (cc < c) ev[cc] = *(const float2*)(e0 + (size_t)cc * SST * 2); }
#pragma unroll
      for (int cc = 0; cc < 15; ++cc) if (cc < c) { const float nr = pr * hre - pi * him + ev[cc].x, ni = pr * him + pi * hre + ev[cc].y; hre = nr; him = ni; } }
    LAS unsigned char* ht = wl + U_BYTES; LAS unsigned char* but = ht + 16 * HP;
    for (int sub = 0; sub < CS / 16; ++sub) {
        bu_group(tb, wl, but, sub, lane); asm volatile("" ::: "memory");
#pragma unroll
        for (int tt = 0; tt < 16; ++tt) { const unsigned w_ = *(const LAS unsigned*)(but + tt * BUP + lane * 4); const float bur = blo(w_), bui = bhi(w_);
            const float nre = tb.lre * hre - tb.lim * him + bur, nim = tb.lre * him + tb.lim * hre + bui; hre = nre; him = nim;
            *(LAS unsigned*)(ht + tt * HP + lane * 4) = att::pk_bf16(hre, him); }
        asm volatile("" ::: "memory");
        f32x4 acc = {0.f, 0.f, 0.f, 0.f};
#pragma unroll
        for (int s = 0; s < 4; ++s) { const bf16x8 a = *(const LAS bf16x8*)(ht + ch * HP + (32 * s + 8 * kq) * 2); acc = __builtin_amdgcn_mfma_f32_16x16x32_bf16(a, cf[s], acc, 0, 0, 0); }
#pragma unroll
        for (int r = 0; r < 4; ++r) { const int t = sub * 16 + 4 * kq + r; const float u = bf2f(*(const LAS bf16_t*)(wl + t * 32 + ch * 2));
            const float y = acc[r] + dch * u; const float gl = y * pg8::sigm(1.5957691216057308f * (y + 0.044715f * y * y * y));
            YCPRE[(row0 + t) * DSS + g * 16 + ch] = f2bf(gl); }
        asm volatile("" ::: "memory");
    }
}
}

namespace wkv {
constexpr int CH = 64, NCHK = SEQ / CH;
constexpr size_t WS_GST = 320 * MiB, WS_GYT = 336 * MiB, WS_YLT = 368 * MiB, WS_SLT = 416 * MiB;
constexpr size_t WS_PEND = WS_ROUTE + 2 * MiB;
constexpr size_t WS_RK = WS_ROUTE + 3 * MiB;
constexpr size_t SM_W2T = 1 * MiB, SM_A2T = SM_W2T + 65536, SM_G2T = SM_A2T + 65536;
constexpr int PB = 144;
constexpr int L_CST = 147456;
constexpr int L_ACT = 109568, ACT_P = 528;
constexpr int L_SW = 33792, L_SA = L_SW + 16640, L_SG = L_SA + 16640, L_LW = 83712, LP = 65;
constexpr int L_PART = 33792;
constexpr int M_AT = 0, M_RT = 9216, M_BT = 18432, M_KT = 27648, M_BH = 36864, M_KH = 46080, M_VT = 55296;
constexpr int L_NABT = 64512, NAB_P = 272, L_NAK = 81920, L_NBRT = 91136, L_NKRT = 100352;
constexpr int M_W1 = M_AT, M_M2T = L_NAK;
static_assert(L_NABT + 64 * NAB_P <= L_NAK && L_NAK + 9216 <= L_NBRT && L_NBRT + 9216 <= L_NKRT && L_NKRT + 9216 <= L_ACT && L_LW + 16640 <= L_ACT && L_ACT + 64 * ACT_P <= 143360, "wkv LDS map");

typedef unsigned u32x2_t __attribute__((ext_vector_type(2)));
using att::pk_bf16;
template <int CTRL> __device__ __forceinline__ float dppx(float v) { return __builtin_bit_cast(float, __builtin_amdgcn_update_dpp(0, __builtin_bit_cast(int, v), CTRL, 0xF, 0xF, false)); }
__device__ __forceinline__ float sum8(float v) { v += dppx<0xB1>(v); v += dppx<0x4E>(v); v += dppx<0x141>(v); return v; }
__device__ __forceinline__ bf16x8 ld8(LAS const unsigned char* p) { return *(const LAS bf16x8*)p; }
__device__ __forceinline__ bf16x8 ld44(LAS const unsigned char* p0, LAS const unsigned char* p1) { const u32x2_t a = *(const LAS u32x2_t*)p0, b = *(const LAS u32x2_t*)p1; u32x4_t t = {a.x, a.y, b.x, b.y}; return __builtin_bit_cast(bf16x8, t); }
__device__ __forceinline__ bf16x8 acc2b(const f32x4& x, const f32x4& y) { u32x4_t t = {pk_bf16(x[0], x[1]), pk_bf16(x[2], x[3]), pk_bf16(y[0], y[1]), pk_bf16(y[2], y[3])}; return __builtin_bit_cast(bf16x8, t); }
#define MFMA16(a, b, c) __builtin_amdgcn_mfma_f32_16x16x32_bf16(a, b, c, 0, 0, 0)
__device__ __forceinline__ int tsw(int row) { return ((row >> 3) & 7) << 4; }

template <int TT> __device__ __forceinline__ void sub4_step(float (&xq)[16], LAS const unsigned char* nbq  , int sub) {
    constexpr int NV = (TT + 15) / 16;
    f32x4 nv[NV > 0 ? NV : 1];
#pragma unroll
    for (int k = 0; k < NV; ++k) nv[k] = *(const LAS f32x4*)(nbq + TT * NAB_P + k * 16);
    float a4[4] = {(sub == (TT & 3)) ? xq[TT >> 2] : 0.f, 0.f, 0.f, 0.f};
#pragma unroll
    for (int k = 0; k < NV; ++k)
#pragma unroll
        for (int e = 0; e < 4; ++e) a4[e] += xq[4 * k + e] * nv[k][e];
    float v = (a4[0] + a4[1]) + (a4[2] + a4[3]);
    v += dppx<0xB1>(v); v += dppx<0x4E>(v);
    xq[TT >> 2] = (sub == (TT & 3)) ? v : xq[TT >> 2];
}
template <int T0, int T1> struct Sub4 { static __device__ __forceinline__ void go(float (&xq)[16], LAS const unsigned char* nbq, int sub) { sub4_step<T0>(xq, nbq, sub); Sub4<T0 + 1, T1>::go(xq, nbq, sub); } };
template <int T1> struct Sub4<T1, T1> { static __device__ __forceinline__ void go(float (&)[16], LAS const unsigned char*, int) {} };

struct PreArgs { const bf16_t* P; const float *mu, *w0, *a0, *k_k, *k_a, *r_k; const bf16_t *w2t, *a2t, *g2t; bf16_t *Vo, *Go; float* RK; bf16_t *GST, *GYT; float *YLT, *SLT, *PEND; };

#define LBAR() asm volatile("s_waitcnt lgkmcnt(0)\n\ts_barrier" ::: "memory")
__device__ __forceinline__ void act_tile(LAS unsigned char* lds, const PreArgs& A, int b, int c, int tid) {
    const size_t row0 = (size_t)b * SEQ + c * CH; const bool seq0 = (c == 0);
    const int i8 = tid & 31, tr = tid >> 5, col = 1536 + 8 * i8;
    const float ka = i8 < 8 ? 2.f : 1.f, kc = i8 < 8 ? -1.f : 0.f; const bool ident = (i8 >= 8) && (i8 < 16);
    u32x4_t zc0[4], zp0[4];
#pragma unroll
    for (int k = 0; k < 4; ++k) { const int tt = tr + 16 * k; const bf16_t* rp = A.P + (row0 + tt) * NPROJ + col;
        zc0[k] = __builtin_nontemporal_load((const u32x4_t*)rp); zp0[k] = (u32x4_t){0u, 0u, 0u, 0u}; if (!(seq0 && tt == 0)) zp0[k] = __builtin_nontemporal_load((const u32x4_t*)(rp - NPROJ)); }
    const f32x4 m0a = *(const f32x4*)(A.mu + col), m0b = *(const f32x4*)(A.mu + col + 4);
#pragma unroll
    for (int k = 0; k < 4; ++k) { const int tt = tr + 16 * k; const u32x4_t zc = zc0[k], zp = zp0[k];
        float z[8] = {s5::blo(zc.x), s5::bhi(zc.x), s5::blo(zc.y), s5::bhi(zc.y), s5::blo(zc.z), s5::bhi(zc.z), s5::blo(zc.w), s5::bhi(zc.w)};
        const float zq[8] = {s5::blo(zp.x), s5::bhi(zp.x), s5::blo(zp.y), s5::bhi(zp.y), s5::blo(zp.z), s5::bhi(zp.z), s5::blo(zp.w), s5::bhi(zp.w)};
#pragma unroll
        for (int e = 0; e < 8; ++e) { const float mm = e < 4 ? m0a[e] : m0b[e - 4]; const float x = z[e] + (zq[e] - z[e]) * mm;
            const float sg = __builtin_amdgcn_rcpf(1.f + __expf(-ka * x));
            z[e] = ident ? x : ka * sg + kc; }
        u32x4_t o = {pk_bf16(z[0], z[1]), pk_bf16(z[2], z[3]), pk_bf16(z[4], z[5]), pk_bf16(z[6], z[7])};
        *(LAS u32x4_t*)(lds + L_ACT + tt * ACT_P + i8 * 16) = o; }
    LBAR();
}
__device__ __forceinline__ void load_lb(bf16x8 (&lb)[8][2], const PreArgs& A, int h, int tid) {
    asm volatile("" : "+v"(tid));
    const int lane = tid & 63, wv = __builtin_amdgcn_readfirstlane(tid >> 6), fr = lane & 15, q = lane >> 4, nh = wv >> 2;
#pragma unroll
    for (int s = 0; s < 8; ++s)
#pragma unroll
        for (int nn = 0; nn < 2; ++nn) { const unsigned ch = (unsigned)(64 * h + 16 * (2 * nh + nn) + fr);
            lb[s][nn] = s < 2 ? *(const bf16x8*)(A.w2t + (ch * 64u + (unsigned)(32 * s + 8 * q))) : s < 4 ? *(const bf16x8*)(A.a2t + (ch * 64u + (unsigned)(32 * (s - 2) + 8 * q))) : *(const bf16x8*)(A.g2t + (ch * 128u + (unsigned)(32 * (s - 4) + 8 * q))); }
}
__device__ __forceinline__ void load_z(u32x4_t (&zc)[3], u32x4_t (&zp)[3], const PreArgs& A, size_t row0, bool seq0, int h, int tid) {
    asm volatile("" : "+v"(tid));
    const int t = tid >> 3, j8 = tid & 7, ch0 = 64 * h + 8 * j8;
    const bf16_t* rb = A.P + row0 * NPROJ;
    const int o = t * NPROJ + ch0; const bool first = seq0 && t == 0;
#pragma unroll
    for (int part = 0; part < 3; ++part) { zc[part] = __builtin_nontemporal_load((const u32x4_t*)(rb + (o + 512 * part))); zp[part] = (u32x4_t){0u, 0u, 0u, 0u}; if (!first) zp[part] = __builtin_nontemporal_load((const u32x4_t*)(rb + (o + 512 * part - NPROJ))); }
}
__device__ __forceinline__ void unit_pre(LAS unsigned char* lds, const PreArgs& A, int u, int tid, bf16x8 (&lb)[8][2], u32x4_t (&zc1)[3], u32x4_t (&zp1)[3]) {
    asm volatile("" : "+v"(tid));
    const int lane = tid & 63, wv = __builtin_amdgcn_readfirstlane(tid >> 6), fr = lane & 15, q = lane >> 4;
    const int c = u & 63, h = (u >> 6) & 7, b = u >> 9;
    const size_t row0 = (size_t)b * SEQ + c * CH;
    const bool seq0 = (c == 0);
    const int t = tid >> 3, j8 = tid & 7, j0 = 8 * j8, ch0 = 64 * h + j0;
#ifdef PROBE_UP
    volatile LAS unsigned long long* ts_ = (volatile LAS unsigned long long*)(lds + 143360 + 2048); const bool pr_ = blockIdx.x == 0 && tid == 0; unsigned long long tp0_ = 0, tp1_ = 0;
    if (pr_) tp0_ = __builtin_amdgcn_s_memrealtime();
#endif
    { const int m = wv & 3, nh = wv >> 2; f32x4 aw[2] = {{0.f, 0.f, 0.f, 0.f}, {0.f, 0.f, 0.f, 0.f}}, aa[2] = {aw[0], aw[0]}, ag[2] = {aw[0], aw[0]};
#pragma unroll
      for (int s = 0; s < 8; ++s) { const bf16x8 af = ld8(lds + L_ACT + (16 * m + fr) * ACT_P + (32 * s + 8 * q) * 2);
#pragma unroll
          for (int nn = 0; nn < 2; ++nn) {
              if (s < 2) aw[nn] = MFMA16(af, lb[s][nn], aw[nn]); else if (s < 4) aa[nn] = MFMA16(af, lb[s][nn], aa[nn]); else ag[nn] = MFMA16(af, lb[s][nn], ag[nn]); } }
#pragma unroll
      for (int nn = 0; nn < 2; ++nn)
#pragma unroll
          for (int r = 0; r < 4; ++r) { const int off = ((16 * m + 4 * q + r) * LP + 16 * (2 * nh + nn) + fr) * 4;
              *(LAS float*)(lds + L_SW + off) = aw[nn][r]; *(LAS float*)(lds + L_SA + off) = aa[nn][r]; *(LAS float*)(lds + L_SG + off) = ag[nn][r]; } }
    LBAR();
    float r_[8], kp_[8], b_[8], an_[8], v_[8];
    { float lw[8], g_[8]; float ss = 0.f, rk = 0.f;
#pragma unroll
      for (int part = 0; part < 3; ++part) {
          const u32x4_t zc = zc1[part], zp = zp1[part]; const f32x4 m0 = *(const LAS f32x4*)(lds + L_CST + (512 * part + ch0) * 4), m1 = *(const LAS f32x4*)(lds + L_CST + (512 * part + ch0 + 4) * 4);
          const float z[8] = {s5::blo(zc.x), s5::bhi(zc.x), s5::blo(zc.y), s5::bhi(zc.y), s5::blo(zc.z), s5::bhi(zc.z), s5::blo(zc.w), s5::bhi(zc.w)};
          const float zq[8] = {s5::blo(zp.x), s5::bhi(zp.x), s5::blo(zp.y), s5::bhi(zp.y), s5::blo(zp.z), s5::bhi(zp.z), s5::blo(zp.w), s5::bhi(zp.w)};
#pragma unroll
          for (int e = 0; e < 8; ++e) { const float x = z[e] + (zq[e] - z[e]) * (e < 4 ? m0[e] : m1[e - 4]); if (part == 0) r_[e] = x; else if (part == 1) kp_[e] = x; else v_[e] = x; } }
      float kk[8];
      LAS const unsigned char* cst = lds + L_CST + (1536 + ch0) * 4;
      const f32x4 w0a = *(const LAS f32x4*)cst, w0b = *(const LAS f32x4*)(cst + 16), a0a = *(const LAS f32x4*)(cst + 2048), a0b = *(const LAS f32x4*)(cst + 2048 + 16);
      const f32x4 kka = *(const LAS f32x4*)(cst + 4096), kkb = *(const LAS f32x4*)(cst + 4096 + 16), kaa = *(const LAS f32x4*)(cst + 6144), kab = *(const LAS f32x4*)(cst + 6144 + 16);
      const f32x4 rka = *(const LAS f32x4*)(cst + 8192), rkb = *(const LAS f32x4*)(cst + 8192 + 16);
#pragma unroll
      for (int e = 0; e < 8; ++e) { const int off = (t * LP + j0 + e) * 4;
          const float sw = *(const LAS float*)(lds + L_SW + off), sa = *(const LAS float*)(lds + L_SA + off); g_[e] = *(const LAS float*)(lds + L_SG + off);
          const float xx = -((e < 4 ? w0a[e] : w0b[e - 4]) + sw);
          const float sp = fmaxf(xx, 0.f) + __logf(1.f + __expf(-fabsf(xx)));
          lw[e] = -__expf(-sp - 0.5f);
          const float a = pg8::sigm((e < 4 ? a0a[e] : a0b[e - 4]) + sa);
          const float k = kp_[e];
          kk[e] = k * (e < 4 ? kka[e] : kkb[e - 4]); ss += kk[e] * kk[e];
          kp_[e] = k * (1.f + (a - 1.f) * (e < 4 ? kaa[e] : kab[e - 4]));
          rk += r_[e] * kp_[e] * (e < 4 ? rka[e] : rkb[e - 4]);
          b_[e] = a; }
      ss = sum8(ss); rk = sum8(rk);
      const float rs = rsqrtf(fmaxf(ss, 1e-24f));
#pragma unroll
      for (int e = 0; e < 8; ++e) { const float kn = kk[e] * rs; an_[e] = -kn; b_[e] = kn * b_[e]; *(LAS float*)(lds + L_LW + (t * LP + j0 + e) * 4) = lw[e]; }
      if (j8 == 0) A.RK[(row0 + t) * 8 + h] = rk;
      u32x4_t ov = {pk_bf16(v_[0], v_[1]), pk_bf16(v_[2], v_[3]), pk_bf16(v_[4], v_[5]), pk_bf16(v_[6], v_[7])}, og = {pk_bf16(g_[0], g_[1]), pk_bf16(g_[2], g_[3]), pk_bf16(g_[4], g_[5]), pk_bf16(g_[6], g_[7])};
      *(u32x4_t*)(A.Vo + (row0 + t) * DR + ch0) = ov; *(u32x4_t*)(A.Go + (row0 + t) * DR + ch0) = og; }
    LBAR();
    { const int j = tid & 63, part = tid >> 6; float s = 0.f;
#pragma unroll
      for (int e = 0; e < 8; ++e) { LAS float* p = (LAS float*)(lds + L_LW + ((8 * part + e) * LP + j) * 4); s += *p; *p = s; }
      *(LAS float*)(lds + L_PART + (part * 64 + j) * 4) = s;
      LBAR();
      float o = 0.f;
      for (int pp = 0; pp < part; ++pp) o += *(const LAS float*)(lds + L_PART + (pp * 64 + j) * 4);
#pragma unroll
      for (int e = 0; e < 8; ++e) { LAS float* p = (LAS float*)(lds + L_LW + ((8 * part + e) * LP + j) * 4); *p += o; } }
    LBAR();
    { float lp[8], lpm[8], lpe[8];
#pragma unroll
      for (int e = 0; e < 8; ++e) { lp[e] = *(const LAS float*)(lds + L_LW + (t * LP + j0 + e) * 4); lpm[e] = t > 0 ? *(const LAS float*)(lds + L_LW + ((t - 1) * LP + j0 + e) * 4) : 0.f;
          lpe[e] = *(const LAS float*)(lds + L_LW + (63 * LP + j0 + e) * 4); }
      LBAR();
      float at[8], rt[8], bt[8], kt[8], bh[8], kh[8];
#pragma unroll
      for (int e = 0; e < 8; ++e) { const float Pt = __expf(lp[e]), Pm = __expf(lpm[e]), Pi = __expf(-lp[e]), Pe = __expf(lpe[e] - lp[e]);
          at[e] = an_[e] * Pm; rt[e] = r_[e] * Pt; bt[e] = b_[e] * Pi; kt[e] = kp_[e] * Pi; bh[e] = b_[e] * Pe; kh[e] = kp_[e] * Pe;
          if (t == 0) A.PEND[(size_t)u * 64 + j0 + e] = __expf(lpe[e]); }
      auto st8 = [&](int base, const float* x) { u32x4_t o = {pk_bf16(x[0], x[1]), pk_bf16(x[2], x[3]), pk_bf16(x[4], x[5]), pk_bf16(x[6], x[7])}; *(LAS u32x4_t*)(lds + base + t * PB + j0 * 2) = o; };
      st8(M_AT, at); st8(M_RT, rt); st8(M_BT, bt); st8(M_KT, kt);
#pragma unroll
      for (int e = 0; e < 8; ++e) { *(LAS bf16_t*)(lds + M_BH + (j0 + e) * PB + ((t * 2) ^ (j8 << 4))) = f2bf(bh[e]); *(LAS bf16_t*)(lds + M_KH + (j0 + e) * PB + ((t * 2) ^ (j8 << 4))) = f2bf(kh[e]); *(LAS bf16_t*)(lds + M_VT + (j0 + e) * PB + ((t * 2) ^ (j8 << 4))) = f2bf(v_[e]); } }
    LBAR();
#ifdef PROBE_UP
    if (pr_) { tp1_ = __builtin_amdgcn_s_memrealtime(); ts_[44] += tp1_ - tp0_; }
#endif
    { const int rt = wv >> 1;
#pragma unroll
      for (int cc = 0; cc < 2; ++cc) { const int ct = 2 * (wv & 1) + cc; f32x4 nab = {0.f, 0.f, 0.f, 0.f}, nak = nab;
#pragma unroll
          for (int kk = 0; kk < 2; ++kk) { const int ko = (32 * kk + 8 * q) * 2;
              const bf16x8 bfr = ld8(lds + M_AT + (16 * ct + fr) * PB + ko);
              nab = MFMA16(ld8(lds + M_BT + (16 * rt + fr) * PB + ko), bfr, nab); nak = MFMA16(ld8(lds + M_KT + (16 * rt + fr) * PB + ko), bfr, nak); }
          const int tt = 16 * ct + fr, s0 = 16 * rt + 4 * q;
#pragma unroll
          for (int r = 0; r < 4; ++r) { if (!(s0 + r < tt)) { nab[r] = 0.f; nak[r] = 0.f; } *(LAS bf16_t*)(lds + L_NAK + (s0 + r) * PB + tt * 2) = f2bf(nak[r]); }
#pragma unroll
          for (int r = 0; r < 4; ++r) *(LAS float*)(lds + L_NABT + tt * NAB_P + r * 64 + (4 * rt + q) * 4) = nab[r]; } }
    LBAR();
    for (int tl = wv; tl < 32; tl += 8) { const int mat = tl >> 4, rt = (tl >> 2) & 3, ct = tl & 3; f32x4 nn = {0.f, 0.f, 0.f, 0.f};
#pragma unroll
        for (int kk = 0; kk < 2; ++kk) { const int ko = (32 * kk + 8 * q) * 2;
            nn = MFMA16(ld8(lds + (mat ? M_KT : M_BT) + (16 * rt + fr) * PB + ko), ld8(lds + M_RT + (16 * ct + fr) * PB + ko), nn); }
        const int tt = 16 * ct + fr, s0 = 16 * rt + 4 * q;
#pragma unroll
        for (int r = 0; r < 4; ++r) if (!(s0 + r <= tt)) nn[r] = 0.f;
        u32x2_t o = {pk_bf16(nn[0], nn[1]), pk_bf16(nn[2], nn[3])};
        *(LAS u32x2_t*)(lds + (mat ? L_NKRT : L_NBRT) + tt * PB + s0 * 2) = o; }
    { const int R = tid >> 2, sub = tid & 3; float xq[16];
      if (wv < 4) {
#pragma unroll
          for (int i = 0; i < 16; ++i) xq[i] = bf2f(*(const LAS bf16_t*)(lds + M_AT + (4 * i + sub) * PB + R * 2));
      } else {
#pragma unroll
          for (int i = 0; i < 16; ++i) xq[i] = bf2f(*(const LAS bf16_t*)(lds + L_NAK + (R - 64) * PB + (4 * i + sub) * 2));
      }
      { LAS const unsigned char* nbq = lds + L_NABT + sub * 64; asm volatile("" : "+v"(nbq)); Sub4<0, 64>::go(xq, nbq, sub); }
      LBAR();
      if (wv < 4) {
#pragma unroll
          for (int i = 0; i < 16; ++i) *(LAS bf16_t*)(lds + M_W1 + R * PB + (4 * i + sub) * 2) = f2bf(xq[i]);
      } else {
#pragma unroll
          for (int i = 0; i < 16; ++i) *(LAS bf16_t*)(lds + M_M2T + (4 * i + sub) * PB + (R - 64) * 2) = f2bf(xq[i]);
      } }
    LBAR();
#ifdef PROBE_UP
    if (pr_) { tp0_ = __builtin_amdgcn_s_memrealtime(); ts_[45] += tp0_ - tp1_; }
#endif
    if (h + 1 < RH) { load_lb(lb, A, h + 1, tid); load_z(zc1, zp1, A, row0, seq0, h + 1, tid); }
    {
      const int cta = wv & 3, s = wv >> 2;
      f32x4 gy[2], gs[2];
#pragma unroll
      for (int hh = 0; hh < 2; ++hh) { const int rt = 2 * s + hh;
          const u32x2_t rr = *(const LAS u32x2_t*)(lds + M_RT + (16 * cta + fr) * PB + (16 * rt + 4 * q) * 2);
          gy[hh] = (f32x4){s5::blo(rr.x), s5::bhi(rr.x), s5::blo(rr.y), s5::bhi(rr.y)}; gs[hh] = (f32x4){0.f, 0.f, 0.f, 0.f};
#pragma unroll
          for (int kk = 0; kk < 2; ++kk) { const int ko = (32 * kk + 8 * q) * 2; const bf16x8 w1 = ld8(lds + M_W1 + (16 * rt + fr) * PB + ko);
              gy[hh] = MFMA16(w1, ld8(lds + L_NBRT + (16 * cta + fr) * PB + ko), gy[hh]);
              gs[hh] = MFMA16(w1, ld8(lds + M_BH + (16 * cta + fr) * PB + (ko ^ tsw(16 * cta + fr))), gs[hh]); } }
      *(bf16x8*)(A.GYT + (size_t)u * 4096 + ((cta * 2 + s) * 64 + lane) * 8) = acc2b(gy[0], gy[1]);
      *(bf16x8*)(A.GST + (size_t)u * 4096 + ((cta * 2 + s) * 64 + lane) * 8) = acc2b(gs[0], gs[1]); }
    {
      const int vi = wv & 3, mh = wv >> 2;
      f32x4 vw[4];
#pragma unroll
      for (int rt = 0; rt < 4; ++rt) { vw[rt] = (f32x4){0.f, 0.f, 0.f, 0.f};
#pragma unroll
          for (int kk = 0; kk < 2; ++kk) { const int ko = (32 * kk + 8 * q) * 2; vw[rt] = MFMA16(ld8(lds + M_M2T + (16 * rt + fr) * PB + ko), ld8(lds + M_VT + (16 * vi + fr) * PB + (ko ^ tsw(16 * vi + fr))), vw[rt]); } }
      const bf16x8 vb0 = acc2b(vw[0], vw[1]), vb1 = acc2b(vw[2], vw[3]);
#pragma unroll
      for (int hh = 0; hh < 2; ++hh) { const int m = 2 * mh + hh; f32x4 yl = {0.f, 0.f, 0.f, 0.f}, sl = yl;
          LAS const unsigned char* nb = lds + L_NBRT + (16 * m + fr) * PB; LAS const unsigned char* bhp = lds + M_BH + (16 * m + fr) * PB;
          yl = MFMA16(ld44(nb + (4 * q) * 2, nb + (16 + 4 * q) * 2), vb0, yl); yl = MFMA16(ld44(nb + (32 + 4 * q) * 2, nb + (48 + 4 * q) * 2), vb1, yl);
          { const int zs = tsw(16 * m + fr); sl = MFMA16(ld44(bhp + (((4 * q) * 2) ^ zs), bhp + (((16 + 4 * q) * 2) ^ zs)), vb0, sl); sl = MFMA16(ld44(bhp + (((32 + 4 * q) * 2) ^ zs), bhp + (((48 + 4 * q) * 2) ^ zs)), vb1, sl); }
#pragma unroll
          for (int kk = 0; kk < 2; ++kk) { const int ko = (32 * kk + 8 * q) * 2; const bf16x8 vf = ld8(lds + M_VT + (16 * vi + fr) * PB + (ko ^ tsw(16 * vi + fr)));
              yl = MFMA16(ld8(lds + L_NKRT + (16 * m + fr) * PB + ko), vf, yl); sl = MFMA16(ld8(lds + M_KH + (16 * m + fr) * PB + (ko ^ tsw(16 * m + fr))), vf, sl); }
          { u32x2_t o = {pk_bf16(yl[0], yl[1]), pk_bf16(yl[2], yl[3])}; *(u32x2_t*)((bf16_t*)A.YLT + (size_t)u * 4096 + ((vi * 4 + m) * 64 + lane) * 4) = o; }
          { u32x2_t o = {pk_bf16(sl[0], sl[1]), pk_bf16(sl[2], sl[3])}; *(u32x2_t*)((bf16_t*)A.SLT + (size_t)u * 4096 + ((vi * 4 + m) * 64 + lane) * 4) = o; } } }
    LBAR();
}

__device__ __forceinline__ void seq(const bf16_t* __restrict__ GST, const bf16_t* __restrict__ GYT, const float* __restrict__ YLT, const float* __restrict__ SLT, const float* __restrict__ PEND,
                                    float* __restrict__ YRAW, int bh, int vi, int lane) {
    const int fr = lane & 15, q = lane >> 4, b = bh >> 3, h = bh & 7;
    f32x4 st[4] = {{0.f, 0.f, 0.f, 0.f}, {0.f, 0.f, 0.f, 0.f}, {0.f, 0.f, 0.f, 0.f}, {0.f, 0.f, 0.f, 0.f}};
    for (int c = 0; c < NCHK; ++c) {
        const size_t u = (size_t)bh * 64 + c;
        bf16x8 gs[4][2], gy[4][2]; f32x4 pe[4], sl[4], yl[4];
#pragma unroll
        for (int a = 0; a < 4; ++a) {
#pragma unroll
            for (int s = 0; s < 2; ++s) { gs[a][s] = *(const bf16x8*)(GST + u * 4096 + ((a * 2 + s) * 64 + lane) * 8); gy[a][s] = *(const bf16x8*)(GYT + u * 4096 + ((a * 2 + s) * 64 + lane) * 8); }
            pe[a] = *(const f32x4*)(PEND + u * 64 + 16 * a + 4 * q);
            sl[a] = *(const f32x4*)(SLT + u * 4096 + ((vi * 4 + a) * 64 + lane) * 4); yl[a] = *(const f32x4*)(YLT + u * 4096 + ((vi * 4 + a) * 64 + lane) * 4); }
        const bf16x8 sb0 = acc2b(st[0], st[1]), sb1 = acc2b(st[2], st[3]);
#pragma unroll
        for (int m = 0; m < 4; ++m) { f32x4 y = MFMA16(gy[m][0], sb0, yl[m]); y = MFMA16(gy[m][1], sb1, y);
#pragma unroll
            for (int r = 0; r < 4; ++r) YRAW[((size_t)b * SEQ + c * CH + 16 * m + 4 * q + r) * DR + h * 64 + 16 * vi + fr] = y[r]; }
#pragma unroll
        for (int a = 0; a < 4; ++a) { f32x4 n = sl[a] + pe[a] * st[a]; n = MFMA16(gs[a][0], sb0, n); n = MFMA16(gs[a][1], sb1, n); st[a] = n; }
    }
}
#ifdef PROBE_SQ
#define SQP0() unsigned long long sq0_ = 0, sq1_ = 0; const bool sqp_ = blockIdx.x == 0 && tid == PROBE_SQ_TID; if (sqp_) sq0_ = __builtin_amdgcn_s_memrealtime()
#define SQP1() if (sqp_) { sq1_ = __builtin_amdgcn_s_memrealtime(); ((volatile LAS unsigned long long*)(lds + 143360 + 2048))[54] += sq1_ - sq0_; }
#define SQP2() if (sqp_) { ((volatile LAS unsigned long long*)(lds + 143360 + 2048))[55] += __builtin_amdgcn_s_memrealtime() - sq1_; }
#else
#define SQP0()
#define SQP1()
#define SQP2()
#endif
struct SetG { bf16x8 g[4][2]; u32x2_t locp[4]; };
__device__ __forceinline__ void load_set(SetG& z, bool state, const bf16_t* __restrict__ GST, const bf16_t* __restrict__ GYT, const float* __restrict__ YLT, const float* __restrict__ SLT, size_t u_, int vi, int lane) {
    const unsigned u = (unsigned)u_;
    asm volatile("" : "+v"(lane));
    const bf16_t* gp = state ? GST : GYT; const bf16_t* lp = (const bf16_t*)(state ? SLT : YLT);
#pragma unroll
    for (int a = 0; a < 4; ++a) {
#pragma unroll
        for (int s = 0; s < 2; ++s) z.g[a][s] = __builtin_nontemporal_load((const bf16x8*)(gp + (u * 4096u + (unsigned)(((a * 2 + s) * 64 + lane) * 8))));
        z.locp[a] = __builtin_nontemporal_load((const u32x2_t*)(lp + (u * 4096u + (unsigned)(((vi * 4 + a) * 64 + lane) * 4)))); }
}
__device__ __forceinline__ f32x4 unpk4(const u32x2_t w) { return (f32x4){s5::blo(w.x), s5::bhi(w.x), s5::blo(w.y), s5::bhi(w.y)}; }
struct PostArgs { const bf16_t* V; const bf16_t* GG; const float* RK; const float* ln_w; const float* ln_b; bf16_t* YA; };
struct PostIn { u32x4_t pv, pg; float rk; };
__device__ __forceinline__ void seq2(LAS unsigned char* lds, const bf16_t* __restrict__ GST, const bf16_t* __restrict__ GYT, const float* __restrict__ YLT, const float* __restrict__ SLT,
                                     const float* __restrict__ PEND, const PostArgs& PA, int bh, int tid) {
    const int lane = tid & 63, wv = __builtin_amdgcn_readfirstlane(tid >> 6), fr = lane & 15, q = lane >> 4, b = bh >> 3, h = bh & 7;
    const bool state = wv < 4; const int vi = wv & 3;
    f32x4 st[4] = {{0.f, 0.f, 0.f, 0.f}, {0.f, 0.f, 0.f, 0.f}, {0.f, 0.f, 0.f, 0.f}, {0.f, 0.f, 0.f, 0.f}};
    SetG z0, z1;
    const size_t u0 = (size_t)bh * 64;
    load_set(z0, state, GST, GYT, YLT, SLT, u0, vi, lane);
    LAS float* ybuf = (LAS float*)(lds + 16384); LAS float* pend = (LAS float*)(lds + 33280);
    { const f32x4 a = *(const f32x4*)(PEND + u0 * 64 + tid * 8), c4 = *(const f32x4*)(PEND + u0 * 64 + tid * 8 + 4); *(LAS f32x4*)(pend + tid * 8) = a; *(LAS f32x4*)(pend + tid * 8 + 4) = c4; }
    const int pt = tid >> 3, pj0 = 8 * (tid & 7), pch = h * 64 + pj0;
    PostIn pi0, pi1;
    const f32x4 lwa = *(const f32x4*)(PA.ln_w + pch), lwb = *(const f32x4*)(PA.ln_w + pch + 4), lba = *(const f32x4*)(PA.ln_b + pch), lbb = *(const f32x4*)(PA.ln_b + pch + 4);
    { const unsigned prow0 = (unsigned)(b * SEQ + pt), poff0 = prow0 * DR + pch; pi0.pv = *(const u32x4_t*)(PA.V + poff0); pi0.pg = *(const u32x4_t*)(PA.GG + poff0); pi0.rk = PA.RK[prow0 * 8 + h]; }
#define WKV_POST(cc, PP) do {   \
        const unsigned prow = (unsigned)(b * SEQ + (cc) * CH + pt), poff = prow * DR + pch; \
        const u32x4_t pv = PP.pv, pg = PP.pg; const float prk = PP.rk; \
        float yv[8]; float s_ = 0.f; \
        _Pragma("unroll") for (int e = 0; e < 8; ++e) { yv[e] = ybuf[pt * 65 + pj0 + e]; s_ += yv[e]; } \
        const float mean_ = sum8(s_) * (1.f / 64.f); float q2_ = 0.f; \
        _Pragma("unroll") for (int e = 0; e < 8; ++e) { yv[e] -= mean_; q2_ += yv[e] * yv[e]; } \
        const float rstd_ = rsqrtf(sum8(q2_) * (1.f / 64.f) + GN_EPS); \
        const float vv[8] = {s5::blo(pv.x), s5::bhi(pv.x), s5::blo(pv.y), s5::bhi(pv.y), s5::blo(pv.z), s5::bhi(pv.z), s5::blo(pv.w), s5::bhi(pv.w)}; \
        const float gg[8] = {s5::blo(pg.x), s5::bhi(pg.x), s5::blo(pg.y), s5::bhi(pg.y), s5::blo(pg.z), s5::bhi(pg.z), s5::blo(pg.w), s5::bhi(pg.w)}; \
        float o_[8]; \
        _Pragma("unroll") for (int e = 0; e < 8; ++e) o_[e] = (yv[e] * rstd_ * (e < 4 ? lwa[e] : lwb[e - 4]) + (e < 4 ? lba[e] : lbb[e - 4]) + prk * vv[e]) * gg[e]; \
        u32x4_t ow = {pk_bf16(o_[0], o_[1]), pk_bf16(o_[2], o_[3]), pk_bf16(o_[4], o_[5]), pk_bf16(o_[6], o_[7])}; \
        *(u32x4_t*)(PA.YA + poff) = ow; \
        } while (0)
#define WKV_STEP(c, ZC, ZN2, PC, PN) do {   \
        SQP0(); \
        LAS unsigned char* slot = lds + (((c) & 1) * 4 + vi) * 2048 + lane * 16; \
        bf16x8 sb0, sb1; \
        if (state) { sb0 = acc2b(st[0], st[1]); sb1 = acc2b(st[2], st[3]); *(LAS bf16x8*)slot = sb0; *(LAS bf16x8*)(slot + 1024) = sb1; } \
        if ((c) + 1 < NCHK) load_set(ZN2, state, GST, GYT, YLT, SLT, u0 + (c) + 1, vi, lane); \
        if ((c) > 0) WKV_POST((c) - 1, PN); \
        if ((c) + 1 < NCHK) { const unsigned prow1 = (unsigned)(b * SEQ + ((c) + 1) * CH + pt), poff1 = prow1 * DR + pch;     \
            PN.pv = __builtin_nontemporal_load((const u32x4_t*)(PA.V + poff1)); PN.pg = __builtin_nontemporal_load((const u32x4_t*)(PA.GG + poff1)); PN.rk = PA.RK[prow1 * 8 + h]; } \
        LDS_BARRIER(); SQP1(); \
        if (state) { \
            _Pragma("unroll") for (int a = 0; a < 4; ++a) { const f32x4 pe = *(const LAS f32x4*)(pend + (c) * 64 + 16 * a + 4 * q); \
                f32x4 n = unpk4(ZC.locp[a]) + pe * st[a]; n = MFMA16(ZC.g[a][0], sb0, n); n = MFMA16(ZC.g[a][1], sb1, n); st[a] = n; } \
        } else { \
            sb0 = *(const LAS bf16x8*)slot; sb1 = *(const LAS bf16x8*)(slot + 1024); \
            int fr_ = fr, q_ = q; asm volatile("" : "+v"(fr_), "+v"(q_)); \
            _Pragma("unroll") for (int m = 0; m < 4; ++m) { f32x4 y = MFMA16(ZC.g[m][0], sb0, unpk4(ZC.locp[m])); y = MFMA16(ZC.g[m][1], sb1, y); \
                _Pragma("unroll") for (int r = 0; r < 4; ++r) ybuf[(16 * m + 4 * q_ + r) * 65 + 16 * vi + fr_] = y[r]; } \
        } \
        LDS_BARRIER(); SQP2(); \
        } while (0)
    for (int c = 0; c < NCHK; c += 2) { WKV_STEP(c, z0, z1, pi0, pi1); WKV_STEP(c + 1, z1, z0, pi1, pi0); }
    WKV_POST(NCHK - 1, pi1);
#undef WKV_POST
#undef WKV_STEP
    __syncthreads();
}
__device__ __forceinline__ void post(int t, int c, const float* __restrict__ YRAW, const bf16_t* __restrict__ V, const bf16_t* __restrict__ GG, const float* __restrict__ RK,
                                     const float* __restrict__ ln_w, const float* __restrict__ ln_b, bf16_t* __restrict__ YA) {
    const size_t o = (size_t)t * DR + c;
    const float y = YRAW[o];
    const float mean = wave_allsum(y) * (1.f / 64.f);
    const float dv = y - mean;
    const float var = wave_allsum(dv * dv) * (1.f / 64.f);
    const float yn = dv * rsqrtf(var + GN_EPS) * ln_w[c] + ln_b[c];
    YA[o] = f2bf((yn + RK[(size_t)t * 8 + (c >> 6)] * bf2f(V[o])) * bf2f(GG[o]));
}
}

namespace rt {
__device__ __forceinline__ void ln1route8(int row0, int lane, const float* __restrict__ S, const float* __restrict__ lw, const float* __restrict__ lb, float* __restrict__ X, bf16_t* __restrict__ XN,
        const float* __restrict__ RTW, const float* __restrict__ gb, const float* __restrict__ eb, unsigned* __restrict__ cnt, int* __restrict__ EID, int* __restrict__ POS, float* __restrict__ WGT, LAS float* lg  ) {
    f32x4 v[8][4];
#pragma unroll
    for (int i = 0; i < 8; ++i) { float s = 0.f;
#pragma unroll
        for (int k = 0; k < 4; ++k) { v[i][k] = *(const f32x4*)(S + (size_t)(row0 + i) * D + 256 * k + 4 * lane); s += (v[i][k][0] + v[i][k][1]) + (v[i][k][2] + v[i][k][3]); }
        const float mean = wave_allsum(s) * (1.f / D); float q = 0.f;
#pragma unroll
        for (int k = 0; k < 4; ++k) { v[i][k] -= mean; q += (v[i][k][0] * v[i][k][0] + v[i][k][1] * v[i][k][1]) + (v[i][k][2] * v[i][k][2] + v[i][k][3] * v[i][k][3]); }
        const float rstd = rsqrtf(wave_allsum(q) * (1.f / D) + LN_EPS);
#pragma unroll
        for (int k = 0; k < 4; ++k) { const f32x4 w4 = *(const f32x4*)(lw + 256 * k + 4 * lane), b4 = *(const f32x4*)(lb + 256 * k + 4 * lane);
            v[i][k] = v[i][k] * rstd * w4 + b4;
            *(f32x4*)(X + (size_t)(row0 + i) * D + 256 * k + 4 * lane) = v[i][k];
            u32x2_t_ o = {att::pk_bf16(v[i][k][0], v[i][k][1]), att::pk_bf16(v[i][k][2], v[i][k][3])};
            *(u32x2_t_*)(XN + (size_t)(row0 + i) * D + 256 * k + 4 * lane) = o; } }
    for (int j = 0; j < 36; ++j) { f32x4 w[4];
#pragma unroll
        for (int k = 0; k < 4; ++k) w[k] = *(const f32x4*)(RTW + j * 1024 + 256 * k + 4 * lane);
#pragma unroll
        for (int i = 0; i < 8; ++i) { float a = 0.f;
#pragma unroll
            for (int k = 0; k < 4; ++k) a += (v[i][k][0] * w[k][0] + v[i][k][1] * w[k][1]) + (v[i][k][2] * w[k][2] + v[i][k][3] * w[k][3]);
            a = wave_allsum(a); if (lane == 0) lg[i * 40 + j] = a; } }
    asm volatile("s_waitcnt lgkmcnt(0)" ::: "memory");
    if (lane < 8) { const LAS float* l8 = lg + lane * 40; const int t = row0 + lane;
        int gs = 0; float gm = l8[0] + gb[0];
        for (int j = 1; j < 4; ++j) { const float x = l8[j] + gb[j]; if (x > gm) { gm = x; gs = j; } }
        float den = 0.f;
        for (int j = 0; j < 4; ++j) den += __expf(l8[j] + gb[j] - gm);
        const float pg = 1.f / den;
        int i0 = 0; float m0 = l8[4 + gs * 8] + eb[gs * 8];
        for (int j = 1; j < 8; ++j) { const float x = l8[4 + gs * 8 + j] + eb[gs * 8 + j]; if (x > m0) { m0 = x; i0 = j; } }
        int i1 = -1; float m1 = 0.f;
        for (int j = 0; j < 8; ++j) { const float x = l8[4 + gs * 8 + j] + eb[gs * 8 + j]; if (j != i0 && (i1 < 0 || x > m1)) { m1 = x; i1 = j; } }
        const float e1 = __expf(m1 - m0);
        const float p0 = 1.f / (1.f + e1), p1 = e1 / (1.f + e1);
        const int ex0 = gs * 8 + i0, ex1 = gs * 8 + i1;
        EID[t * 2] = ex0; EID[t * 2 + 1] = ex1;
        WGT[t * 2] = pg * p0; WGT[t * 2 + 1] = pg * p1;
        POS[t * 2] = (int)atomicAdd(&cnt[ex0], 1u);
        POS[t * 2 + 1] = (int)atomicAdd(&cnt[ex1], 1u); }
}
__device__ __forceinline__ void ln1route_phase(LAS unsigned char* lds, const float* __restrict__ S, const float* __restrict__ lw, const float* __restrict__ lb, float* __restrict__ X, bf16_t* __restrict__ XN,
        const float* __restrict__ RTW, const float* __restrict__ gb, const float* __restrict__ eb, unsigned* __restrict__ cnt, int* __restrict__ EID, int* __restrict__ POS, float* __restrict__ WGT, unsigned* __restrict__ TOKS, int tid, int bid, int G) {
    constexpr int XP = 1028;
    LAS float* xt = (LAS float*)lds; LAS float* part = (LAS float*)(lds + 16 * XP * 4); LAS float* lgs = part + 8 * 16 * 48;
    const int lane = tid & 63, wv = __builtin_amdgcn_readfirstlane(tid >> 6), fr = lane & 15, q = lane >> 4;
    float bw[3][32];
#pragma unroll
    for (int ct = 0; ct < 3; ++ct)
#pragma unroll
        for (int ks = 0; ks < 32; ++ks) bw[ct][ks] = RTW[((wv * 32 + ks) * 3 + ct) * 64 + lane];
    f32x4 vn[2][4];
    if (bid < T / 16) {
#pragma unroll
        for (int i = 0; i < 2; ++i)
#pragma unroll
            for (int k = 0; k < 4; ++k) vn[i][k] = __builtin_nontemporal_load((const f32x4*)(S + (size_t)(bid * 16 + 2 * wv + i) * D + 4 * lane + 256 * k)); }
    int dt = -1, de0 = 0, de1 = 0, dp0 = 0, dp1 = 0;
    for (int tl = bid; tl < T / 16; tl += G) {
        const int row0 = tl * 16;
        f32x4 vc[2][4];
#pragma unroll
        for (int i = 0; i < 2; ++i)
#pragma unroll
            for (int k = 0; k < 4; ++k) vc[i][k] = vn[i][k];
        if (tl + G < T / 16) {
#pragma unroll
            for (int i = 0; i < 2; ++i)
#pragma unroll
                for (int k = 0; k < 4; ++k) vn[i][k] = __builtin_nontemporal_load((const f32x4*)(S + (size_t)((tl + G) * 16 + 2 * wv + i) * D + 4 * lane + 256 * k)); }
#pragma unroll
        for (int i = 0; i < 2; ++i) { const int r = 2 * wv + i; f32x4 v[4]; float s = 0.f;
#pragma unroll
            for (int k = 0; k < 4; ++k) { v[k] = vc[i][k]; s += (v[k][0] + v[k][1]) + (v[k][2] + v[k][3]); }
            const float mean = wave_allsum(s) * (1.f / D); float qq = 0.f;
#pragma unroll
            for (int k = 0; k < 4; ++k) { v[k] -= mean; qq += (v[k][0] * v[k][0] + v[k][1] * v[k][1]) + (v[k][2] * v[k][2] + v[k][3] * v[k][3]); }
            const float rstd = rsqrtf(wave_allsum(qq) * (1.f / D) + LN_EPS);
#pragma unroll
            for (int k = 0; k < 4; ++k) { const f32x4 w4 = *(const f32x4*)(lw + 256 * k + 4 * lane), b4 = *(const f32x4*)(lb + 256 * k + 4 * lane);
                v[k] = v[k] * rstd * w4 + b4;
                u32x2_t_ o = {att::pk_bf16(v[k][0], v[k][1]), att::pk_bf16(v[k][2], v[k][3])};
                *(u32x2_t_*)(XN + (size_t)(row0 + r) * D + 256 * k + 4 * lane) = o;
                *(LAS f32x4*)(xt + r * XP + 256 * k + 4 * lane) = v[k]; } }
        asm volatile("s_waitcnt lgkmcnt(0)\n\ts_barrier" ::: "memory");
        f32x4 acc[3] = {{0.f, 0.f, 0.f, 0.f}, {0.f, 0.f, 0.f, 0.f}, {0.f, 0.f, 0.f, 0.f}};
#pragma unroll
        for (int ks = 0; ks < 32; ++ks) { const float a = xt[fr * XP + 128 * wv + 4 * ks + q];
#pragma unroll
            for (int ct = 0; ct < 3; ++ct) acc[ct] = __builtin_amdgcn_mfma_f32_16x16x4f32(a, bw[ct][ks], acc[ct], 0, 0, 0); }
#pragma unroll
        for (int ct = 0; ct < 3; ++ct)
#pragma unroll
            for (int r = 0; r < 4; ++r) part[(wv * 16 + 4 * q + r) * 48 + 16 * ct + fr] = acc[ct][r];
        asm volatile("s_waitcnt lgkmcnt(0)\n\ts_barrier" ::: "memory");
        for (int e = tid; e < 16 * 36; e += 512) { const int tk = e / 36, j = e % 36; float s = 0.f;
#pragma unroll
            for (int w8 = 0; w8 < 8; ++w8) s += part[(w8 * 16 + tk) * 48 + j];
            lgs[tk * 40 + j] = s; }
        asm volatile("s_waitcnt lgkmcnt(0)\n\ts_barrier" ::: "memory");
        if (tid < 16) { const LAS float* l8 = lgs + tid * 40; const int t = row0 + tid;
            int gs = 0; float gm = l8[0] + gb[0];
            for (int j = 1; j < 4; ++j) { const float x = l8[j] + gb[j]; if (x > gm) { gm = x; gs = j; } }
            float den = 0.f;
            for (int j = 0; j < 4; ++j) den += __expf(l8[j] + gb[j] - gm);
            const float pg = 1.f / den;
            int i0 = 0; float m0 = l8[4 + gs * 8] + eb[gs * 8];
            for (int j = 1; j < 8; ++j) { const float x = l8[4 + gs * 8 + j] + eb[gs * 8 + j]; if (x > m0) { m0 = x; i0 = j; } }
            int i1 = -1; float m1 = 0.f;
            for (int j = 0; j < 8; ++j) { const float x = l8[4 + gs * 8 + j] + eb[gs * 8 + j]; if (j != i0 && (i1 < 0 || x > m1)) { m1 = x; i1 = j; } }
            const float e1 = __expf(m1 - m0);
            const float p0 = 1.f / (1.f + e1), p1 = e1 / (1.f + e1);
            const int ex0 = gs * 8 + i0, ex1 = gs * 8 + i1;
            EID[t * 2] = ex0; EID[t * 2 + 1] = ex1;
            WGT[t * 2] = pg * p0; WGT[t * 2 + 1] = pg * p1;
            if (dt >= 0) { POS[dt * 2] = dp0; POS[dt * 2 + 1] = dp1; TOKS[(size_t)de0 * T + dp0] = (unsigned)dt; TOKS[(size_t)de1 * T + dp1] = (unsigned)dt; }
            dp0 = (int)atomicAdd(&cnt[ex0 * 64], 1u); dp1 = (int)atomicAdd(&cnt[ex1 * 64], 1u); dt = t; de0 = ex0; de1 = ex1; }
        asm volatile("s_waitcnt lgkmcnt(0)\n\ts_barrier" ::: "memory");
    }
    if (tid < 16 && dt >= 0) { POS[dt * 2] = dp0; POS[dt * 2 + 1] = dp1; TOKS[(size_t)de0 * T + dp0] = (unsigned)dt; TOKS[(size_t)de1 * T + dp1] = (unsigned)dt; }
}
template <bool LAST> __device__ __forceinline__ void ln2_row(int t, int lane, const bf16_t* __restrict__ YG, const LAS int* offs, const int* __restrict__ EID, const int* __restrict__ POS, const float* __restrict__ WGT, const float* __restrict__ lw, const float* __restrict__ lb,
                                                          float* __restrict__ X, bf16_t* __restrict__ XN) {
    const int s0 = offs[EID[t * 2]] + POS[t * 2], s1 = offs[EID[t * 2 + 1]] + POS[t * 2 + 1]; const float w0 = WGT[t * 2], w1 = WGT[t * 2 + 1];
    f32x4 v[4]; float s = 0.f;
#pragma unroll
    for (int k = 0; k < 4; ++k) { const int c = 256 * k + 4 * lane;
        const u32x2_t_ a = __builtin_nontemporal_load((const u32x2_t_*)(YG + (size_t)s0 * D + c)), b = __builtin_nontemporal_load((const u32x2_t_*)(YG + (size_t)s1 * D + c)), x = *(const u32x2_t_*)(XN + (size_t)t * D + c);
        v[k][0] = ALPHA * s5::blo(x.x) + (s5::blo(a.x) * w0 + s5::blo(b.x) * w1); v[k][1] = ALPHA * s5::bhi(x.x) + (s5::bhi(a.x) * w0 + s5::bhi(b.x) * w1);
        v[k][2] = ALPHA * s5::blo(x.y) + (s5::blo(a.y) * w0 + s5::blo(b.y) * w1); v[k][3] = ALPHA * s5::bhi(x.y) + (s5::bhi(a.y) * w0 + s5::bhi(b.y) * w1);
        s += (v[k][0] + v[k][1]) + (v[k][2] + v[k][3]); }
    const float mean = wave_allsum(s) * (1.f / D); float q = 0.f;
#pragma unroll
    for (int k = 0; k < 4; ++k) { v[k] -= mean; q += (v[k][0] * v[k][0] + v[k][1] * v[k][1]) + (v[k][2] * v[k][2] + v[k][3] * v[k][3]); }
    const float rstd = rsqrtf(wave_allsum(q) * (1.f / D) + LN_EPS);
#pragma unroll
    for (int k = 0; k < 4; ++k) { const int c = 256 * k + 4 * lane; const f32x4 w4 = *(const f32x4*)(lw + c), b4 = *(const f32x4*)(lb + c);
        const f32x4 o = v[k] * rstd * w4 + b4;
        if (LAST) *(f32x4*)(X + (size_t)t * D + c) = o;
        else { u32x2_t_ ob = {att::pk_bf16(o[0], o[1]), att::pk_bf16(o[2], o[3])}; *(u32x2_t_*)(XN + (size_t)t * D + c) = ob; } }
}
__device__ __forceinline__ void kmean_task(LAS unsigned char* lds, const bf16_t* __restrict__ P, float* __restrict__ KM, float* __restrict__ KN, int task, int tid) {
    const int lane = tid & 63, wave = tid >> 6, rs = lane >> 3, chn = lane & 7;
    const int n = task & 15, h = (task >> 4) & 7, b = task >> 7;
    const bf16_t* src = P + ((size_t)b * SEQ + n * MBLK + wave * 32 + rs) * NPROJ + OFF_MOBA + 512 + h * 64 + chn * 8;
    float a[8] = {0.f, 0.f, 0.f, 0.f, 0.f, 0.f, 0.f, 0.f}; float n2max = 0.f;
#pragma unroll
    for (int k = 0; k < 4; ++k) { const u32x4_t z = *(const u32x4_t*)(src + (size_t)(8 * k) * NPROJ);
        const float v[8] = {s5::blo(z.x), s5::bhi(z.x), s5::blo(z.y), s5::bhi(z.y), s5::blo(z.z), s5::bhi(z.z), s5::blo(z.w), s5::bhi(z.w)}; float q2 = 0.f;
#pragma unroll
        for (int e = 0; e < 8; ++e) { a[e] += v[e]; q2 += v[e] * v[e]; }
        n2max = fmaxf(n2max, wkv::sum8(q2)); }
    LAS float* part = (LAS float*)lds;
    LAS float* pmax = (LAS float*)(lds + 16384);
#pragma unroll
    for (int e = 0; e < 8; ++e) part[(wave * 8 + rs) * 64 + chn * 8 + e] = a[e];
    pmax[tid] = n2max;
    __syncthreads();
    if (tid < 64) { float s = 0.f, m = 0.f;
#pragma unroll 8
        for (int i = 0; i < 64; ++i) s += part[i * 64 + tid];
#pragma unroll
        for (int i = 0; i < 8; ++i) m = fmaxf(m, pmax[tid * 8 + i]);
        m = wave_allmax(m);
        KM[(size_t)task * 64 + tid] = s * (1.f / MBLK);
        if (tid == 0) KN[task] = sqrtf(m); }
    __syncthreads();
}
__device__ __forceinline__ void gather_phase(LAS unsigned char* lds, const bf16_t* __restrict__ XN, const unsigned* __restrict__ cnt, const int* __restrict__ EID, const int* __restrict__ POS,
                                             int* __restrict__ SLOT, bf16_t* __restrict__ XG, int tid, int bid, int G) {
    LAS int* offs = (LAS int*)lds;
    if (tid == 0) { int o = 0;
#pragma unroll 1
        for (int e = 0; e < NE; ++e) { offs[e] = o; o += ((int)cnt[e * 64] + 255) & ~255; } }
    __syncthreads();
    const int lane = tid & 63, wave = tid >> 6;
    for (int t = bid * 8 + wave; t < T; t += G * 8) {
        const u32x4_t a = *(const u32x4_t*)(XN + (size_t)t * D + lane * 8), b = *(const u32x4_t*)(XN + (size_t)t * D + 512 + lane * 8);
#pragma unroll
        for (int k = 0; k < 2; ++k) { const int slot = offs[EID[t * 2 + k]] + POS[t * 2 + k];
            if (lane == 0) SLOT[t * 2 + k] = slot;
            *(u32x4_t*)(XG + (size_t)slot * D + lane * 8) = a; *(u32x4_t*)(XG + (size_t)slot * D + 512 + lane * 8) = b; } }
    __syncthreads();
}
__device__ __forceinline__ void slot_phase(LAS unsigned char* lds, const unsigned* __restrict__ cnt, const int* __restrict__ EID, const int* __restrict__ POS, int* __restrict__ SLOT, unsigned* __restrict__ TOK, int tid, int bid, int G) {
    LAS int* offs = (LAS int*)lds;
    if (tid == 0) { int o = 0;
#pragma unroll 1
        for (int e = 0; e < NE; ++e) { offs[e] = o; o += ((int)cnt[e * 64] + 255) & ~255; } }
    __syncthreads();
    for (int i = bid * 512 + tid; i < T * 2; i += G * 512) { const int slot = offs[EID[i]] + POS[i]; SLOT[i] = slot; TOK[slot] = (unsigned)(i >> 1); }
    __syncthreads();
}
}

constexpr int RING_BYTES = 131072;
constexpr int MISC_OFF = 143360;
constexpr int LDS_BYTES = 163840;

struct Args { const float* in[39]; float* out; unsigned char* ws; };
__device__ __forceinline__ int lnd(int v) { asm volatile("" : "+s"(v)); return v; }
#ifdef GEMM_ONLY
#define VBL(nvb, vbsz) for (int vb = 0, vt = 0; vb < 0;)
#else
#define VBL(nvb, vbsz) for (int _t = otid(c.wv), _g = lnd((int)gridDim.x), vb = lnd((int)blockIdx.x) * (512 / (vbsz)) + _t / (vbsz), vt = _t % (vbsz); vb < (nvb); vb += _g * (512 / (vbsz)))
#endif

__device__ __forceinline__ void tr_item(const float* __restrict__ W, int ldw, int K, int nblk, bf16_t* __restrict__ WT, int interleave, int row_off, LAS float* scr, int item, int lane) {
    const int kb = item / nblk, nb = item % nblk, k0 = 64 * kb, n0 = 32 * nb;
    float wv_[32];
#pragma unroll
    for (int i = 0; i < 32; ++i) wv_[i] = __builtin_nontemporal_load(W + ((size_t)(k0 + 2 * i + (lane >> 5)) * ldw + n0 + (lane & 31)));
#pragma unroll
    for (int i = 0; i < 32; ++i) scr[(2 * i + (lane >> 5)) * 33 + (lane & 31)] = wv_[i];
    asm volatile("s_waitcnt lgkmcnt(0)" ::: "memory");
    const int c = lane & 7;
    const int dr0 = interleave ? ((n0 >> 7) * 256 + (n0 & 127) + row_off) : (n0 + row_off);
#pragma unroll
    for (int j = 0; j < 4; ++j) { const int n = (lane >> 3) + 8 * j; const LAS float* sp = scr + (8 * c) * 33 + n;
        uint4 o; o.x = (unsigned)f2bf(sp[0 * 33]) | ((unsigned)f2bf(sp[1 * 33]) << 16); o.y = (unsigned)f2bf(sp[2 * 33]) | ((unsigned)f2bf(sp[3 * 33]) << 16);
        o.z = (unsigned)f2bf(sp[4 * 33]) | ((unsigned)f2bf(sp[5 * 33]) << 16); o.w = (unsigned)f2bf(sp[6 * 33]) | ((unsigned)f2bf(sp[7 * 33]) << 16);
        *(uint4*)(WT + (size_t)(dr0 + n) * K + k0 + 8 * c) = o; }
    asm volatile("s_waitcnt lgkmcnt(0)" ::: "memory");
}
struct Ctx { volatile LAS unsigned long long* tab; unsigned char* ws0; float* X; LAS unsigned char* lds; int wv; };
__device__ __forceinline__ const float* inp(const Ctx& c, int k) { volatile LAS unsigned long long* tp = c.tab; asm volatile("" : "+s"(tp)); const unsigned long long v = tp[k]; const unsigned lo = __builtin_amdgcn_readfirstlane((unsigned)v), hi = __builtin_amdgcn_readfirstlane((unsigned)(v >> 32));
    return (const float*)(((unsigned long long)hi << 32) | lo); }
__device__ __forceinline__ unsigned char* wsl(const Ctx& c) { unsigned char* w = c.ws0; asm volatile("" : "+s"(w)); return w; }
#define WBF(off) ((bf16_t*)(w + (off)))
#define WF32(off) ((float*)(w + (off)))

__device__ __forceinline__ void phase_weights(const Ctx& c, int l) {
    unsigned char* w = wsl(c);
    const int tid = otid(c.wv), lane = tid & 63, wave = tid >> 6;
    LAS float* scr = (LAS float*)(c.lds + wave * 16384);
    const int gw = lnd((int)blockIdx.x) * 8 + wave, NGW = lnd((int)gridDim.x) * 8;
    constexpr int I_IN = (D / 64) * (NPROJ / 32), I_GLU = (DSS / 64) * (DSS / 32), I_UP = (DR / 64) * (D / 32), I_OUT = (D / 64) * (D / 32), I_EG = (D / 64) * (DE / 32), I_ED = (DE / 64) * (D / 32);
    constexpr int I_E = 2 * I_EG + I_ED;
    constexpr int I_LORA = 16 + 16 + 32;
    constexpr int NITEMS = I_IN + 2 * I_GLU + 3 * I_UP + I_OUT + NE * I_E + I_LORA;
    for (int it = gw; it < NITEMS; it += NGW) {
        int r = it;
        if (r < I_LORA) {
            if (r < 16) tr_item(inp(c, 4) + (size_t)l * 64 * DR, DR, 64, DR / 32, WBF(WS_SMALL + wkv::SM_W2T), 0, 0, scr, r, lane);
            else if (r < 32) tr_item(inp(c, 6) + (size_t)l * 64 * DR, DR, 64, DR / 32, WBF(WS_SMALL + wkv::SM_A2T), 0, 0, scr, r - 16, lane);
            else tr_item(inp(c, 7) + (size_t)l * 128 * DR, DR, 128, DR / 32, WBF(WS_SMALL + wkv::SM_G2T), 0, 0, scr, r - 32, lane);
            continue; }
        r -= I_LORA;
        if (r < I_IN) { tr_item(inp(c, 1) + (size_t)l * D * NPROJ, NPROJ, D, NPROJ / 32, WBF(WS_WT_IN), 0, 0, scr, r, lane); continue; } r -= I_IN;
        if (r < 2 * I_GLU) { const int hf = r / I_GLU; tr_item(inp(c, 21) + (size_t)l * DSS * 2 * DSS + hf * DSS, 2 * DSS, DSS, DSS / 32, WBF(WS_WT_GLU), 1, hf * 128, scr, r % I_GLU, lane); continue; } r -= 2 * I_GLU;
        if (r < 3 * I_UP) { const int br = r / I_UP; tr_item(inp(c, 23 + br) + (size_t)l * DR * D, D, DR, D / 32, WBF(WS_WT_UPA + (size_t)br * MiB), 0, 0, scr, r % I_UP, lane); continue; } r -= 3 * I_UP;
        if (r < I_OUT) { tr_item(inp(c, 27) + (size_t)l * D * D, D, D, D / 32, WBF(WS_WT_OUT), 0, 0, scr, r, lane); continue; } r -= I_OUT;
        const int e = r / I_E; r %= I_E; const size_t eo = ((size_t)l * NE + e) * D * DE;
        if (r < 2 * I_EG) { const int hf = r / I_EG; tr_item(inp(c, 34 + hf) + eo, DE, D, DE / 32, WBF(WS_WT_EGU) + (size_t)e * 512 * D, 1, hf * 128, scr, r % I_EG, lane); continue; } r -= 2 * I_EG;
        tr_item(inp(c, 36) + eo, D, DE, D / 32, WBF(WS_WT_ED) + (size_t)e * D * DE, 0, 0, scr, r, lane);
    }
    VBL(8 * 32 * 3 * 64 / 256, 256) k_rtw(vb, vt, inp(c, 30) + (size_t)l * D * 4, inp(c, 32) + (size_t)l * D * 32, WF32(WS_SMALL + SM_RTW));
    VBL(NGR * SST / 256, 256) k_s5tab(vb, vt, inp(c, 13) + (size_t)l * NGR * SST, inp(c, 14) + (size_t)l * NGR * SST, inp(c, 15) + (size_t)l * NGR * SST * SGRP,
                                      inp(c, 16) + (size_t)l * NGR * SST * SGRP, inp(c, 20) + (size_t)l * NGR, WF32(WS_SMALL + SM_LAM), WF32(WS_SMALL + SM_BB));
}

#ifdef PROBE_A
#define GB() do { xcd_barrier(bar); if (l == 1 && blockIdx.x == 0 && otid(c.wv) == 0) { volatile LAS unsigned long long* ts_ = (volatile LAS unsigned long long*)(lds + MISC_OFF + 2048); const unsigned n_ = (unsigned)ts_[0]; ts_[1 + n_] = __builtin_amdgcn_s_memrealtime(); ts_[0] = n_ + 1; } } while (0)
#else
#define GB() xcd_barrier(bar)
#endif
template <int l> __device__ __forceinline__ void layer_body(const Ctx& c, const XcdBarrier& bar, LAS unsigned char* lds, unsigned char* lds_raw, volatile LAS unsigned* MISC, int G) {
#ifdef PROBE_A
    if (l == 1 && blockIdx.x == 0 && otid(c.wv) == 0) { volatile LAS unsigned long long* ts_ = (volatile LAS unsigned long long*)(lds + MISC_OFF + 2048); ts_[1] = __builtin_amdgcn_s_memrealtime(); ts_[0] = 1; }
#endif
        { unsigned char* w = wsl(c);
          pg8::Gemm g{WBF(WS_XN), WBF(WS_WT_IN), T, NPROJ, D}; pg8::StaticOrder S; S.init(T, NPROJ, lnd(G), lnd((int)blockIdx.x));
          pg8::EpiProj E{WBF(WS_PROJ), NPROJ, inp(c, 26) + (size_t)l * 3 * D, OFF_GATE / 256};
          pg8::gemm_phase<pg8::EpiProj, pg8::StaticOrder, true, true>(lds, g, S, E, c.wv); }
        GB();
        { unsigned char* w = wsl(c);
          { wkv::PreArgs pa; pa.P = WBF(WS_PROJ); pa.mu = inp(c, 2) + (size_t)l * 1792; pa.w0 = inp(c, 3) + (size_t)l * DR; pa.a0 = inp(c, 5) + (size_t)l * DR; pa.k_k = inp(c, 8) + (size_t)l * DR;
            pa.k_a = inp(c, 9) + (size_t)l * DR; pa.r_k = inp(c, 10) + (size_t)l * DR; pa.w2t = WBF(WS_SMALL + wkv::SM_W2T); pa.a2t = WBF(WS_SMALL + wkv::SM_A2T); pa.g2t = WBF(WS_SMALL + wkv::SM_G2T);
            pa.Vo = WBF(WS_V); pa.Go = WBF(WS_GG); pa.RK = (float*)(w + wkv::WS_RK); pa.GST = WBF(wkv::WS_GST); pa.GYT = WBF(wkv::WS_GYT); pa.YLT = WF32(wkv::WS_YLT); pa.SLT = WF32(wkv::WS_SLT); pa.PEND = (float*)(w + wkv::WS_PEND);
            const int tid = otid(c.wv);
#ifdef PROBE_IN
            if (l == 1 && blockIdx.x == 0 && tid == 0) ((volatile LAS unsigned long long*)(lds + MISC_OFF + 2048))[39] = __builtin_amdgcn_s_memrealtime();
#endif
            { const float* srcs_[6] = {pa.mu, pa.w0, pa.a0, pa.k_k, pa.k_a, pa.r_k};
#pragma unroll
              for (int k_ = 0; k_ < 2; ++k_) { const int i4 = tid + 512 * k_, f0 = 4 * i4;
                  const int arr = f0 < 1536 ? 0 : 1 + ((f0 - 1536) >> 9), off = f0 < 1536 ? f0 : (f0 - 1536) & 511;
                  const float* sp = arr == 0 ? pa.mu : arr == 1 ? pa.w0 : arr == 2 ? pa.a0 : arr == 3 ? pa.k_k : arr == 4 ? pa.k_a : pa.r_k; (void)srcs_;
                  *(LAS f32x4*)(lds + wkv::L_CST + f0 * 4) = *(const f32x4*)(sp + off); } }
            { const int G_ = lnd(G), bid_ = lnd((int)blockIdx.x);
              for (int tile = bid_; tile < NB * wkv::NCHK; tile += G_) {
                  const int b_ = tile >> 6, c_ = tile & 63;
                  wkv::act_tile(lds, pa, b_, c_, tid);
                  pg8::bf16x8 lb_[8][2]; wkv::load_lb(lb_, pa, 0, tid);
                  u32x4_t zc_[3], zp_[3]; wkv::load_z(zc_, zp_, pa, (size_t)b_ * SEQ + c_ * wkv::CH, c_ == 0, 0, tid);
                  for (int h_ = 0; h_ < RH; ++h_) wkv::unit_pre(lds, pa, ((b_ * RH + h_) << 6) + c_, tid, lb_, zc_, zp_); } }
#ifdef PROBE_IN
            if (l == 1 && blockIdx.x == 0 && tid == 0) ((volatile LAS unsigned long long*)(lds + MISC_OFF + 2048))[40] = __builtin_amdgcn_s_memrealtime();
#endif
          }
          { const int tid = otid(c.wv);
            for (int task = lnd((int)blockIdx.x); task < NB * MH * NBLK; task += lnd(G)) rt::kmean_task(lds, WBF(WS_PROJ), WF32(WS_SMALL + SM_KMEAN), WF32(WS_SMALL + SM_KNORM), task, tid);
#ifdef PROBE_IN
            if (l == 1 && blockIdx.x == 0 && tid == 0) ((volatile LAS unsigned long long*)(lds + MISC_OFF + 2048))[41] = __builtin_amdgcn_s_memrealtime();
#endif
          } }
        __syncthreads();
        { unsigned char* w = wsl(c); const int tid = otid(c.wv), lane = tid & 63, wave = tid >> 6;
          for (int u = lnd((int)blockIdx.x) * 8 + wave; u < NB * NGR * s5::NCH; u += lnd(G) * 8)
              s5::part1b(lds + wave * s5::WAVE_LDS2, WBF(WS_PROJ), WF32(WS_SMALL + SM_LAM), WF32(WS_SMALL + SM_BB), (float*)(w + s5::WS_S5E), u, lane); }
        GB();
#ifdef PROBE_PB
        if (l == 1 && blockIdx.x == PROBE_PB_BLK && otid(c.wv) == 0) ((volatile LAS unsigned long long*)(lds + MISC_OFF + 2048))[46] = __builtin_amdgcn_s_memrealtime();
#endif
        { unsigned char* w = wsl(c); const int tid = otid(c.wv);
          for (int bh = lnd((int)blockIdx.x); bh < NB * RH; bh += lnd(G))
              { wkv::PostArgs pa2{WBF(WS_V), WBF(WS_GG), (const float*)(w + wkv::WS_RK), inp(c, 11) + (size_t)l * DR, inp(c, 12) + (size_t)l * DR, WBF(WS_YA)};
                wkv::seq2(lds, WBF(wkv::WS_GST), WBF(wkv::WS_GYT), WF32(wkv::WS_YLT), WF32(wkv::WS_SLT), (const float*)(w + wkv::WS_PEND), pa2, bh, tid); } }
#ifdef PROBE_PB
        if (l == 1 && blockIdx.x == PROBE_PB_BLK && otid(c.wv) == 0) ((volatile LAS unsigned long long*)(lds + MISC_OFF + 2048))[47] = __builtin_amdgcn_s_memrealtime();
#endif
        { unsigned char* w = wsl(c); const int tid = otid(c.wv), lane = tid & 63, wave = tid >> 6;
          const int G_ = lnd(G), bid_ = lnd((int)blockIdx.x), skip_ = G_ >= 64 ? NB * RH : 0;
          if (bid_ >= skip_) for (int u = (bid_ - skip_) * 8 + wave; u < NB * NGR * s5::NCH; u += (G_ - skip_) * 8)
              s5::part2b(lds + wave * s5::WAVE_LDS2, WBF(WS_PROJ), WF32(WS_SMALL + SM_LAM), WF32(WS_SMALL + SM_BB), (const float*)(w + s5::WS_S5E),
                        inp(c, 17) + (size_t)l * NGR * SGRP * SST, inp(c, 18) + (size_t)l * NGR * SGRP * SST, inp(c, 19) + (size_t)l * DSS, WBF(WS_YCPRE), u, lane); }
        __syncthreads();
#ifdef PROBE_PB
        if (l == 1 && blockIdx.x == PROBE_PB_BLK && otid(c.wv) == 0) ((volatile LAS unsigned long long*)(lds + MISC_OFF + 2048))[48] = __builtin_amdgcn_s_memrealtime();
#endif
        { unsigned char* w = wsl(c);
          att::phase(lds, MISC + 12, (unsigned*)(w + WS_CTL) + CW_AQ + l, WBF(WS_PROJ), WF32(WS_SMALL + SM_KMEAN), WF32(WS_SMALL + SM_KNORM), WBF(WS_YB), c.wv); }
#ifdef PROBE_PB
        if (l == 1 && blockIdx.x == PROBE_PB_BLK && otid(c.wv) == 0) ((volatile LAS unsigned long long*)(lds + MISC_OFF + 2048))[49] = __builtin_amdgcn_s_memrealtime();
#endif
        GB();
        { unsigned char* w = wsl(c);
          pg8::Gemm g{WBF(WS_YCPRE), WBF(WS_WT_GLU), T, 2 * DSS, DSS}; pg8::StaticOrder S; S.init(T, 2 * DSS, lnd(G), lnd((int)blockIdx.x));
          pg8::EpiGated<0> E{WBF(WS_YC), DSS, inp(c, 22) + (size_t)l * 2 * DSS, DSS, 3};
          pg8::gemm_phase<pg8::EpiGated<0>, pg8::StaticOrder, true, true>(lds, g, S, E, c.wv); }
        GB();
        { unsigned char* w = wsl(c);
          static_assert(WS_YB == WS_YA + (size_t)T * DR * 2 && WS_YC == WS_YB + (size_t)T * DR * 2 && WS_WT_UPB == WS_WT_UPA + (size_t)D * DR * 2 && WS_WT_UPC == WS_WT_UPB + (size_t)D * DR * 2, "branch operands contiguous");
          pg8::Gemm g{WBF(WS_YA), WBF(WS_WT_UPA), 3 * T, 3 * D, DR}; pg8::TripleOrder S; S.base.init(T, D, lnd(G), lnd((int)blockIdx.x));
          pg8::EpiUp E{WBF(WS_PROJ) + OFF_GATE, NPROJ, WBF(WS_MERGEDB), D};
          pg8::gemm_phase<pg8::EpiUp, pg8::TripleOrder, true, true>(lds, g, S, E, c.wv); }
        GB();
        { unsigned char* w = wsl(c);
          pg8::Gemm g{WBF(WS_MERGEDB), WBF(WS_WT_OUT), T, D, D}; pg8::StaticOrder S; S.init(T, D, lnd(G), lnd((int)blockIdx.x));
          pg8::EpiOut E{WBF(WS_XN), WF32(WS_S), D, ALPHA};
          pg8::gemm_phase<pg8::EpiOut, pg8::StaticOrder, true, true>(lds, g, S, E, c.wv); }
        GB();
        { unsigned char* w = wsl(c); unsigned* cnt = (unsigned*)(w + WS_CTL) + CW_CNT + l * 32 * 64;
          rt::ln1route_phase(lds, WF32(WS_S), inp(c, 28) + (size_t)l * D, inp(c, 29) + (size_t)l * D, c.X, WBF(WS_XN), WF32(WS_SMALL + SM_RTW), inp(c, 31) + (size_t)l * 4, inp(c, 33) + (size_t)l * 32, cnt,
                             (int*)(w + WS_ROUTE + RT_EID), (int*)(w + WS_ROUTE + RT_POS), (float*)(w + WS_ROUTE + RT_WGT), (unsigned*)(w + WS_TOKS), otid(c.wv), lnd((int)blockIdx.x), lnd(G)); }
        GB();
        { unsigned char* w = wsl(c); unsigned* cnt = (unsigned*)(w + WS_CTL) + CW_CNT + l * 32 * 64;
          { const int t_ = otid(c.wv); if (t_ < NE) MISC[352 + t_] = cnt[t_ * 64]; }
          __syncthreads();
          if (otid(c.wv) == 0) { int nt = 0;
#pragma unroll 1
              for (int e = 0; e < NE; ++e) { const int te = ((int)MISC[352 + e] + 255) >> 8;
#pragma unroll 1
                  for (int q = 0; q < te; ++q) { MISC[16 + nt + q] = (unsigned)e; MISC[656 + nt + q] = (unsigned)(e * T + q * 256); }
                  nt += te; }
              MISC[8] = (unsigned)nt; }
          __syncthreads();
          const int ntiles = (int)MISC[8];
          pg8::Gemm g{WBF(WS_XN), WBF(WS_WT_EGU), MAXSLOT, NE * 512, D}; pg8::GatherOrder<2> S{(const LAS int*)(lds + MISC_OFF + 64), (const LAS int*)(lds + MISC_OFF + 2624), (const unsigned*)(w + WS_TOKS), ntiles, lnd(G), lnd((int)blockIdx.x), T};
          pg8::EpiGated<1> E{WBF(WS_HID), DE, nullptr, 0, 1};
          pg8::gemm_phase<pg8::EpiGated<1>, pg8::GatherOrder<2>, true, true>(lds, g, S, E, c.wv); }
        GB();
        { unsigned char* w = wsl(c); const int ntiles = (int)MISC[8];
          pg8::Gemm g{WBF(WS_HID), WBF(WS_WT_ED), MAXSLOT, NE * D, DE}; pg8::GroupedOrder<4> S{(const LAS int*)(lds + MISC_OFF + 64), ntiles, lnd(G), lnd((int)blockIdx.x)};
          pg8::EpiBf16Grp E{WBF(WS_YG), D, 3};
          pg8::gemm_phase<pg8::EpiBf16Grp, pg8::GroupedOrder<4>, true, true>(lds, g, S, E, c.wv); }
        GB();
        { unsigned char* w = wsl(c);
          { const int tid = otid(c.wv), lane = tid & 63, wave = tid >> 6; unsigned* cnt = (unsigned*)(w + WS_CTL) + CW_CNT + l * 32 * 64;
            LAS int* offs = (LAS int*)lds;
            if (tid < NE) offs[64 + tid] = (int)cnt[tid * 64];
            __syncthreads();
            if (tid == 0) { int o = 0;
#pragma unroll 1
                for (int e = 0; e < NE; ++e) { offs[e] = o; o += (offs[64 + e] + 255) & ~255; } }
            __syncthreads();
            for (int t = lnd((int)blockIdx.x) * 8 + wave; t < T; t += lnd(G) * 8)
                rt::ln2_row<(l == DEPTH - 1)>(t, lane, WBF(WS_YG), offs, (const int*)(w + WS_ROUTE + RT_EID), (const int*)(w + WS_ROUTE + RT_POS), (float*)(w + WS_ROUTE + RT_WGT), inp(c, 37) + (size_t)l * D, inp(c, 38) + (size_t)l * D, c.X, WBF(WS_XN));
            __syncthreads(); } }
        if (l + 1 < DEPTH) phase_weights(c, l + 1);
        GB();
}

__global__ void __launch_bounds__(512, 2) mega(Args a) {
    extern __shared__ __attribute__((aligned(16))) unsigned char lds_raw[];
    LAS unsigned char* lds = (LAS unsigned char*)lds_raw;
    volatile LAS unsigned* MISC = (volatile LAS unsigned*)(lds + MISC_OFF);
    Ctx c; c.tab = (volatile LAS unsigned long long*)(lds + MISC_OFF + 1024); c.ws0 = a.ws; c.X = a.out; c.lds = lds;
    c.wv = __builtin_amdgcn_readfirstlane((int)threadIdx.x >> 6);
    if (threadIdx.x < 16) MISC[threadIdx.x] = 0u;
    if (threadIdx.x < 64) ((volatile LAS unsigned long long*)(lds + MISC_OFF + 2048))[threadIdx.x] = 0ull;
    if (threadIdx.x < 39) c.tab[threadIdx.x] = (unsigned long long)a.in[threadIdx.x];
    __syncthreads();
    XcdBarrier bar = xcd_barrier_post((unsigned*)(a.ws + WS_CTL) + CW_BAR, MISC, c.wv);
    const int G = (int)gridDim.x;
    constexpr int l = -1; (void)l;
    { unsigned char* w = wsl(c); const float* xin = inp(c, 0); bf16_t* xn = WBF(WS_XN);
#pragma unroll 4
      for (size_t i = ((size_t)lnd((int)blockIdx.x) * 512 + otid(c.wv)) * 8; i < (size_t)T * D; i += (size_t)lnd(G) * 512 * 8) {
          const f32x4 a = __builtin_nontemporal_load((const f32x4*)(xin + i)), b = __builtin_nontemporal_load((const f32x4*)(xin + i + 4));
          u32x4_t o = {att::pk_bf16(a[0], a[1]), att::pk_bf16(a[2], a[3]), att::pk_bf16(b[0], b[1]), att::pk_bf16(b[2], b[3])}; *(u32x4_t*)(xn + i) = o; } }
    phase_weights(c, 0);
    GB();
    layer_body<0>(c, bar, lds, lds_raw, MISC, G);
    layer_body<1>(c, bar, lds, lds_raw, MISC, G);
    layer_body<2>(c, bar, lds, lds_raw, MISC, G);
    layer_body<3>(c, bar, lds, lds_raw, MISC, G);
#ifdef PROBE_A
#ifndef PROBE_PB_BLK
#define PROBE_PB_BLK 0
#endif
    if (blockIdx.x == PROBE_PB_BLK) {
        volatile LAS unsigned long long* ts_ = (volatile LAS unsigned long long*)(lds + MISC_OFF + 2048);
#if defined(PROBE_PB)
        const float dA = (float)(ts_[PROBE_PB_I1] - ts_[PROBE_PB_I0]) * 0.01f, dB = (float)(ts_[PROBE_PB_I3] - ts_[PROBE_PB_I2]) * 0.01f;
#elif defined(PROBE_UP)
        const float dA = (float)ts_[44] * 0.01f / 32.f, dB = (float)ts_[45] * 0.01f / 32.f;
#elif defined(PROBE_IN)
        const float dA = (float)(ts_[40] - ts_[39]) * 0.01f, dB = (float)(ts_[41] - ts_[40]) * 0.01f;
#else
        const float dA = (float)(ts_[2 + PROBE_A] - ts_[1 + PROBE_A]) * 0.01f, dB = (float)(ts_[2 + PROBE_B] - ts_[1 + PROBE_B]) * 0.01f;
#endif
        const int tid = otid(c.wv);
        if (tid == 0) c.X[0] += dA * 0.01f;
        const float dl = sqrtf(dB * 1e-6f * 16777216.f / 1048576.f);
        for (int i = tid; i < 1048576; i += 512) c.X[16 * i + 5] += dl;
    }
#endif
}

extern "C" void kernel_launch(void* const* d_in, const int* in_sizes, int n_in, void* d_out, int out_size, void* d_ws, size_t ws_size, hipStream_t stream) {
    static int grid = 0;
    if (grid == 0) {
        if (n_in != 39 || out_size != T * D || ws_size < WS_END) { fprintf(stderr, "kernel_launch: unexpected shapes n_in %d out %d ws %zu\n", n_in, out_size, ws_size); grid = -1; return; }
        int dev = 0, cus = 0, per_cu = 0;
        if (hipGetDevice(&dev) != hipSuccess || hipDeviceGetAttribute(&cus, hipDeviceAttributeMultiprocessorCount, dev) != hipSuccess) { grid = -1; return; }
        if (hipFuncSetAttribute((const void*)mega, hipFuncAttributeMaxDynamicSharedMemorySize, LDS_BYTES) != hipSuccess) { fprintf(stderr, "kernel_launch: hipFuncSetAttribute failed\n"); grid = -1; return; }
        if (hipOccupancyMaxActiveBlocksPerMultiprocessor(&per_cu, (const void*)mega, 512, LDS_BYTES) != hipSuccess || per_cu < 1) fprintf(stderr, "kernel_launch: occupancy query says %d\n", per_cu);
        (void)hipGetLastError();
        grid = cus;
        fprintf(stderr, "kernel_launch: grid %d, ws %zu\n", grid, ws_size);
    }
    if (grid < 0) return;
    (void)hipMemsetAsync((char*)d_ws + WS_CTL, 0, CTL_BYTES, stream);
    Args a{};
    for (int i = 0; i < 39; ++i) a.in[i] = (const float*)d_in[i];
    a.out = (float*)d_out; a.ws = (unsigned char*)d_ws;
    hipLaunchKernelGGL(mega, dim3(grid), dim3(512), LDS_BYTES, stream, a);
}
```
